# Optimizing an MI355X kernel written in HIP

```python
import math
import jax, jax.numpy as jnp
from jax import lax
import numpy as np

D_MODEL = 1024
BATCH = 32
SEQ = 2048
DEPTH = 1

N_HEADS = 8
HEAD_DIM = 64
QK_DIM = 2 * N_HEADS * HEAD_DIM
V_DIM = N_HEADS * 2 * HEAD_DIM
BLOCK_Q = 128
CONV_WIDTH = D_MODEL
CONV_K = 3
D_FF = -(-8 * D_MODEL // (3 * 256)) * 256
EPS = 1e-6

IN_SIZES = [QK_DIM, QK_DIM, V_DIM, CONV_WIDTH, CONV_WIDTH, CONV_WIDTH, D_MODEL, D_MODEL]
IN_SPLITS = [int(s) for s in np.cumsum(IN_SIZES)[:-1]]
D_IN = int(sum(IN_SIZES))

kernel_name = "hybrid_conv_diffattn_gated_adaln_block"


def rmsnorm(x, g):
    xf = x.astype(jnp.float32)
    y = xf * lax.rsqrt(jnp.mean(xf * xf, axis=-1, keepdims=True) + EPS)
    return (y * g.astype(jnp.float32)).astype(x.dtype)


def causal_dwconv(u, w):
    S = u.shape[1]
    up = jnp.pad(u, ((0, 0), (CONV_K - 1, 0), (0, 0)))
    y = up[:, 0:S] * w[0]
    for j in range(1, CONV_K):
        y = y + up[:, j:j + S] * w[j]
    return y


def diff_attention(q, k, v, lam):
    S = q.shape[1]
    scale = HEAD_DIM ** -0.5
    outs = []
    for i in range(S // BLOCK_Q):
        q0 = i * BLOCK_Q
        kl = q0 + BLOCK_Q
        qb = q[:, q0:kl]
        kb = k[:, :kl]
        vb = v[:, :kl]
        s = jnp.einsum('bqhcd,bkhcd->bhcqk', qb, kb).astype(jnp.float32) * scale
        causal = (q0 + jnp.arange(BLOCK_Q))[:, None] >= jnp.arange(kl)[None, :]
        p = jax.nn.softmax(jnp.where(causal, s, -jnp.inf), axis=-1)
        a = (p[:, :, 0] - lam * p[:, :, 1]).astype(vb.dtype)
        outs.append(jnp.einsum('bhqk,bkhe->bqhe', a, vb))
    return jnp.concatenate(outs, axis=1)


def setup_inputs(seed: int = 0) -> dict:
    key = jax.random.key(seed)
    ks = jax.random.split(key, 20)
    f32 = jnp.float32
    L, D = DEPTH, D_MODEL

    def w(k, shape, fan_in, mult=1.0):
        return jax.random.normal(k, shape, f32) * (mult * fan_in ** -0.5)

    def gain(k, shape):
        return 1.0 + 0.02 * jax.random.normal(k, shape, f32)

    return {
        "x": jax.random.normal(ks[0], (BATCH, SEQ, D), f32),
        "c": jax.random.normal(ks[1], (BATCH, D), f32),
        "w_ada": w(ks[2], (L, D, 6 * D), D, 0.1),
        "b_ada": 0.02 * jax.random.normal(ks[3], (L, 6 * D), f32),
        "norm1_g": gain(ks[4], (L, D)),
        "w_in": w(ks[5], (L, D, D_IN), D),
        "conv_w": w(ks[6], (L, CONV_K, CONV_WIDTH), CONV_K),
        "q_norm_g": gain(ks[7], (L, HEAD_DIM)),
        "k_norm_g": gain(ks[8], (L, HEAD_DIM)),
        "lambda_q1": 0.1 * jax.random.normal(ks[9], (L, HEAD_DIM), f32),
        "lambda_k1": 0.1 * jax.random.normal(ks[10], (L, HEAD_DIM), f32),
        "lambda_q2": 0.1 * jax.random.normal(ks[11], (L, HEAD_DIM), f32),
        "lambda_k2": 0.1 * jax.random.normal(ks[12], (L, HEAD_DIM), f32),
        "subln_g": gain(ks[13], (L, 2 * HEAD_DIM)),
        "w_a_out": w(ks[14], (L, CONV_WIDTH, D), CONV_WIDTH),
        "w_b_out": w(ks[15], (L, V_DIM, D), V_DIM),
        "w_o": w(ks[16], (L, D, D), D),
        "norm2_g": gain(ks[17], (L, D)),
        "w_gu": w(ks[18], (L, D, 2 * D_FF), D),
        "w_down": w(ks[19], (L, D_FF, D), D_FF),
    }


def reference(x, c, w_ada, b_ada, norm1_g, w_in, conv_w, q_norm_g, k_norm_g,
              lambda_q1, lambda_k1, lambda_q2, lambda_k2, subln_g,
              w_a_out, w_b_out, w_o, norm2_g, w_gu, w_down):
    B, S, D = x.shape
    c_act = jax.nn.silu(c)
    for l in range(DEPTH):
        lambda_init = 0.8 - 0.6 * math.exp(-0.3 * l)
        mod = c_act @ w_ada[l] + b_ada[l]
        sh1, sc1, g1, sh2, sc2, g2 = [m[:, None, :] for m in jnp.split(mod, 6, axis=-1)]

        h = rmsnorm(x, norm1_g[l]) * (1.0 + sc1) + sh1
        proj = h @ w_in[l]
        q, k, v, cb, cc, cx, ga, gb = jnp.split(proj, IN_SPLITS, axis=-1)

        ya = cb * causal_dwconv(cc * cx, conv_w[l])
        ya = ya @ w_a_out[l]

        q = rmsnorm(q.reshape(B, S, N_HEADS, 2, HEAD_DIM), q_norm_g[l])
        k = rmsnorm(k.reshape(B, S, N_HEADS, 2, HEAD_DIM), k_norm_g[l])
        v = v.reshape(B, S, N_HEADS, 2 * HEAD_DIM)
        lam = (jnp.exp(jnp.sum(lambda_q1[l].astype(jnp.float32) * lambda_k1[l].astype(jnp.float32)))
               - jnp.exp(jnp.sum(lambda_q2[l].astype(jnp.float32) * lambda_k2[l].astype(jnp.float32)))
               + lambda_init)
        o = diff_attention(q, k, v, lam)
        o = rmsnorm(o, subln_g[l]) * (1.0 - lambda_init)
        yb = o.reshape(B, S, V_DIM) @ w_b_out[l]

        m = jax.nn.sigmoid(ga) * ya + jax.nn.sigmoid(gb) * yb
        x = x + g1 * (m @ w_o[l])

        h2 = rmsnorm(x, norm2_g[l]) * (1.0 + sc2) + sh2
        gu = h2 @ w_gu[l]
        fg, fu = jnp.split(gu, 2, axis=-1)
        x = x + g2 * ((jax.nn.silu(fg) * fu) @ w_down[l])
    return x
```

```cpp
#include <hip/hip_runtime.h>
#include <hip/hip_cooperative_groups.h>
#include <hip/hip_bf16.h>
#include <cstdio>
#include <cstdint>
#include <cmath>
namespace cg = cooperative_groups;
namespace pg8 {
#define PG8_LAS __attribute__((address_space(3)))
typedef unsigned short bf16_t;
typedef short bf16x8 __attribute__((ext_vector_type(8)));
typedef float f32x4 __attribute__((ext_vector_type(4)));
typedef unsigned u32x4 __attribute__((ext_vector_type(4)));
constexpr int BM = 256, BK = 64, HALF = 128, HTB = HALF * BK * 2  , STAGE_BYTES = 8 * HTB, NXCD = 8, WGM = 8;

__host__ __device__ __forceinline__ int lds_byte(int r, int c) { const int st = (r >> 4) * 2 + (c >> 5), rr = r & 15, cc = c & 31, ob = rr * 64 + cc * 2; return st * 1024 + (ob ^ (((ob >> 9) & 1) << 5)); }
__host__ __device__ __forceinline__ void stage_rc(int b, int& R, int& C) { const int st = b / 1024, sb = b % 1024, swz = sb ^ (((sb >> 9) & 1) << 5); R = (st >> 1) * 16 + swz / 64; C = (st & 1) * 32 + (swz % 64) / 2; }
__host__ __device__ __forceinline__ int perm32(int rho) { const int n = rho >> 4, i = rho & 15; return 8 * (i >> 2) + 4 * n + (i & 3); }

struct Unit { int pm, pn; };
struct Gemm { const bf16_t* A; const bf16_t* Bt; int M, N, K; };

struct StaticOrder {
    int nM, nN, nwg, G, c;
    __host__ __device__ void init(int M, int N, int G_, int c_) { nM = M / BM; nN = N / BM; nwg = nM * nN; G = G_; c = c_; }
    __host__ __device__ bool next(int i, Unit& u) const {
        const long L = (long)i * G + c; if (L >= nwg) return false;
        int wgid = (int)L; { const int q = nwg / NXCD, r = nwg % NXCD, xcd = wgid % NXCD, off = wgid / NXCD; wgid = (xcd < r ? xcd * (q + 1) : r * (q + 1) + (xcd - r) * q) + off; }
        const int nig = WGM * nN, gid = wgid / nig, fm = gid * WGM, gsz = (nM - fm) < WGM ? (nM - fm) : WGM;
        u.pm = fm + ((wgid % nig) % gsz); u.pn = (wgid % nig) / gsz; return true;
    }
    __device__ __forceinline__ void a_ready(const Unit&) const {}
    __device__ __forceinline__ void done(const Unit&) const {}
};
typedef float f32x2 __attribute__((ext_vector_type(2))); typedef __bf16 bf16x2_t __attribute__((ext_vector_type(2)));
__device__ __forceinline__ unsigned cvt_pk_bf16(float lo, float hi) { f32x2 v = {lo, hi}; bf16x2_t b = __builtin_convertvector(v, bf16x2_t); return __builtin_bit_cast(unsigned, b); }
constexpr float EPSF = 1e-6f;
constexpr float QC2 = 0.125f * 1.4426950408889634f;
__device__ __forceinline__ u32x4 pack8(const f32x4 a, const f32x4 b) { u32x4 w; w.x = cvt_pk_bf16(a[0], a[1]); w.y = cvt_pk_bf16(a[2], a[3]); w.z = cvt_pk_bf16(b[0], b[1]); w.w = cvt_pk_bf16(b[2], b[3]); return w; }
__device__ __forceinline__ float bf_lo(unsigned u) { return __uint_as_float(u << 16); }
__device__ __forceinline__ float bf_hi(unsigned u) { return __uint_as_float(u & 0xffff0000u); }
__device__ __forceinline__ void unpack8(const u32x4 w, f32x4& a, f32x4& b) { a = (f32x4){bf_lo(w.x), bf_hi(w.x), bf_lo(w.y), bf_hi(w.y)}; b = (f32x4){bf_lo(w.z), bf_hi(w.z), bf_lo(w.w), bf_hi(w.w)}; }
template <int X> __device__ __forceinline__ float swz_xor(float v) { return __uint_as_float((unsigned)__builtin_amdgcn_ds_swizzle((int)__float_as_uint(v), (X << 10) | 0x1f)); }
__device__ __forceinline__ float wave_sum64(float v) { v += swz_xor<1>(v); v += swz_xor<2>(v); v += swz_xor<4>(v); v += swz_xor<8>(v); v += swz_xor<16>(v);
    auto rr = __builtin_amdgcn_permlane32_swap(__float_as_uint(v), __float_as_uint(v), false, false); return __uint_as_float(rr[0]) + __uint_as_float(rr[1]); }
__device__ __forceinline__ float sigm(float x) { return __builtin_amdgcn_rcpf(1.f + __builtin_amdgcn_exp2f(-1.4426950408889634f * x)); }
#ifdef EXP_NOSIG
__device__ __forceinline__ f32x4 sigm4(const f32x4 v) { return v * 0.25f + 0.5f; }
#else
__device__ __forceinline__ f32x4 sigm4(const f32x4 v) { return (f32x4){sigm(v[0]), sigm(v[1]), sigm(v[2]), sigm(v[3])}; }
#endif

struct EpiAll {
    static constexpr bool PERM = true, AFTER_DRAIN = false;
    int mode; bf16_t *o0, *o1, *o2, *o3, *o4, *o5, *o6; const float *f0, *f1; float* fo;
    __device__ __forceinline__ void operator()(const f32x4 (&acc)[2][2][4][2], const Unit& un, int wr, int wc, int fr, int fq) const {
        const int pn = un.pn; const size_t row0 = (size_t)un.pm * BM + wr * 64 + fr;
        if (mode == 0) {
            if (pn < 8) {
                const bool isq = pn < 4; bf16_t* base = isq ? o0 : o1; const float* g = isq ? f0 : f1; const float sc = isq ? QC2 : 1.f;
                f32x4 gv[2][2];
#pragma unroll
                for (int bj = 0; bj < 2; ++bj)
#pragma unroll
                    for (int n = 0; n < 2; ++n) gv[bj][n] = *(const f32x4*)(g + 32 * bj + 8 * fq + 4 * n) * sc;
                const int col0 = (pn & 3) * 256 + 64 * wc + 8 * fq;
#pragma unroll
                for (int ai = 0; ai < 2; ++ai)
#pragma unroll
                    for (int m = 0; m < 4; ++m) {
                        float ss = 0.f;
#pragma unroll
                        for (int bj = 0; bj < 2; ++bj)
#pragma unroll
                            for (int n = 0; n < 2; ++n) { const f32x4 x = acc[ai][bj][m][n]; ss += (x[0] * x[0] + x[1] * x[1]) + (x[2] * x[2] + x[3] * x[3]); }
                        ss += swz_xor<16>(ss); { auto rr = __builtin_amdgcn_permlane32_swap(__float_as_uint(ss), __float_as_uint(ss), false, false); ss = __uint_as_float(rr[0]) + __uint_as_float(rr[1]); }
                        const float rs = rsqrtf(ss * (1.f / 64.f) + EPSF);
                        bf16_t* rowp = base + (row0 + ai * HALF + m * 16) * 1024 + col0;
#pragma unroll
                        for (int bj = 0; bj < 2; ++bj) *(u32x4*)(rowp + 32 * bj) = pack8(acc[ai][bj][m][0] * rs * gv[bj][0], acc[ai][bj][m][1] * rs * gv[bj][1]);
                    }
            } else if (pn < 12) {
                const int col0 = (pn & 3) * 256 + wc * 32 + 8 * fq;
#pragma unroll
                for (int ai = 0; ai < 2; ++ai)
#pragma unroll
                    for (int m = 0; m < 4; ++m) { bf16_t* rowp = o2 + (row0 + ai * HALF + m * 16) * 1024 + col0;
#pragma unroll
                        for (int bj = 0; bj < 2; ++bj) *(u32x4*)(rowp + bj * HALF) = pack8(acc[ai][bj][m][0], acc[ai][bj][m][1]); }
            } else {
                const int col0 = (pn & 3) * 256 + wc * 32 + 8 * fq;
#pragma unroll
                for (int ai = 0; ai < 2; ++ai)
#pragma unroll
                    for (int m = 0; m < 4; ++m) { bf16_t* rowp = o6 + (row0 + ai * HALF + m * 16) * 1024 + col0;
#pragma unroll
                        for (int bj = 0; bj < 2; ++bj) *(u32x4*)(rowp + bj * HALF) = pack8(sigm4(acc[ai][bj][m][0]), sigm4(acc[ai][bj][m][1])); }
            }
        } else if (mode == 5) {
            if (pn < 4) {
                const int col0 = pn * 256 + wc * 32 + 8 * fq;
#pragma unroll
                for (int ai = 0; ai < 2; ++ai)
#pragma unroll
                    for (int m = 0; m < 4; ++m) { bf16_t* rowp = o3 + (row0 + ai * HALF + m * 16) * 1024 + col0;
#pragma unroll
                        for (int bj = 0; bj < 2; ++bj) *(u32x4*)(rowp + bj * HALF) = pack8(acc[ai][bj][m][0], acc[ai][bj][m][1]); }
            } else if (pn < 12) {
                const int col0 = (pn - 4) * 128 + wc * 32 + 8 * fq;
#pragma unroll
                for (int ai = 0; ai < 2; ++ai)
#pragma unroll
                    for (int m = 0; m < 4; ++m)
                        *(u32x4*)(o4 + (row0 + ai * HALF + m * 16) * 1024 + col0) = pack8(acc[ai][0][m][0] * acc[ai][1][m][0], acc[ai][0][m][1] * acc[ai][1][m][1]);
            } else {
                const int col0 = (pn & 3) * 256 + wc * 32 + 8 * fq;
#pragma unroll
                for (int ai = 0; ai < 2; ++ai)
#pragma unroll
                    for (int m = 0; m < 4; ++m) { bf16_t* rowp = o5 + (row0 + ai * HALF + m * 16) * 1024 + col0;
#pragma unroll
                        for (int bj = 0; bj < 2; ++bj) *(u32x4*)(rowp + bj * HALF) = pack8(sigm4(acc[ai][bj][m][0]), sigm4(acc[ai][bj][m][1])); }
            }
        } else if (mode == 1 || mode == 2) {
            const int col0 = pn * 256 + wc * 32 + 8 * fq;
#pragma unroll
            for (int ai = 0; ai < 2; ++ai)
#pragma unroll
                for (int m = 0; m < 4; ++m) { const size_t off = (row0 + ai * HALF + m * 16) * 1024 + col0;
#pragma unroll
                    for (int bj = 0; bj < 2; ++bj) { f32x4 ga, gb; unpack8(*(const u32x4*)(o1 + off + bj * HALF), ga, gb);
                        f32x4 r0 = ga * acc[ai][bj][m][0], r1 = gb * acc[ai][bj][m][1];
                        if (mode == 2) { f32x4 ma, mb; unpack8(*(const u32x4*)(o0 + off + bj * HALF), ma, mb); r0 += ma; r1 += mb; }
                        *(u32x4*)(o0 + off + bj * HALF) = pack8(r0, r1); } }
        } else if (mode == 3) {
            const int col0 = pn * 256 + wc * 32 + 8 * fq; const float* gp = f1 + (size_t)((un.pm * BM) >> 11) * 6144 + col0;
            f32x4 gv[2][2];
#pragma unroll
            for (int bj = 0; bj < 2; ++bj)
#pragma unroll
                for (int n = 0; n < 2; ++n) gv[bj][n] = *(const f32x4*)(gp + bj * HALF + 4 * n);
#pragma unroll
            for (int ai = 0; ai < 2; ++ai)
#pragma unroll
                for (int m = 0; m < 4; ++m) { const size_t off = (row0 + ai * HALF + m * 16) * 1024 + col0;
#pragma unroll
                    for (int bj = 0; bj < 2; ++bj)
#pragma unroll
                        for (int n = 0; n < 2; ++n) *(f32x4*)(fo + off + bj * HALF + 4 * n) = *(const f32x4*)(f0 + off + bj * HALF + 4 * n) + gv[bj][n] * acc[ai][bj][m][n]; }
        } else {
            const int col0 = pn * 128 + wc * 32 + 8 * fq;
#pragma unroll
            for (int ai = 0; ai < 2; ++ai)
#pragma unroll
                for (int m = 0; m < 4; ++m) { const f32x4 g0 = acc[ai][0][m][0], g1 = acc[ai][0][m][1];
                    *(u32x4*)(o0 + (row0 + ai * HALF + m * 16) * 2816 + col0) = pack8(g0 * sigm4(g0) * acc[ai][1][m][0], g1 * sigm4(g1) * acc[ai][1][m][1]); }
        }
    }
};

template <class Epi, class Sched, bool ALIGN_EPI = false, bool SP2 = false>
__device__ __forceinline__ void gemm_phase(PG8_LAS unsigned char* lds, const Gemm g, const Sched& S, const Epi& E) {
    int tid_ = threadIdx.x; asm volatile("" : "+v"(tid_)); const int tid = tid_, wid = __builtin_amdgcn_readfirstlane(tid >> 6), lane = tid & 63, wr = wid >> 2, wc = wid & 3, fr = lane & 15, fq = lane >> 4;
    const int K = g.K, nt = K / BK;
    unsigned voffA[2], voffB[2];
#pragma unroll
    for (int i = 0; i < 2; ++i) { int R, C; stage_rc(tid * 16 + i * 8192, R, C); const int Rb = Epi::PERM ? ((R & ~31) + perm32(R & 31)) : R;
        voffA[i] = (unsigned)(R * K + C) * 2u; voffB[i] = (unsigned)(Rb * K + C) * 2u; }
    const size_t kstep = (size_t)(BK * 2);
    const size_t hstep = (size_t)HALF * K * 2;
    const size_t tstep = 2 * hstep;
    const unsigned ldsw = (unsigned)wid * 1024u;
    const int aoff = lds_byte(wr * 64 + fr, fq * 8), boff = lds_byte(wc * 32 + fr, fq * 8);
#define PG8_SA(b, h) (((b) * 2 + (h)) * HTB)
#define PG8_SB(b, h) ((4 + (b) * 2 + (h)) * HTB)
#define PG8_STAGE(bufoff, gbase, voff) do { _Pragma("unroll") for (int _i = 0; _i < 2; ++_i) \
        __builtin_amdgcn_global_load_lds((const unsigned*)((const char*)(gbase) + (voff)[_i]), (PG8_LAS unsigned*)(lds + (bufoff) + ldsw + _i * 8192), 16, 0, 0); } while (0)
#define PG8_LDA(dst, b, h) do { _Pragma("unroll") for (int m = 0; m < 4; ++m) _Pragma("unroll") for (int k = 0; k < 2; ++k) dst[m][k] = *(const PG8_LAS bf16x8*)(lds + PG8_SA(b, h) + aoff + m * 2048 + k * 1024); } while (0)
#define PG8_LDB(dst, b, h) do { _Pragma("unroll") for (int n = 0; n < 2; ++n) _Pragma("unroll") for (int k = 0; k < 2; ++k) dst[n][k] = *(const PG8_LAS bf16x8*)(lds + PG8_SB(b, h) + boff + n * 2048 + k * 1024); } while (0)
#define PG8_MMA(ai, bj, At, Bt) do { __builtin_amdgcn_s_setprio(1); _Pragma("unroll") for (int m = 0; m < 4; ++m) _Pragma("unroll") for (int n = 0; n < 2; ++n) _Pragma("unroll") for (int k = 0; k < 2; ++k) \
        acc[ai][bj][m][n] = __builtin_amdgcn_mfma_f32_16x16x32_bf16(Bt[n][k], At[m][k], acc[ai][bj][m][n], 0, 0, 0); __builtin_amdgcn_s_setprio(0); } while (0)
#define PG8_WAIT_V(n) asm volatile("s_waitcnt vmcnt(" #n ")" ::: "memory")
#define PG8_WAIT_L(n) asm volatile("s_waitcnt lgkmcnt(" #n ")" ::: "memory")
#define PG8_BAR __builtin_amdgcn_s_barrier()
#define PG8_SCHED __builtin_amdgcn_sched_barrier(0)
    Unit cur, nxt; int ui = 0;
    if (!S.next(0, cur)) return;
    f32x4 acc[2][2][4][2];
#pragma unroll
    for (int a = 0; a < 2; ++a)
#pragma unroll
        for (int b = 0; b < 2; ++b)
#pragma unroll
            for (int m = 0; m < 4; ++m)
#pragma unroll
                for (int n = 0; n < 2; ++n) acc[a][b][m][n] = (f32x4){0.f, 0.f, 0.f, 0.f};
    bf16x8 At[4][2], B0[2][2], B1[2][2];
    const char* cA = (const char*)g.A + (size_t)cur.pm * tstep; const char* cB = (const char*)g.Bt + (size_t)cur.pn * tstep;
    S.a_ready(cur);
    if constexpr (SP2) {
        PG8_STAGE(PG8_SB(0, 0), cB, voffB); PG8_STAGE(PG8_SB(0, 1), cB + hstep, voffB); PG8_STAGE(PG8_SA(0, 0), cA, voffA); PG8_STAGE(PG8_SA(0, 1), cA + hstep, voffA);
        if (wr == 1) PG8_BAR;
        PG8_WAIT_V(2); PG8_BAR;
        PG8_STAGE(PG8_SB(1, 0), cB + kstep, voffB); PG8_STAGE(PG8_SA(1, 0), cA + kstep, voffA); PG8_STAGE(PG8_SB(1, 1), cB + hstep + kstep, voffB);
        PG8_WAIT_V(6); PG8_BAR;
    } else {
        PG8_STAGE(PG8_SB(0, 0), cB, voffB); PG8_STAGE(PG8_SA(0, 0), cA, voffA); PG8_STAGE(PG8_SB(0, 1), cB + hstep, voffB); PG8_STAGE(PG8_SA(0, 1), cA + hstep, voffA);
        if (wr == 1) PG8_BAR;
        PG8_WAIT_V(4); PG8_BAR;
        PG8_STAGE(PG8_SB(1, 0), cB + kstep, voffB); PG8_STAGE(PG8_SA(1, 0), cA + kstep, voffA); PG8_STAGE(PG8_SB(1, 1), cB + hstep + kstep, voffB);
        PG8_WAIT_V(6); PG8_BAR;
    }
    for (;;) {
        const bool has_next = S.next(ui + 1, nxt);
        const char* nA = has_next ? (const char*)g.A + (size_t)nxt.pm * tstep : cA; const char* nB = has_next ? (const char*)g.Bt + (size_t)nxt.pn * tstep : cB;
        for (int t = 0; t < nt; t += 2) {
            const bool last = (t == nt - 2);
            const char* a1 = cA + (size_t)(t + 1) * kstep;
            const char* a2 = last ? nA : cA + (size_t)(t + 2) * kstep; const char* b2 = last ? nB : cB + (size_t)(t + 2) * kstep;
            const char* a3 = a2 + kstep; const char* b3 = b2 + kstep;
            if (last && has_next) S.a_ready(nxt);
            if constexpr (SP2) {
            PG8_LDB(B0, 0, 0); PG8_LDB(B1, 0, 1); PG8_SCHED; PG8_LDA(At, 0, 0); PG8_STAGE(PG8_SA(1, 1), a1 + hstep, voffA);
            PG8_WAIT_V(8); PG8_WAIT_L(0); PG8_BAR; PG8_MMA(0, 0, At, B0); PG8_MMA(0, 1, At, B1); PG8_BAR; PG8_SCHED;
            PG8_LDA(At, 0, 1); PG8_STAGE(PG8_SB(0, 0), b2, voffB); PG8_STAGE(PG8_SB(0, 1), b2 + hstep, voffB); PG8_STAGE(PG8_SA(0, 0), a2, voffA);
            PG8_WAIT_V(8); PG8_WAIT_L(0); PG8_BAR; PG8_MMA(1, 0, At, B0); PG8_MMA(1, 1, At, B1); PG8_BAR; PG8_SCHED;
            PG8_LDB(B0, 1, 0); PG8_LDB(B1, 1, 1); PG8_SCHED; PG8_LDA(At, 1, 0); PG8_STAGE(PG8_SA(0, 1), a2 + hstep, voffA);
            PG8_WAIT_V(8); PG8_WAIT_L(0); PG8_BAR; PG8_MMA(0, 0, At, B0); PG8_MMA(0, 1, At, B1); PG8_BAR; PG8_SCHED;
            PG8_LDA(At, 1, 1); PG8_STAGE(PG8_SB(1, 0), b3, voffB); PG8_STAGE(PG8_SB(1, 1), b3 + hstep, voffB); PG8_STAGE(PG8_SA(1, 0), a3, voffA);
            PG8_WAIT_V(8); PG8_WAIT_L(0); PG8_BAR; PG8_MMA(1, 0, At, B0); PG8_MMA(1, 1, At, B1); PG8_BAR; PG8_SCHED;
            } else {
            PG8_LDB(B0, 0, 0); PG8_SCHED; PG8_LDA(At, 0, 0); PG8_STAGE(PG8_SA(1, 1), a1 + hstep, voffA);
            PG8_WAIT_L(8); PG8_BAR; PG8_WAIT_L(0); PG8_MMA(0, 0, At, B0); PG8_BAR; PG8_SCHED;
            PG8_LDB(B1, 0, 1); PG8_STAGE(PG8_SB(0, 0), b2, voffB);
            PG8_BAR; PG8_WAIT_L(0); PG8_MMA(0, 1, At, B1); PG8_BAR;
            PG8_LDA(At, 0, 1); PG8_STAGE(PG8_SA(0, 0), a2, voffA);
            PG8_BAR; PG8_WAIT_L(0); PG8_MMA(1, 0, At, B0); PG8_BAR; PG8_SCHED;
            PG8_STAGE(PG8_SB(0, 1), b2 + hstep, voffB);
            PG8_WAIT_V(6); PG8_BAR; PG8_MMA(1, 1, At, B1); PG8_BAR;
            PG8_LDB(B0, 1, 0); PG8_SCHED; PG8_LDA(At, 1, 0); PG8_STAGE(PG8_SA(0, 1), a2 + hstep, voffA);
            PG8_WAIT_L(8); PG8_BAR; PG8_WAIT_L(0); PG8_MMA(0, 0, At, B0); PG8_BAR; PG8_SCHED;
            PG8_LDB(B1, 1, 1); PG8_STAGE(PG8_SB(1, 0), b3, voffB);
            PG8_BAR; PG8_WAIT_L(0); PG8_MMA(0, 1, At, B1); PG8_BAR;
            PG8_LDA(At, 1, 1); PG8_STAGE(PG8_SA(1, 0), a3, voffA);
            PG8_BAR; PG8_WAIT_L(0); PG8_MMA(1, 0, At, B0); PG8_BAR; PG8_SCHED;
            PG8_STAGE(PG8_SB(1, 1), b3 + hstep, voffB);
            PG8_WAIT_V(6); PG8_BAR; PG8_MMA(1, 1, At, B1); PG8_BAR;
            }
        }
        if constexpr (ALIGN_EPI) { if (wr == 0) PG8_BAR; }
        if constexpr (!Epi::AFTER_DRAIN) { PG8_WAIT_V(0); E(acc, cur, wr, wc, fr, fq); PG8_WAIT_V(0); S.done(cur); }
        if (!has_next) break;
#pragma unroll
        for (int a = 0; a < 2; ++a)
#pragma unroll
            for (int b = 0; b < 2; ++b)
#pragma unroll
                for (int m = 0; m < 4; ++m)
#pragma unroll
                    for (int n = 0; n < 2; ++n) acc[a][b][m][n] = (f32x4){0.f, 0.f, 0.f, 0.f};
        cur = nxt; cA = nA; cB = nB; ++ui;
        if constexpr (ALIGN_EPI) { if (wr == 1) PG8_BAR; }
    }
    PG8_WAIT_V(0);
    if constexpr (!ALIGN_EPI) { if (wr == 0) PG8_BAR; }
    PG8_BAR;
    if constexpr (Epi::AFTER_DRAIN) { E.fused(acc, cur, wr, wc, fr, fq, lds, wid, lane); S.done(cur); }
#undef PG8_SA
#undef PG8_SB
#undef PG8_STAGE
#undef PG8_LDA
#undef PG8_LDB
#undef PG8_MMA
#undef PG8_WAIT_V
#undef PG8_WAIT_L
#undef PG8_BAR
#undef PG8_SCHED
}
}
namespace attn_body {
using bf16=__hip_bfloat16;
using bf16x8=__attribute__((ext_vector_type(8)))short;
using s16x4=__attribute__((ext_vector_type(4)))short;
using f32x16=__attribute__((ext_vector_type(16)))float;
using u32x4=__attribute__((ext_vector_type(4)))unsigned;
constexpr int BATCH=32,NHEAD=16,SEQ=2048,D=64,DM=NHEAD*D;
constexpr int NW=8,QBLK=32,QB=QBLK*NW,KVBLK=64,NQB=SEQ/QB;
constexpr int ATTN_PITCH=DM, ATTN_UNIT_ROWS=QB;
__device__ __forceinline__ int crow(int r,int hi){return (r&3)+8*(r>>2)+4*hi;}
#define SBAR() __builtin_amdgcn_sched_barrier(0)
__device__ __forceinline__ void cmask(f32x16&p0,f32x16&p1,int jb,int qrel,int hi){
  const float NEG=-INFINITY; int kb=64*jb+4*hi;
  #pragma unroll
  for(int r=0;r<16;++r){int kv=kb+(r&3)+8*(r>>2); if(kv>qrel)p0[r]=NEG; if(kv+32>qrel)p1[r]=NEG;}
}

constexpr int NSLOT=3, SLOTB=8192;
constexpr int LDS_K=0, LDS_V=NSLOT*SLOTB, LDS_WS=2*NSLOT*SLOTB, LDS_OST=LDS_WS+NW*64*4, LDS_BYTES=LDS_OST+NW*4096;
constexpr float C2=0.125f*1.4426950408889634f;
__device__ __forceinline__ void glds16(const void*gsrc,unsigned lds_dst){unsigned keep;
  asm volatile("s_mov_b32 %0, m0\n\ts_mov_b32 m0, %2\n\ts_nop 0\n\tglobal_load_lds_dwordx4 %1, off\n\ts_mov_b32 m0, %0":"=&s"(keep):"v"(gsrc),"s"(lds_dst):"memory");}
__device__ __forceinline__ float max3f(float a,float b,float c){float r;asm("v_max3_f32 %0, %1, %2, %3":"=v"(r):"v"(a),"v"(b),"v"(c));return r;}
__device__ __forceinline__ float max2f(float a,float b){float r;asm("v_max_f32_e32 %0, %1, %2":"=v"(r):"v"(a),"v"(b));return r;}
__device__ __forceinline__ float fadd_s(float a,float b){float r;asm("v_add_f32_e32 %0, %1, %2":"=v"(r):"v"(a),"v"(b));return r;}
__device__ __forceinline__ float fsub_s(float a,float b){float r;asm("v_sub_f32_e32 %0, %1, %2":"=v"(r):"v"(a),"v"(b));return r;}
typedef float f32x2_t __attribute__((ext_vector_type(2))); typedef __bf16 bf16x2_t __attribute__((ext_vector_type(2)));
__device__ __forceinline__ unsigned cvtpk_s(float lo,float hi){f32x2_t v={lo,hi};bf16x2_t b=__builtin_convertvector(v,bf16x2_t);return __builtin_bit_cast(unsigned,b);}
#define WAIT_BAR(N) asm volatile("s_waitcnt vmcnt(" #N ") lgkmcnt(0)\n\ts_barrier":::"memory")

__device__ __forceinline__ void qkt(f32x16&p0,f32x16&p1,const char*Kslot,const bf16x8*qr,const f32x16&negm,int r32,int hi){
  const char*kb=Kslot+hi*1024+r32*16;
  #pragma unroll
  for(int d0=0;d0<4;++d0){
    const bf16x8 b0=*reinterpret_cast<const bf16x8*>(kb+d0*2048);
    const bf16x8 b1=*reinterpret_cast<const bf16x8*>(kb+d0*2048+512);
    if(d0==0){p0=__builtin_amdgcn_mfma_f32_32x32x16_bf16(b0,qr[0],negm,0,0,0);p1=__builtin_amdgcn_mfma_f32_32x32x16_bf16(b1,qr[0],negm,0,0,0);}
    else{p0=__builtin_amdgcn_mfma_f32_32x32x16_bf16(b0,qr[d0],p0,0,0,0);p1=__builtin_amdgcn_mfma_f32_32x32x16_bf16(b1,qr[d0],p1,0,0,0);}}
}
typedef __attribute__((address_space(3))) const char* lds_cptr;
typedef short v4i16_t __attribute__((ext_vector_type(4)));
__device__ __forceinline__ void kload8(bf16x8*kf,lds_cptr kp){
  kf[0]=*(const __attribute__((address_space(3))) bf16x8*)(kp);      kf[1]=*(const __attribute__((address_space(3))) bf16x8*)(kp+512);
  kf[2]=*(const __attribute__((address_space(3))) bf16x8*)(kp+2048); kf[3]=*(const __attribute__((address_space(3))) bf16x8*)(kp+2560);
  kf[4]=*(const __attribute__((address_space(3))) bf16x8*)(kp+4096); kf[5]=*(const __attribute__((address_space(3))) bf16x8*)(kp+4608);
  kf[6]=*(const __attribute__((address_space(3))) bf16x8*)(kp+6144); kf[7]=*(const __attribute__((address_space(3))) bf16x8*)(kp+6656);
}
__device__ __forceinline__ void kload2(bf16x8*kf,lds_cptr kp,int j){ kf[2*j]=*(const __attribute__((address_space(3))) bf16x8*)(kp+j*2048); kf[2*j+1]=*(const __attribute__((address_space(3))) bf16x8*)(kp+j*2048+512); }
__device__ __forceinline__ s16x4 vtr(lds_cptr p){ return __builtin_bit_cast(s16x4,__builtin_amdgcn_ds_read_tr16_b64_v4i16((__attribute__((address_space(3))) v4i16_t*)p)); }
__device__ __forceinline__ float rowmax(const f32x16&p0,const f32x16&p1){
  float a=max3f(p0[0],p0[1],p1[0]),b=max3f(p0[2],p0[3],p1[1]);a=max3f(a,p1[2],p1[3]);
  #pragma unroll
  for(int r=4;r<16;r+=4){a=max3f(a,p0[r],p0[r+1]);b=max3f(b,p0[r+2],p0[r+3]);a=max3f(a,p1[r],p1[r+1]);b=max3f(b,p1[r+2],p1[r+3]);}
  const float m=max2f(a,b);
  auto rr=__builtin_amdgcn_permlane32_swap(__float_as_uint(m),__float_as_uint(m),false,false);
  return max2f(__uint_as_float(rr[0]),__uint_as_float(rr[1]));
}
__device__ __forceinline__ void pv(f32x16*o,int vb,bf16x8 pa0,bf16x8 pa1,bf16x8 pa2,bf16x8 pa3){
  #pragma unroll
  for(int d0=0;d0<2;++d0){s16x4 lo[4],hi[4];
    #pragma unroll
    for(int ks=0;ks<4;++ks){
      asm volatile("ds_read_b64_tr_b16 %0,%1 offset:%c2":"=&v"(lo[ks]):"v"(vb),"i"(d0*4096+ks*1024):"memory");
      asm volatile("ds_read_b64_tr_b16 %0,%1 offset:%c2":"=&v"(hi[ks]):"v"(vb),"i"(d0*4096+ks*1024+512):"memory");}
    asm volatile("s_waitcnt lgkmcnt(0)":::"memory");SBAR();
    #define PK(k) (bf16x8){lo[k][0],lo[k][1],lo[k][2],lo[k][3],hi[k][0],hi[k][1],hi[k][2],hi[k][3]}
    o[d0]=__builtin_amdgcn_mfma_f32_32x32x16_bf16(pa0,PK(0),o[d0],0,0,0);
    o[d0]=__builtin_amdgcn_mfma_f32_32x32x16_bf16(pa1,PK(1),o[d0],0,0,0);
    o[d0]=__builtin_amdgcn_mfma_f32_32x32x16_bf16(pa2,PK(2),o[d0],0,0,0);
    o[d0]=__builtin_amdgcn_mfma_f32_32x32x16_bf16(pa3,PK(3),o[d0],0,0,0);
    #undef PK
  }
}

#ifndef ATTN_STORE16
#define ATTN_STORE16(p,v) (*(u32x4*)(p)=(v))
#endif
template<int THRL> __device__ __forceinline__ void attn_unit(int b,int h,int hv,int qb,int mode,float lam,const float*subg,const bf16*Q,const bf16*__restrict__ K,const bf16*__restrict__ V,bf16*O,char*shm){
  int tid_=threadIdx.x; asm volatile("":"+v"(tid_)); const int tid=tid_,lane=tid&63,r32=lane&31,hi=lane>>5; const int wid=__builtin_amdgcn_readfirstlane(tid>>6);
  const long rowbase=(long)b*SEQ; const int q0=qb*QB;
  const bf16*Qw=Q+(rowbase+q0+wid*QBLK)*DM+h*D;
  const bf16*Kh=K+rowbase*DM+h*D,*Vh=V+rowbase*DM+hv*D;
  const unsigned lds0=(unsigned)(uintptr_t)shm;
  float*wsf=(float*)(shm+LDS_WS)+wid*64;
  const bf16*ksrc=Kh+(long)lane*DM+wid*8;
  const bf16*vsrc=Vh+(long)(16*(wid&3)+(lane>>2))*DM+(wid>>2)*32+(lane&3)*8;
  const unsigned kdst=lds0+LDS_K+wid*1024, vdst=lds0+LDS_V+wid*1024;
  #define DMA_K(t,slot) glds16(ksrc+(long)(t)*KVBLK*DM,(unsigned)__builtin_amdgcn_readfirstlane(kdst+(slot)))
  #define DMA_V(t,slot) glds16(vsrc+(long)(t)*KVBLK*DM,(unsigned)__builtin_amdgcn_readfirstlane(vdst+(slot)))
  const int vb0=(int)(lds0+LDS_V)+((lane>>4)&1)*32+(lane&3)*8+(4*hi+((lane&15)>>2))*64;
  const char*Kbase=shm+LDS_K; bf16x8 kf[8];
  const lds_cptr shm3=(lds_cptr)shm; const lds_cptr kp0=shm3+LDS_K+hi*1024+r32*16; const lds_cptr vp0=shm3+LDS_V+((lane>>4)&1)*32+(lane&3)*8+(4*hi+((lane&15)>>2))*64;
  const int NT=(q0+QB)/KVBLK;
  DMA_K(0,0);DMA_V(0,0);DMA_K(1,SLOTB);
  bf16x8 qr[4];
  #pragma unroll
  for(int d0=0;d0<4;++d0)qr[d0]=*reinterpret_cast<const bf16x8*>(&Qw[(long)r32*DM+d0*16+hi*8]);
  float mhat=0.f,l_reg=0.f;f32x16 o[2];o[0]=f32x16{};o[1]=f32x16{};f32x16 negm=f32x16{};asm volatile("":"+v"(negm));
  const int qrel=wid*QBLK+r32;
  #define CMASK(P0,P1,t) do{int jb_=(t)-(NT-4); if(jb_>=0)cmask(P0,P1,jb_,qrel,hi);}while(0)
  bool resc=false;
  #define START(P0,P1) do{ const float rm=rowmax(P0,P1); resc=false; \
    { const float dl=rm; mhat=fadd_s(mhat,dl); \
      _Pragma("unroll") for(int r=0;r<16;++r){P0[r]=fsub_s(P0[r],dl);P1[r]=fsub_s(P1[r],dl);} \
      _Pragma("unroll") for(int r=0;r<16;++r)negm[r]=-mhat; asm volatile("":"+v"(negm)); } \
    _Pragma("unroll") for(int r=0;r<16;++r)P0[r]=__builtin_amdgcn_exp2f(P0[r]); }while(0)
  #define RESC() do{ if(resc){ asm volatile("s_waitcnt lgkmcnt(0)":::"memory"); \
      _Pragma("unroll") for(int d_=0;d_<2;++d_) _Pragma("unroll") for(int r=0;r<16;++r)o[d_][r]*=wsf[crow(r,hi)]; } }while(0)
  f32x16 pA0,pA1,pB0,pB1;
  int sl_prev=0,sl_cur=0,sl_next=SLOTB;
  #define ROT() do{sl_prev=sl_cur;sl_cur=sl_next;sl_next=(sl_next==(NSLOT-1)*SLOTB)?0:sl_next+SLOTB;}while(0)
  DMA_K(2,2*SLOTB);
  WAIT_BAR(3);
  qkt(pA0,pA1,Kbase,qr,negm,r32,hi);asm volatile("s_nop 15\n\ts_nop 7":"+v"(pA0),"+v"(pA1));CMASK(pA0,pA1,0);
  START(pA0,pA1);
  _Pragma("unroll") for(int r=0;r<16;++r)pA1[r]=__builtin_amdgcn_exp2f(pA1[r]);
  WAIT_BAR(0);
  DMA_K(3,0);DMA_V(1,SLOTB);
  ROT();
  kload8(kf,kp0+sl_cur);
  WAIT_BAR(2);
  s16x4 vlo[8],vhi[8]; u32x4 pw0,pw1,pw2,pw3;
  #define PKW(P,B) cvtpk_s(P[B],P[B+1])
  #define PAF(k) __builtin_bit_cast(bf16x8,pw##k)
  #define VFR(i) (bf16x8){vlo[i][0],vlo[i][1],vlo[i][2],vlo[i][3],vhi[i][0],vhi[i][1],vhi[i][2],vhi[i][3]}
  #define PIN(x) asm volatile("":"+v"(x))
  #define MX3(a,b,c) __builtin_fmaxf(__builtin_fmaxf((a),(b)),(c))
  #define GAPA(MF,A0,A1,A2,A3,W0,W1,PW) do{ MF; sacc+=A0; sacc+=A1; sacc+=A2; sacc+=A3; PIN(sacc); W0; W1; PIN(PW); SBAR(); }while(0)
  #define EX(v) __builtin_amdgcn_exp2f(v)
  #define GAPB(MF,X,B) do{ MF; X[B]=EX(X[B]); X[B+1]=EX(X[B+1]); X[B+2]=EX(X[B+2]); X[B+3]=EX(X[B+3]); PIN(X); SBAR(); }while(0)
  #define VRD(i) do{ vlo[i]=vtr(vp_+(((i)>>2)*4096+((i)&3)*1024)); vhi[i]=vtr(vp_+(((i)>>2)*4096+((i)&3)*1024+512)); }while(0)
  #define KRD(G,j) do{ if(G){ kload2(kf,kp0+sl_next,j); SBAR(); } }while(0)
  #define STEP(C0,C1,P0,P1,t,GK,GV,GL) do{ SBAR(); \
    const lds_cptr vp_=vp0+sl_prev; \
    VRD(0); SBAR(); float sacc=(P0[0]+P0[1]); \
    GAPA(C0=__builtin_amdgcn_mfma_f32_32x32x16_bf16(kf[0],qr[0],negm,0,0,0), P0[2],P0[3],P0[4],P0[5],     pw0[0]=PKW(P0,0), pw0[1]=PKW(P0,2), pw0); \
    VRD(4); SBAR(); GAPA(C1=__builtin_amdgcn_mfma_f32_32x32x16_bf16(kf[1],qr[0],negm,0,0,0), P0[6],P0[7],P0[8],P0[9],     pw0[2]=PKW(P0,4), pw0[3]=PKW(P0,6), pw0); \
    VRD(1); SBAR(); GAPA(C0=__builtin_amdgcn_mfma_f32_32x32x16_bf16(kf[2],qr[1],C0,0,0,0),   P0[10],P0[11],P0[12],P0[13], pw1[0]=PKW(P0,8), pw1[1]=PKW(P0,10), pw1); \
    VRD(5); SBAR(); GAPA(C1=__builtin_amdgcn_mfma_f32_32x32x16_bf16(kf[3],qr[1],C1,0,0,0),   P0[14],P0[15],P1[0],P1[1],   pw1[2]=PKW(P0,12),pw1[3]=PKW(P0,14), pw1); \
    VRD(2); SBAR(); GAPA(C0=__builtin_amdgcn_mfma_f32_32x32x16_bf16(kf[4],qr[2],C0,0,0,0),   P1[2],P1[3],P1[4],P1[5],     pw2[0]=PKW(P1,0), pw2[1]=PKW(P1,2), pw2); \
    VRD(6); SBAR(); GAPA(C1=__builtin_amdgcn_mfma_f32_32x32x16_bf16(kf[5],qr[2],C1,0,0,0),   P1[6],P1[7],P1[8],P1[9],     pw2[2]=PKW(P1,4), pw2[3]=PKW(P1,6), pw2); \
    VRD(3); SBAR(); GAPA(C0=__builtin_amdgcn_mfma_f32_32x32x16_bf16(kf[6],qr[3],C0,0,0,0),   P1[10],P1[11],P1[12],P1[13], pw3[0]=PKW(P1,8), pw3[1]=PKW(P1,10), pw3); \
    VRD(7); SBAR(); GAPA(C1=__builtin_amdgcn_mfma_f32_32x32x16_bf16(kf[7],qr[3],C1,0,0,0),   P1[14],P1[15],0.f,0.f,       pw3[2]=PKW(P1,12),pw3[3]=PKW(P1,14), pw3); \
    l_reg+=sacc; \
    if(GK){DMA_K((t)+3,sl_cur);} if(GV){DMA_V((t)+1,sl_next);} \
    CMASK(C0,C1,t); \
    { float a=MX3(C0[0],C0[1],C1[0]),b=MX3(C0[2],C0[3],C1[1]); a=MX3(a,C1[2],C1[3]); \
      _Pragma("unroll") for(int r=4;r<16;r+=4){a=MX3(a,C0[r],C0[r+1]);b=MX3(b,C0[r+2],C0[r+3]);a=MX3(a,C1[r],C1[r+1]);b=MX3(b,C1[r+2],C1[r+3]);} \
      float rm=__builtin_fmaxf(a,b); { auto rr=__builtin_amdgcn_permlane32_swap(__float_as_uint(rm),__float_as_uint(rm),false,false); rm=__builtin_fmaxf(__uint_as_float(rr[0]),__uint_as_float(rr[1])); } \
      resc=false; \
      if(__builtin_expect(__any(rm>(float)THRL),0)){ const float dl=__builtin_fmaxf(rm,0.f); mhat+=dl; \
        _Pragma("unroll") for(int r=0;r<16;++r){C0[r]-=dl;C1[r]-=dl;} \
        _Pragma("unroll") for(int r=0;r<16;++r)negm[r]=-mhat; asm volatile("":"+v"(negm)); \
        const float f=__builtin_amdgcn_exp2f(-dl); l_reg*=f; if(hi==0)wsf[r32]=f; resc=true; } } \
    SBAR(); \
    GAPB(o[0]=__builtin_amdgcn_mfma_f32_32x32x16_bf16(PAF(0),VFR(0),o[0],0,0,0), C0,0); \
    GAPB(o[1]=__builtin_amdgcn_mfma_f32_32x32x16_bf16(PAF(0),VFR(4),o[1],0,0,0), C0,4); \
    KRD(GL,0); GAPB(o[0]=__builtin_amdgcn_mfma_f32_32x32x16_bf16(PAF(1),VFR(1),o[0],0,0,0), C0,8); \
    KRD(GL,1); GAPB(o[1]=__builtin_amdgcn_mfma_f32_32x32x16_bf16(PAF(1),VFR(5),o[1],0,0,0), C0,12); \
    KRD(GL,2); GAPB(o[0]=__builtin_amdgcn_mfma_f32_32x32x16_bf16(PAF(2),VFR(2),o[0],0,0,0), C1,0); \
    KRD(GL,3); GAPB(o[1]=__builtin_amdgcn_mfma_f32_32x32x16_bf16(PAF(2),VFR(6),o[1],0,0,0), C1,4); \
    GAPB(o[0]=__builtin_amdgcn_mfma_f32_32x32x16_bf16(PAF(3),VFR(3),o[0],0,0,0), C1,8); \
    GAPB(o[1]=__builtin_amdgcn_mfma_f32_32x32x16_bf16(PAF(3),VFR(7),o[1],0,0,0), C1,12); \
    }while(0)
  int t=1;
  #undef CMASK
  #define CMASK(P0,P1,t) do{}while(0)
  for(;t+5<NT;t+=2){
    STEP(pB0,pB1,pA0,pA1,t,true,true,true);     WAIT_BAR(2); RESC(); ROT();
    STEP(pA0,pA1,pB0,pB1,t+1,true,true,true);   WAIT_BAR(2); RESC(); ROT();
  }
  #undef CMASK
  #define CMASK(P0,P1,t) do{int jb_=(t)-(NT-4); if(jb_>=0)cmask(P0,P1,jb_,qrel,hi);}while(0)
  #define ENDW(tt) do{ if((tt)+3<NT){WAIT_BAR(2);} else if((tt)+2<NT){WAIT_BAR(1);} else {WAIT_BAR(0);} }while(0)
  for(;t+1<NT;t+=2){
    STEP(pB0,pB1,pA0,pA1,t,(t+3<NT),(t+1<NT),(t+1<NT));       ENDW(t);   RESC(); ROT();
    STEP(pA0,pA1,pB0,pB1,t+1,(t+4<NT),(t+2<NT),(t+2<NT));     ENDW(t+1); RESC(); ROT();
  }
  STEP(pB0,pB1,pA0,pA1,NT-1,false,false,false); RESC();
  { float sacc=pB0[0]+pB0[1]; _Pragma("unroll") for(int r=2;r<16;++r)sacc+=pB0[r]; _Pragma("unroll") for(int r=0;r<16;++r)sacc+=pB1[r]; l_reg+=sacc;
    pw0=(u32x4){PKW(pB0,0),PKW(pB0,2),PKW(pB0,4),PKW(pB0,6)};pw1=(u32x4){PKW(pB0,8),PKW(pB0,10),PKW(pB0,12),PKW(pB0,14)};pw2=(u32x4){PKW(pB1,0),PKW(pB1,2),PKW(pB1,4),PKW(pB1,6)};pw3=(u32x4){PKW(pB1,8),PKW(pB1,10),PKW(pB1,12),PKW(pB1,14)};
    SBAR(); pv(o,vb0+sl_cur,PAF(0),PAF(1),PAF(2),PAF(3)); }
  #undef PKW
  #undef PAF
  #undef VFR
  #undef PIN
  #undef MX3
  #undef GAPA
  #undef GAPB
  #undef EX
  #undef VRD
  #undef KRD
  #undef STEP
  #undef ENDW
  {auto rr=__builtin_amdgcn_permlane32_swap(__float_as_uint(l_reg),__float_as_uint(l_reg),false,false);l_reg=__uint_as_float(rr[0])+__uint_as_float(rr[1]);}
  if(hi==0)wsf[32+r32]=l_reg;asm volatile("s_waitcnt lgkmcnt(0)":::"memory");
  float rli[16];
  #pragma unroll
  for(int r=0;r<16;++r)rli[r]=__builtin_amdgcn_rcpf(wsf[32+crow(r,hi)]);
  bf16*Ow=O+(rowbase+q0+wid*QBLK)*DM+hv*D;
  { bf16*stg=(bf16*)(shm+LDS_OST)+wid*2048;
    #pragma unroll
    for(int r=0;r<16;++r){const int orow=crow(r,hi);
      #pragma unroll
      for(int d0=0;d0<2;++d0)stg[orow*64+d0*32+r32]=__float2bfloat16(o[d0][r]*rli[r]);}
    asm volatile("s_waitcnt lgkmcnt(0)":::"memory");
    #pragma unroll
    for(int i=0;i<4;++i){const int row=i*8+(lane>>3),ch=lane&7; const u32x4 v=*(const u32x4*)(stg+row*64+ch*8); bf16*p=Ow+(long)row*DM+ch*8;
      if(mode==0){ *(u32x4*)p=v; }
      else{ const u32x4 pv=*(const u32x4*)p; float d[8];
        #pragma unroll
        for(int j=0;j<4;++j){ d[2*j]=__uint_as_float(pv[j]<<16)-lam*__uint_as_float(v[j]<<16); d[2*j+1]=__uint_as_float(pv[j]&0xffff0000u)-lam*__uint_as_float(v[j]&0xffff0000u); }
        if(mode==1){ u32x4 w;
          #pragma unroll
          for(int j=0;j<4;++j)w[j]=cvtpk_s(d[2*j],d[2*j+1]);
          *(u32x4*)p=w; }
        else{ const u32x4 av=*(const u32x4*)(p-64); float da[8]; float ss=0.f;
          #pragma unroll
          for(int j=0;j<4;++j){ da[2*j]=__uint_as_float(av[j]<<16); da[2*j+1]=__uint_as_float(av[j]&0xffff0000u); }
          #pragma unroll
          for(int j=0;j<8;++j)ss+=da[j]*da[j]+d[j]*d[j];
          ss+=pg8::swz_xor<1>(ss); ss+=pg8::swz_xor<2>(ss); ss+=pg8::swz_xor<4>(ss);
          const float rs=rsqrtf(ss*(1.f/128.f)+1e-6f)*0.8f;
          u32x4 wa,wb;
          #pragma unroll
          for(int j=0;j<4;++j){ wa[j]=cvtpk_s(da[2*j]*rs*subg[ch*8+2*j],da[2*j+1]*rs*subg[ch*8+2*j+1]); wb[j]=cvtpk_s(d[2*j]*rs*subg[64+ch*8+2*j],d[2*j+1]*rs*subg[64+ch*8+2*j+1]); }
          *(u32x4*)(p-64)=wa; *(u32x4*)p=wb; } } } }

  asm volatile("s_waitcnt lgkmcnt(0)\n\ts_barrier":::"memory");
  #undef DMA_K
  #undef DMA_V
  #undef CMASK
  #undef START
  #undef RESC
  #undef ROT
}
constexpr int ATTN_LDS_BYTES=LDS_BYTES;
template<int THRL=8> __device__ __forceinline__ void attn_phase(char*lds,const bf16*Q,const bf16*K,const bf16*V,bf16*O,int vcu,int G,float lam,const float*subg){
  for(int w=vcu;w<1024;w+=G){ const int bh=w>>2,s=w&3,b=bh>>3,h=bh&7;
    for(int i=0;i<2;++i){ const int qb=(i==0)?s:7-s;
      for(int su=0;su<4;++su){ const int c=su&1,half=su>>1; const int mode=(c==0)?0:(half==0?1:2);
        attn_unit<THRL>(b,2*h+c,2*h+half,qb,mode,lam,subg,Q,K,V,O,lds); } } }
}
#undef SBAR
#undef WAIT_BAR
}
constexpr int NWAVES = 8;
constexpr int BATCH = 32, SEQ = 2048, D = 1024, M = BATCH * SEQ, DIN = 8192, DFF = 2816, NGU = 2 * DFF, NMOD = 6 * D;
constexpr size_t MiB = 1u << 20;
constexpr size_t WS_S0 = 0, WS_S1 = 128 * MiB, WS_S2 = 256 * MiB, WS_S3 = 384 * MiB, WS_S4 = 512 * MiB, WS_S5 = 640 * MiB;
constexpr size_t WS_WIN = 768 * MiB, WS_WA = WS_WIN + 16 * MiB, WS_WB = WS_WA + 2 * MiB, WS_WO = WS_WB + 2 * MiB, WS_WGU = WS_WO + 2 * MiB, WS_WDN = WS_WGU + 11 * MiB, WS_MOD = WS_WDN + 6 * MiB, WS_CTL = WS_MOD + 1 * MiB, WS_END = WS_CTL + 1 * MiB;
constexpr int RING_BYTES = 131072, LDS_BYTES = 147456;
#define LAS __attribute__((address_space(3)))
typedef unsigned short bf16;
typedef unsigned v4u __attribute__((ext_vector_type(4)));
typedef unsigned v2u __attribute__((ext_vector_type(2)));
typedef float f32x4 __attribute__((ext_vector_type(4)));
__device__ __forceinline__ unsigned pk2(float lo, float hi) { return pg8::cvt_pk_bf16(lo, hi); }
__device__ __forceinline__ float wave_sum(float v) { return pg8::wave_sum64(v); }
__device__ __forceinline__ void transpose_item(const float* W, int K, int N, int src_col0, bf16* WT, int dst_row0, int k0, LAS float* scr, int lane) {
#pragma unroll 8
    for (int i = 0; i < 32; ++i) { const int kk = 2 * i + (lane >> 5); scr[kk * 33 + (lane & 31)] = W[(size_t)(k0 + kk) * N + src_col0 + (lane & 31)]; }
    asm volatile("s_waitcnt lgkmcnt(0)" ::: "memory");
    const int c = lane & 7;
#pragma unroll
    for (int j = 0; j < 4; ++j) { const int n = (lane >> 3) + 8 * j; const LAS float* s = scr + (8 * c) * 33 + n;
        v4u o; o.x = pk2(s[0 * 33], s[1 * 33]); o.y = pk2(s[2 * 33], s[3 * 33]); o.z = pk2(s[4 * 33], s[5 * 33]); o.w = pk2(s[6 * 33], s[7 * 33]);
        *(v4u*)(WT + (size_t)(dst_row0 + n) * K + k0 + 8 * c) = o; }
    asm volatile("s_waitcnt lgkmcnt(0)" ::: "memory");
}
__device__ __forceinline__ int win_src(int n0) {
    if (n0 < 1024) return 3072 + n0;
    if (n0 < 3072) { const int p = (n0 - 1024) >> 8, s = n0 & 255; return s < 128 ? 4096 + 128 * p + s : 5120 + 128 * p + (s - 128); }
    if (n0 < 4096) return 6144 + (n0 - 3072);
    if (n0 < 6144) { const int m = n0 - 4096, pn = m >> 8, s = m & 255, bj = s >> 7, wc = (s & 127) >> 5; return pn * 256 + 64 * wc + 32 * bj; }
    if (n0 < 7168) return 2048 + (n0 - 6144);
    return n0;
}
__device__ __forceinline__ int wgu_src(int n0) { const int p = n0 >> 8, s = n0 & 255; return s < 128 ? 128 * p + s : DFF + 128 * p + (s - 128); }

__device__ __forceinline__ void norm_rows(const float* X, const float* g, const float* modsh, const float* modsc, bf16* H, int rb, int lane) {
    const size_t row0 = (size_t)rb * 32; const int b = (int)(row0 >> 11);
    f32x4 av[4], sv[4];
#pragma unroll
    for (int j = 0; j < 4; ++j) { const int idx = 4 * lane + 256 * j; const f32x4 gg = *(const f32x4*)(g + idx), sc = *(const f32x4*)(modsc + (size_t)b * NMOD + idx); av[j] = gg * (sc + 1.0f); sv[j] = *(const f32x4*)(modsh + (size_t)b * NMOD + idx); }
#pragma unroll 2
    for (int r = 0; r < 32; ++r) {
        const f32x4* xr = (const f32x4*)(X + (row0 + r) * D) + lane;
        f32x4 v[4]; float s = 0.f;
#pragma unroll
        for (int j = 0; j < 4; ++j) { v[j] = xr[64 * j]; s += (v[j].x * v[j].x + v[j].y * v[j].y) + (v[j].z * v[j].z + v[j].w * v[j].w); }
        const float rstd = rsqrtf(wave_sum(s) * (1.f / D) + 1e-6f);
        v2u* o8 = (v2u*)(H + (row0 + r) * D) + lane;
#pragma unroll
        for (int j = 0; j < 4; ++j) { const f32x4 y = v[j] * rstd * av[j] + sv[j]; v2u w; w.x = pk2(y.x, y.y); w.y = pk2(y.z, y.w); o8[64 * j] = w; }
    }
}

struct Args { const float* in[20]; float* out; unsigned char* ws; };
__global__ void __launch_bounds__(NWAVES * 64, 2) fwd_megakernel(Args args) {
    extern __shared__ __attribute__((aligned(16))) unsigned char lds[];
    cg::grid_group grid = cg::this_grid();
    const int G = gridDim.x, bx = blockIdx.x, vcu = (G % 8 == 0) ? (bx % 8) * (G / 8) + bx / 8 : bx;
    const int NGW = G * NWAVES;
#define GRID_SYNC() do { asm volatile("s_waitcnt vmcnt(0) lgkmcnt(0)" ::: "memory"); __syncthreads(); \
    if (threadIdx.x == 0) { __builtin_amdgcn_fence(__ATOMIC_RELEASE, "agent"); asm volatile("s_waitcnt vmcnt(0)" ::: "memory"); \
        __hip_atomic_fetch_add(barw, 1u, __ATOMIC_RELAXED, __HIP_MEMORY_SCOPE_AGENT); ++nbar; const unsigned want = nbar * (unsigned)G; \
        while (__hip_atomic_load(barw, __ATOMIC_RELAXED, __HIP_MEMORY_SCOPE_AGENT) < want) __builtin_amdgcn_s_sleep(2); } \
    __syncthreads(); __builtin_amdgcn_fence(__ATOMIC_ACQUIRE, "agent"); asm volatile("s_waitcnt vmcnt(0)" ::: "memory"); __syncthreads(); } while (0)
#define PHASE_IDS() int tid = threadIdx.x; asm volatile("" : "+v"(tid)); const int lane = tid & 63, wave = __builtin_amdgcn_readfirstlane(tid >> 6), gw = vcu * NWAVES + wave; (void)lane; (void)gw
    unsigned char* ws = args.ws;
    const float* x = args.in[0];
    bf16* S0 = (bf16*)(ws + WS_S0); bf16* S1 = (bf16*)(ws + WS_S1); bf16* S2 = (bf16*)(ws + WS_S2); bf16* S3 = (bf16*)(ws + WS_S3); bf16* S4 = (bf16*)(ws + WS_S4); bf16* S5 = (bf16*)(ws + WS_S5);
    bf16* WIN = (bf16*)(ws + WS_WIN); bf16* WA = (bf16*)(ws + WS_WA); bf16* WB = (bf16*)(ws + WS_WB); bf16* WO = (bf16*)(ws + WS_WO); bf16* WGU = (bf16*)(ws + WS_WGU); bf16* WDN = (bf16*)(ws + WS_WDN);
    float* mod = (float*)(ws + WS_MOD);
    float* X1 = (float*)(ws + WS_S1);
    LAS unsigned char* ldsl = (LAS unsigned char*)lds;
    unsigned* barw = (unsigned*)(ws + WS_CTL); unsigned nbar = 0;
    grid.sync();

    if (bx < 96) {
        PHASE_IDS();
        LAS float* cact = (LAS float*)ldsl;
        const float* c = args.in[1];
        for (int i = tid; i < BATCH * D; i += NWAVES * 64) { const int b = i >> 10, k = i & 1023; const float cv = c[i]; cact[k * 32 + b] = cv / (1.f + __expf(-cv)); }
        __syncthreads();
        const float* wada = args.in[2]; const int col = bx * 64 + lane, k0 = wave * 128;
        float acc[32];
#pragma unroll
        for (int b = 0; b < 32; ++b) acc[b] = 0.f;
#pragma unroll 4
        for (int kk = 0; kk < 128; ++kk) { const float w = wada[(size_t)(k0 + kk) * NMOD + col]; const LAS f32x4* cp = (const LAS f32x4*)(cact + (k0 + kk) * 32);
#pragma unroll
            for (int j = 0; j < 8; ++j) { const f32x4 cv = cp[j]; acc[4 * j] += w * cv.x; acc[4 * j + 1] += w * cv.y; acc[4 * j + 2] += w * cv.z; acc[4 * j + 3] += w * cv.w; } }
        __syncthreads();
        LAS float* part = (LAS float*)ldsl;
#pragma unroll
        for (int b = 0; b < 32; ++b) part[(wave * 32 + b) * 64 + lane] = acc[b];
        __syncthreads();
        const float* bada = args.in[3];
        for (int o = tid; o < 2048; o += NWAVES * 64) { const int b = o >> 6, cl = o & 63; float s = 0.f;
#pragma unroll
            for (int w = 0; w < 8; ++w) s += part[(w * 32 + b) * 64 + cl];
            mod[(size_t)b * NMOD + bx * 64 + cl] = s + bada[bx * 64 + cl]; }
        __syncthreads();
    }
    {
        PHASE_IDS();
        LAS float* scr = (LAS float*)(ldsl + wave * 16384);
        constexpr int I_IN = 16 * 256, I_SQ = 16 * 32, I_GU = 16 * 176, I_DN = 44 * 32, NITEMS = I_IN + 3 * I_SQ + I_GU + I_DN;
        for (int it = gw; it < NITEMS; it += NGW) {
            int r = it;
            if (r < I_IN) { const int kb = r >> 8, nb = r & 255; transpose_item(args.in[5], D, DIN, win_src(32 * nb), WIN, 32 * nb, 64 * kb, scr, lane); continue; } r -= I_IN;
            if (r < I_SQ) { const int kb = r >> 5, nb = r & 31; transpose_item(args.in[14], D, D, 32 * nb, WA, 32 * nb, 64 * kb, scr, lane); continue; } r -= I_SQ;
            if (r < I_SQ) { const int kb = r >> 5, nb = r & 31; transpose_item(args.in[15], D, D, 32 * nb, WB, 32 * nb, 64 * kb, scr, lane); continue; } r -= I_SQ;
            if (r < I_SQ) { const int kb = r >> 5, nb = r & 31; transpose_item(args.in[16], D, D, 32 * nb, WO, 32 * nb, 64 * kb, scr, lane); continue; } r -= I_SQ;
            if (r < I_GU) { const int kb = r / 176, nb = r % 176; transpose_item(args.in[18], D, NGU, wgu_src(32 * nb), WGU, 32 * nb, 64 * kb, scr, lane); continue; } r -= I_GU;
            { const int kb = r >> 5, nb = r & 31; transpose_item(args.in[19], DFF, D, 32 * nb, WDN, 32 * nb, 64 * kb, scr, lane); }
        }
    }
    GRID_SYNC();
    { PHASE_IDS(); for (int rb = gw; rb < M / 32; rb += NGW) norm_rows(x, args.in[4], mod, mod + D, S0, rb, lane); }
    GRID_SYNC();

    pg8::StaticOrder SO; pg8::Gemm g; pg8::EpiAll E{};
    g = pg8::Gemm{S0, WIN, M, 4096, D}; SO.init(M, 4096, G, bx);
    E.mode = 5; E.o3 = S1; E.o4 = S2; E.o5 = S3;
    pg8::gemm_phase<pg8::EpiAll, pg8::StaticOrder, true, true>(ldsl, g, SO, E);
    GRID_SYNC();
    {
        PHASE_IDS();
        const float* cw = args.in[6]; const int NT = G * NWAVES * 64, gt = vcu * (NWAVES * 64) + tid;
        for (int it = gt; it < (M / 16) * 128; it += NT) {
            const int cgp = it & 127, rbk = it >> 7; const size_t t0 = (size_t)rbk * 16; const int c0 = cgp * 8;
            f32x4 w0a = *(const f32x4*)(cw + c0), w0b = *(const f32x4*)(cw + c0 + 4), w1a = *(const f32x4*)(cw + D + c0), w1b = *(const f32x4*)(cw + D + c0 + 4), w2a = *(const f32x4*)(cw + 2 * D + c0), w2b = *(const f32x4*)(cw + 2 * D + c0 + 4);
            f32x4 p2a = {0.f, 0.f, 0.f, 0.f}, p2b = p2a, p1a = p2a, p1b = p2a;
            if ((t0 & (SEQ - 1)) != 0) { pg8::unpack8(*(const v4u*)(S2 + (t0 - 2) * D + c0), p2a, p2b); pg8::unpack8(*(const v4u*)(S2 + (t0 - 1) * D + c0), p1a, p1b); }
#pragma unroll 4
            for (int r = 0; r < 16; ++r) { f32x4 ua, ub, ba, bb; pg8::unpack8(*(const v4u*)(S2 + (t0 + r) * D + c0), ua, ub); pg8::unpack8(*(const v4u*)(S1 + (t0 + r) * D + c0), ba, bb);
                const f32x4 ya = ba * (w0a * p2a + w1a * p1a + w2a * ua), yb = bb * (w0b * p2b + w1b * p1b + w2b * ub);
                *(v4u*)(S1 + (t0 + r) * D + c0) = pg8::pack8(ya, yb); p2a = p1a; p2b = p1b; p1a = ua; p1b = ub; }
        }
    }
    GRID_SYNC();
    SO.init(M, D, G, bx);
    g = pg8::Gemm{S1, WA, M, D, D}; E.mode = 1; E.o0 = S3; E.o1 = S3;
    pg8::gemm_phase<pg8::EpiAll, pg8::StaticOrder, true, true>(ldsl, g, SO, E);
    GRID_SYNC();
    g = pg8::Gemm{S0, WIN + (size_t)4096 * D, M, 4096, D}; SO.init(M, 4096, G, bx);
    E.mode = 0; E.o0 = S1; E.o1 = S2; E.o2 = S4; E.o6 = S5; E.f0 = args.in[7]; E.f1 = args.in[8];
    pg8::gemm_phase<pg8::EpiAll, pg8::StaticOrder, true, true>(ldsl, g, SO, E);
    GRID_SYNC();
    {
        PHASE_IDS();
        float l1 = args.in[9][lane] * args.in[10][lane], l2 = args.in[11][lane] * args.in[12][lane];
        l1 = wave_sum(l1); l2 = wave_sum(l2);
        const float lam = __uint_as_float(__builtin_amdgcn_readfirstlane(__float_as_uint(__expf(l1) - __expf(l2) + 0.2f)));
        attn_body::attn_phase<8>((char*)lds, (const attn_body::bf16*)S1, (const attn_body::bf16*)S2, (const attn_body::bf16*)S4, (attn_body::bf16*)S0, vcu, G, lam, args.in[13]);
    }
    GRID_SYNC();
    SO.init(M, D, G, bx);
    g = pg8::Gemm{S0, WB, M, D, D}; E.mode = 2; E.o0 = S3; E.o1 = S5;
    pg8::gemm_phase<pg8::EpiAll, pg8::StaticOrder, true, true>(ldsl, g, SO, E);
    GRID_SYNC();
#ifdef EXP_NOFFN
    g = pg8::Gemm{S3, WO, M, D, D}; E.mode = 3; E.f0 = x; E.f1 = mod + 2 * D; E.fo = args.out;
    pg8::gemm_phase<pg8::EpiAll, pg8::StaticOrder, true, true>(ldsl, g, SO, E);
    return;
#endif
    g = pg8::Gemm{S3, WO, M, D, D}; E.mode = 3; E.f0 = x; E.f1 = mod + 2 * D; E.fo = X1;
    pg8::gemm_phase<pg8::EpiAll, pg8::StaticOrder, true, true>(ldsl, g, SO, E);
    GRID_SYNC();
    { PHASE_IDS(); for (int rb = gw; rb < M / 32; rb += NGW) norm_rows(X1, args.in[17], mod + 3 * D, mod + 4 * D, S0, rb, lane); }
    GRID_SYNC();
    g = pg8::Gemm{S0, WGU, M, NGU, D}; SO.init(M, NGU, G, bx); E.mode = 4; E.o0 = S3;
    pg8::gemm_phase<pg8::EpiAll, pg8::StaticOrder, true, true>(ldsl, g, SO, E);
    GRID_SYNC();
    g = pg8::Gemm{S3, WDN, M, D, DFF}; SO.init(M, D, G, bx); E.mode = 3; E.f0 = X1; E.f1 = mod + 5 * D; E.fo = args.out;
    pg8::gemm_phase<pg8::EpiAll, pg8::StaticOrder, true, true>(ldsl, g, SO, E);
}

extern "C" void kernel_launch(void* const* d_in, const int* in_sizes, int n_in, void* d_out, int out_size, void* d_ws, size_t ws_size, hipStream_t stream) {
    static int grid = 0;
    if (grid == 0) {
        if (n_in != 20 || in_sizes[0] != M * D || out_size != M * D || ws_size < WS_END) { fprintf(stderr, "kernel_launch: unexpected shapes (n_in %d, in0 %d, out %d, ws %zu)\n", n_in, n_in > 0 ? in_sizes[0] : -1, out_size, ws_size); grid = -1; return; }
        int dev = 0, cus = 0, per_cu = 0;
        (void)hipGetDevice(&dev); (void)hipDeviceGetAttribute(&cus, hipDeviceAttributeMultiprocessorCount, dev);
        (void)hipFuncSetAttribute((const void*)fwd_megakernel, hipFuncAttributeMaxDynamicSharedMemorySize, LDS_BYTES);
        if (hipOccupancyMaxActiveBlocksPerMultiprocessor(&per_cu, (const void*)fwd_megakernel, NWAVES * 64, LDS_BYTES) != hipSuccess || per_cu < 1) per_cu = 1;
        (void)hipGetLastError();
        grid = cus * per_cu;
    }
    if (grid < 0) return;
    (void)hipMemsetAsync((unsigned char*)d_ws + WS_CTL, 0, 4096, stream);
    Args a{};
    for (int i = 0; i < 20; ++i) a.in[i] = (const float*)d_in[i];
    a.out = (float*)d_out; a.ws = (unsigned char*)d_ws;
    void* kargs[] = {&a};
    hipError_t e = hipLaunchCooperativeKernel((const void*)fwd_megakernel, dim3(grid), dim3(NWAVES * 64), kargs, LDS_BYTES, stream);
    if (e != hipSuccess) fprintf(stderr, "cooperative launch failed: %s (grid %d)\n", hipGetErrorString(e), grid);
}
```

```cpp
#include <hip/hip_runtime.h>
#include <hip/hip_cooperative_groups.h>
#include <hip/hip_bf16.h>
#include <cstdio>
#include <cstdint>
#include <cmath>
namespace cg = cooperative_groups;
namespace pg8 {
#define PG8_LAS __attribute__((address_space(3)))
typedef unsigned short bf16_t;
typedef short bf16x8 __attribute__((ext_vector_type(8)));
typedef float f32x4 __attribute__((ext_vector_type(4)));
typedef unsigned u32x4 __attribute__((ext_vector_type(4)));
constexpr int BM = 256, BK = 64, HALF = 128, HTB = HALF * BK * 2  , STAGE_BYTES = 8 * HTB, NXCD = 8, WGM = 8;

__host__ __device__ __forceinline__ int lds_byte(int r, int c) { const int st = (r >> 4) * 2 + (c >> 5), rr = r & 15, cc = c & 31, ob = rr * 64 + cc * 2; return st * 1024 + (ob ^ (((ob >> 9) & 1) << 5)); }
__host__ __device__ __forceinline__ void stage_rc(int b, int& R, int& C) { const int st = b / 1024, sb = b % 1024, swz = sb ^ (((sb >> 9) & 1) << 5); R = (st >> 1) * 16 + swz / 64; C = (st & 1) * 32 + (swz % 64) / 2; }
__host__ __device__ __forceinline__ int perm32(int rho) { const int n = rho >> 4, i = rho & 15; return 8 * (i >> 2) + 4 * n + (i & 3); }

struct Unit { int pm, pn; };
struct Gemm { const bf16_t* A; const bf16_t* Bt; int M, N, K; };

struct StaticOrder {
    int nM, nN, nwg, G, c;
    __host__ __device__ void init(int M, int N, int G_, int c_) { nM = M / BM; nN = N / BM; nwg = nM * nN; G = G_; c = c_; }
    __host__ __device__ bool next(int i, Unit& u) const {
        const long L = (long)i * G + c; if (L >= nwg) return false;
        int wgid = (int)L; { const int q = nwg / NXCD, r = nwg % NXCD, xcd = wgid % NXCD, off = wgid / NXCD; wgid = (xcd < r ? xcd * (q + 1) : r * (q + 1) + (xcd - r) * q) + off; }
        const int nig = WGM * nN, gid = wgid / nig, fm = gid * WGM, gsz = (nM - fm) < WGM ? (nM - fm) : WGM;
        u.pm = fm + ((wgid % nig) % gsz); u.pn = (wgid % nig) / gsz; return true;
    }
    __device__ __forceinline__ void a_ready(const Unit&) const {}
    __device__ __forceinline__ void done(const Unit&) const {}
};
typedef float f32x2 __attribute__((ext_vector_type(2))); typedef __bf16 bf16x2_t __attribute__((ext_vector_type(2)));
__device__ __forceinline__ unsigned cvt_pk_bf16(float lo, float hi) { f32x2 v = {lo, hi}; bf16x2_t b = __builtin_convertvector(v, bf16x2_t); return __builtin_bit_cast(unsigned, b); }
constexpr float EPSF = 1e-6f;
constexpr float QC2 = 0.125f * 1.4426950408889634f;
__device__ __forceinline__ u32x4 pack8(const f32x4 a, const f32x4 b) { u32x4 w; w.x = cvt_pk_bf16(a[0], a[1]); w.y = cvt_pk_bf16(a[2], a[3]); w.z = cvt_pk_bf16(b[0], b[1]); w.w = cvt_pk_bf16(b[2], b[3]); return w; }
__device__ __forceinline__ float bf_lo(unsigned u) { return __uint_as_float(u << 16); }
__device__ __forceinline__ float bf_hi(unsigned u) { return __uint_as_float(u & 0xffff0000u); }
__device__ __forceinline__ void unpack8(const u32x4 w, f32x4& a, f32x4& b) { a = (f32x4){bf_lo(w.x), bf_hi(w.x), bf_lo(w.y), bf_hi(w.y)}; b = (f32x4){bf_lo(w.z), bf_hi(w.z), bf_lo(w.w), bf_hi(w.w)}; }
template <int X> __device__ __forceinline__ float swz_xor(float v) { return __uint_as_float((unsigned)__builtin_amdgcn_ds_swizzle((int)__float_as_uint(v), (X << 10) | 0x1f)); }
__device__ __forceinline__ float wave_sum64(float v) { v += swz_xor<1>(v); v += swz_xor<2>(v); v += swz_xor<4>(v); v += swz_xor<8>(v); v += swz_xor<16>(v);
    auto rr = __builtin_amdgcn_permlane32_swap(__float_as_uint(v), __float_as_uint(v), false, false); return __uint_as_float(rr[0]) + __uint_as_float(rr[1]); }
__device__ __forceinline__ float sigm(float x) { return __builtin_amdgcn_rcpf(1.f + __builtin_amdgcn_exp2f(-1.4426950408889634f * x)); }
#ifdef EXP_NOSIG
__device__ __forceinline__ f32x4 sigm4(const f32x4 v) { return v * 0.25f + 0.5f; }
#else
__device__ __forceinline__ f32x4 sigm4(const f32x4 v) { return (f32x4){sigm(v[0]), sigm(v[1]), sigm(v[2]), sigm(v[3])}; }
#endif

struct EpiAll {
    static constexpr bool PERM = true, AFTER_DRAIN = false;
    int mode; bf16_t *o0, *o1, *o2, *o3, *o4, *o5, *o6; const float *f0, *f1; float* fo;
    __device__ __forceinline__ void operator()(const f32x4 (&acc)[2][2][4][2], const Unit& un, int wr, int wc, int fr, int fq) const {
        const int pn = un.pn; const size_t row0 = (size_t)un.pm * BM + wr * 64 + fr;
        if (mode == 0) {
            if (pn < 8) {
                const bool isq = pn < 4; bf16_t* base = isq ? o0 : o1; const float* g = isq ? f0 : f1; const float sc = isq ? QC2 : 1.f;
                f32x4 gv[2][2];
#pragma unroll
                for (int bj = 0; bj < 2; ++bj)
#pragma unroll
                    for (int n = 0; n < 2; ++n) gv[bj][n] = *(const f32x4*)(g + 32 * bj + 8 * fq + 4 * n) * sc;
                const int col0 = (pn & 3) * 256 + 64 * wc + 8 * fq;
#pragma unroll
                for (int ai = 0; ai < 2; ++ai)
#pragma unroll
                    for (int m = 0; m < 4; ++m) {
                        float ss = 0.f;
#pragma unroll
                        for (int bj = 0; bj < 2; ++bj)
#pragma unroll
                            for (int n = 0; n < 2; ++n) { const f32x4 x = acc[ai][bj][m][n]; ss += (x[0] * x[0] + x[1] * x[1]) + (x[2] * x[2] + x[3] * x[3]); }
                        ss += swz_xor<16>(ss); { auto rr = __builtin_amdgcn_permlane32_swap(__float_as_uint(ss), __float_as_uint(ss), false, false); ss = __uint_as_float(rr[0]) + __uint_as_float(rr[1]); }
                        const float rs = rsqrtf(ss * (1.f / 64.f) + EPSF);
                        bf16_t* rowp = base + (row0 + ai * HALF + m * 16) * 1024 + col0;
#pragma unroll
                        for (int bj = 0; bj < 2; ++bj) *(u32x4*)(rowp + 32 * bj) = pack8(acc[ai][bj][m][0] * rs * gv[bj][0], acc[ai][bj][m][1] * rs * gv[bj][1]);
                    }
            } else if (pn < 12) {
                const int col0 = (pn & 3) * 256 + wc * 32 + 8 * fq;
#pragma unroll
                for (int ai = 0; ai < 2; ++ai)
#pragma unroll
                    for (int m = 0; m < 4; ++m) { bf16_t* rowp = o2 + (row0 + ai * HALF + m * 16) * 1024 + col0;
#pragma unroll
                        for (int bj = 0; bj < 2; ++bj) *(u32x4*)(rowp + bj * HALF) = pack8(acc[ai][bj][m][0], acc[ai][bj][m][1]); }
            } else {
                const int col0 = (pn & 3) * 256 + wc * 32 + 8 * fq;
#pragma unroll
                for (int ai = 0; ai < 2; ++ai)
#pragma unroll
                    for (int m = 0; m < 4; ++m) { bf16_t* rowp = o6 + (row0 + ai * HALF + m * 16) * 1024 + col0;
#pragma unroll
                        for (int bj = 0; bj < 2; ++bj) *(u32x4*)(rowp + bj * HALF) = pack8(sigm4(acc[ai][bj][m][0]), sigm4(acc[ai][bj][m][1])); }
            }
        } else if (mode == 5) {
            if (pn < 4) {
                const int col0 = pn * 256 + wc * 32 + 8 * fq;
#pragma unroll
                for (int ai = 0; ai < 2; ++ai)
#pragma unroll
                    for (int m = 0; m < 4; ++m) { bf16_t* rowp = o3 + (row0 + ai * HALF + m * 16) * 1024 + col0;
#pragma unroll
                        for (int bj = 0; bj < 2; ++bj) *(u32x4*)(rowp + bj * HALF) = pack8(acc[ai][bj][m][0], acc[ai][bj][m][1]); }
            } else if (pn < 12) {
                const int col0 = (pn - 4) * 128 + wc * 32 + 8 * fq;
#pragma unroll
                for (int ai = 0; ai < 2; ++ai)
#pragma unroll
                    for (int m = 0; m < 4; ++m)
                        *(u32x4*)(o4 + (row0 + ai * HALF + m * 16) * 1024 + col0) = pack8(acc[ai][0][m][0] * acc[ai][1][m][0], acc[ai][0][m][1] * acc[ai][1][m][1]);
            } else {
                const int col0 = (pn & 3) * 256 + wc * 32 + 8 * fq;
#pragma unroll
                for (int ai = 0; ai < 2; ++ai)
#pragma unroll
                    for (int m = 0; m < 4; ++m) { bf16_t* rowp = o5 + (row0 + ai * HALF + m * 16) * 1024 + col0;
#pragma unroll
                        for (int bj = 0; bj < 2; ++bj) *(u32x4*)(rowp + bj * HALF) = pack8(sigm4(acc[ai][bj][m][0]), sigm4(acc[ai][bj][m][1])); }
            }
        } else if (mode == 1 || mode == 2) {
            const int col0 = pn * 256 + wc * 32 + 8 * fq;
#pragma unroll
            for (int ai = 0; ai < 2; ++ai)
#pragma unroll
                for (int m = 0; m < 4; ++m) { const size_t off = (row0 + ai * HALF + m * 16) * 1024 + col0;
#pragma unroll
                    for (int bj = 0; bj < 2; ++bj) { f32x4 ga, gb; unpack8(*(const u32x4*)(o1 + off + bj * HALF), ga, gb);
                        f32x4 r0 = ga * acc[ai][bj][m][0], r1 = gb * acc[ai][bj][m][1];
                        if (mode == 2) { f32x4 ma, mb; unpack8(*(const u32x4*)(o0 + off + bj * HALF), ma, mb); r0 += ma; r1 += mb; }
                        *(u32x4*)(o0 + off + bj * HALF) = pack8(r0, r1); } }
        } else if (mode == 3) {
            const int col0 = pn * 256 + wc * 32 + 8 * fq; const float* gp = f1 + (size_t)((un.pm * BM) >> 11) * 6144 + col0;
            f32x4 gv[2][2];
#pragma unroll
            for (int bj = 0; bj < 2; ++bj)
#pragma unroll
                for (int n = 0; n < 2; ++n) gv[bj][n] = *(const f32x4*)(gp + bj * HALF + 4 * n);
#pragma unroll
            for (int ai = 0; ai < 2; ++ai)
#pragma unroll
                for (int m = 0; m < 4; ++m) { const size_t off = (row0 + ai * HALF + m * 16) * 1024 + col0;
#pragma unroll
                    for (int bj = 0; bj < 2; ++bj)
#pragma unroll
                        for (int n = 0; n < 2; ++n) *(f32x4*)(fo + off + bj * HALF + 4 * n) = *(const f32x4*)(f0 + off + bj * HALF + 4 * n) + gv[bj][n] * acc[ai][bj][m][n]; }
        } else {
            const int col0 = pn * 128 + wc * 32 + 8 * fq;
#pragma unroll
            for (int ai = 0; ai < 2; ++ai)
#pragma unroll
                for (int m = 0; m < 4; ++m) { const f32x4 g0 = acc[ai][0][m][0], g1 = acc[ai][0][m][1];
                    *(u32x4*)(o0 + (row0 + ai * HALF + m * 16) * 2816 + col0) = pack8(g0 * sigm4(g0) * acc[ai][1][m][0], g1 * sigm4(g1) * acc[ai][1][m][1]); }
        }
    }
};

template <class Epi, class Sched, bool ALIGN_EPI = false, bool SP2 = false>
__device__ __forceinline__ void gemm_phase(PG8_LAS unsigned char* lds, const Gemm g, const Sched& S, const Epi& E) {
    int tid_ = threadIdx.x; asm volatile("" : "+v"(tid_)); const int tid = tid_, wid = __builtin_amdgcn_readfirstlane(tid >> 6), lane = tid & 63, wr = wid >> 2, wc = wid & 3, fr = lane & 15, fq = lane >> 4;
    const int K = g.K, nt = K / BK;
    unsigned voffA[2], voffB[2];
#pragma unroll
    for (int i = 0; i < 2; ++i) { int R, C; stage_rc(tid * 16 + i * 8192, R, C); const int Rb = Epi::PERM ? ((R & ~31) + perm32(R & 31)) : R;
        voffA[i] = (unsigned)(R * K + C) * 2u; voffB[i] = (unsigned)(Rb * K + C) * 2u; }
    const size_t kstep = (size_t)(BK * 2);
    const size_t hstep = (size_t)HALF * K * 2;
    const size_t tstep = 2 * hstep;
    const unsigned ldsw = (unsigned)wid * 1024u;
    const int aoff = lds_byte(wr * 64 + fr, fq * 8), boff = lds_byte(wc * 32 + fr, fq * 8);
#define PG8_SA(b, h) (((b) * 2 + (h)) * HTB)
#define PG8_SB(b, h) ((4 + (b) * 2 + (h)) * HTB)
#define PG8_STAGE(bufoff, gbase, voff) do { _Pragma("unroll") for (int _i = 0; _i < 2; ++_i) \
        __builtin_amdgcn_global_load_lds((const unsigned*)((const char*)(gbase) + (voff)[_i]), (PG8_LAS unsigned*)(lds + (bufoff) + ldsw + _i * 8192), 16, 0, 0); } while (0)
#define PG8_LDA(dst, b, h) do { _Pragma("unroll") for (int m = 0; m < 4; ++m) _Pragma("unroll") for (int k = 0; k < 2; ++k) dst[m][k] = *(const PG8_LAS bf16x8*)(lds + PG8_SA(b, h) + aoff + m * 2048 + k * 1024); } while (0)
#define PG8_LDB(dst, b, h) do { _Pragma("unroll") for (int n = 0; n < 2; ++n) _Pragma("unroll") for (int k = 0; k < 2; ++k) dst[n][k] = *(const PG8_LAS bf16x8*)(lds + PG8_SB(b, h) + boff + n * 2048 + k * 1024); } while (0)
#define PG8_MMA(ai, bj, At, Bt) do { __builtin_amdgcn_s_setprio(1); _Pragma("unroll") for (int m = 0; m < 4; ++m) _Pragma("unroll") for (int n = 0; n < 2; ++n) _Pragma("unroll") for (int k = 0; k < 2; ++k) \
        acc[ai][bj][m][n] = __builtin_amdgcn_mfma_f32_16x16x32_bf16(Bt[n][k], At[m][k], acc[ai][bj][m][n], 0, 0, 0); __builtin_amdgcn_s_setprio(0); } while (0)
#define PG8_WAIT_V(n) asm volatile("s_waitcnt vmcnt(" #n ")" ::: "memory")
#define PG8_WAIT_L(n) asm volatile("s_waitcnt lgkmcnt(" #n ")" ::: "memory")
#define PG8_BAR __builtin_amdgcn_s_barrier()
#define PG8_SCHED __builtin_amdgcn_sched_barrier(0)
    Unit cur, nxt; int ui = 0;
    if (!S.next(0, cur)) return;
    f32x4 acc[2][2][4][2];
#pragma unroll
    for (int a = 0; a < 2; ++a)
#pragma unroll
        for (int b = 0; b < 2; ++b)
#pragma unroll
            for (int m = 0; m < 4; ++m)
#pragma unroll
                for (int n = 0; n < 2; ++n) acc[a][b][m][n] = (f32x4){0.f, 0.f, 0.f, 0.f};
    bf16x8 At[4][2], B0[2][2], B1[2][2];
    const char* cA = (const char*)g.A + (size_t)cur.pm * tstep; const char* cB = (const char*)g.Bt + (size_t)cur.pn * tstep;
    S.a_ready(cur);
    if constexpr (SP2) {
        PG8_STAGE(PG8_SB(0, 0), cB, voffB); PG8_STAGE(PG8_SB(0, 1), cB + hstep, voffB); PG8_STAGE(PG8_SA(0, 0), cA, voffA); PG8_STAGE(PG8_SA(0, 1), cA + hstep, voffA);
        if (wr == 1) PG8_BAR;
        PG8_WAIT_V(2); PG8_BAR;
        PG8_STAGE(PG8_SB(1, 0), cB + kstep, voffB); PG8_STAGE(PG8_SA(1, 0), cA + kstep, voffA); PG8_STAGE(PG8_SB(1, 1), cB + hstep + kstep, voffB);
        PG8_WAIT_V(6); PG8_BAR;
    } else {
        PG8_STAGE(PG8_SB(0, 0), cB, voffB); PG8_STAGE(PG8_SA(0, 0), cA, voffA); PG8_STAGE(PG8_SB(0, 1), cB + hstep, voffB); PG8_STAGE(PG8_SA(0, 1), cA + hstep, voffA);
        if (wr == 1) PG8_BAR;
        PG8_WAIT_V(4); PG8_BAR;
        PG8_STAGE(PG8_SB(1, 0), cB + kstep, voffB); PG8_STAGE(PG8_SA(1, 0), cA + kstep, voffA); PG8_STAGE(PG8_SB(1, 1), cB + hstep + kstep, voffB);
        PG8_WAIT_V(6); PG8_BAR;
    }
    for (;;) {
        const bool has_next = S.next(ui + 1, nxt);
        const char* nA = has_next ? (const char*)g.A + (size_t)nxt.pm * tstep : cA; const char* nB = has_next ? (const char*)g.Bt + (size_t)nxt.pn * tstep : cB;
        for (int t = 0; t < nt; t += 2) {
            const bool last = (t == nt - 2);
            const char* a1 = cA + (size_t)(t + 1) * kstep;
            const char* a2 = last ? nA : cA + (size_t)(t + 2) * kstep; const char* b2 = last ? nB : cB + (size_t)(t + 2) * kstep;
            const char* a3 = a2 + kstep; const char* b3 = b2 + kstep;
            if (last && has_next) S.a_ready(nxt);
            if constexpr (SP2) {
            PG8_LDB(B0, 0, 0); PG8_LDB(B1, 0, 1); PG8_SCHED; PG8_LDA(At, 0, 0); PG8_STAGE(PG8_SA(1, 1), a1 + hstep, voffA);
            PG8_WAIT_V(8); PG8_WAIT_L(0); PG8_BAR; PG8_MMA(0, 0, At, B0); PG8_MMA(0, 1, At, B1); PG8_BAR; PG8_SCHED;
            PG8_LDA(At, 0, 1); PG8_STAGE(PG8_SB(0, 0), b2, voffB); PG8_STAGE(PG8_SB(0, 1), b2 + hstep, voffB); PG8_STAGE(PG8_SA(0, 0), a2, voffA);
            PG8_WAIT_V(8); PG8_WAIT_L(0); PG8_BAR; PG8_MMA(1, 0, At, B0); PG8_MMA(1, 1, At, B1); PG8_BAR; PG8_SCHED;
            PG8_LDB(B0, 1, 0); PG8_LDB(B1, 1, 1); PG8_SCHED; PG8_LDA(At, 1, 0); PG8_STAGE(PG8_SA(0, 1), a2 + hstep, voffA);
            PG8_WAIT_V(8); PG8_WAIT_L(0); PG8_BAR; PG8_MMA(0, 0, At, B0); PG8_MMA(0, 1, At, B1); PG8_BAR; PG8_SCHED;
            PG8_LDA(At, 1, 1); PG8_STAGE(PG8_SB(1, 0), b3, voffB); PG8_STAGE(PG8_SB(1, 1), b3 + hstep, voffB); PG8_STAGE(PG8_SA(1, 0), a3, voffA);
            PG8_WAIT_V(8); PG8_WAIT_L(0); PG8_BAR; PG8_MMA(1, 0, At, B0); PG8_MMA(1, 1, At, B1); PG8_BAR; PG8_SCHED;
            } else {
            PG8_LDB(B0, 0, 0); PG8_SCHED; PG8_LDA(At, 0, 0); PG8_STAGE(PG8_SA(1, 1), a1 + hstep, voffA);
            PG8_WAIT_L(8); PG8_BAR; PG8_WAIT_L(0); PG8_MMA(0, 0, At, B0); PG8_BAR; PG8_SCHED;
            PG8_LDB(B1, 0, 1); PG8_STAGE(PG8_SB(0, 0), b2, voffB);
            PG8_BAR; PG8_WAIT_L(0); PG8_MMA(0, 1, At, B1); PG8_BAR;
            PG8_LDA(At, 0, 1); PG8_STAGE(PG8_SA(0, 0), a2, voffA);
            PG8_BAR; PG8_WAIT_L(0); PG8_MMA(1, 0, At, B0); PG8_BAR; PG8_SCHED;
            PG8_STAGE(PG8_SB(0, 1), b2 + hstep, voffB);
            PG8_WAIT_V(6); PG8_BAR; PG8_MMA(1, 1, At, B1); PG8_BAR;
            PG8_LDB(B0, 1, 0); PG8_SCHED; PG8_LDA(At, 1, 0); PG8_STAGE(PG8_SA(0, 1), a2 + hstep, voffA);
            PG8_WAIT_L(8); PG8_BAR; PG8_WAIT_L(0); PG8_MMA(0, 0, At, B0); PG8_BAR; PG8_SCHED;
            PG8_LDB(B1, 1, 1); PG8_STAGE(PG8_SB(1, 0), b3, voffB);
            PG8_BAR; PG8_WAIT_L(0); PG8_MMA(0, 1, At, B1); PG8_BAR;
            PG8_LDA(At, 1, 1); PG8_STAGE(PG8_SA(1, 0), a3, voffA);
            PG8_BAR; PG8_WAIT_L(0); PG8_MMA(1, 0, At, B0); PG8_BAR; PG8_SCHED;
            PG8_STAGE(PG8_SB(1, 1), b3 + hstep, voffB);
            PG8_WAIT_V(6); PG8_BAR; PG8_MMA(1, 1, At, B1); PG8_BAR;
            }
        }
        if constexpr (ALIGN_EPI) { if (wr == 0) PG8_BAR; }
        if constexpr (!Epi::AFTER_DRAIN) { E(acc, cur, wr, wc, fr, fq); S.done(cur); }
        if (!has_next) break;
#pragma unroll
        for (int a = 0; a < 2; ++a)
#pragma unroll
            for (int b = 0; b < 2; ++b)
#pragma unroll
                for (int m = 0; m < 4; ++m)
#pragma unroll
                    for (int n = 0; n < 2; ++n) acc[a][b][m][n] = (f32x4){0.f, 0.f, 0.f, 0.f};
        cur = nxt; cA = nA; cB = nB; ++ui;
        if constexpr (ALIGN_EPI) { if (wr == 1) PG8_BAR; }
    }
    PG8_WAIT_V(0);
    if constexpr (!ALIGN_EPI) { if (wr == 0) PG8_BAR; }
    PG8_BAR;
    if constexpr (Epi::AFTER_DRAIN) { E.fused(acc, cur, wr, wc, fr, fq, lds, wid, lane); S.done(cur); }
#undef PG8_SA
#undef PG8_SB
#undef PG8_STAGE
#undef PG8_LDA
#undef PG8_LDB
#undef PG8_MMA
#undef PG8_WAIT_V
#undef PG8_WAIT_L
#undef PG8_BAR
#undef PG8_SCHED
}
}
namespace attn2 {
typedef short bf16x8 __attribute__((ext_vector_type(8)));
typedef short s16x4 __attribute__((ext_vector_type(4)));
typedef float f32x16 __attribute__((ext_vector_type(16)));
typedef float f32x4 __attribute__((ext_vector_type(4)));
typedef unsigned u32x4 __attribute__((ext_vector_type(4)));
typedef unsigned short bf16;
constexpr int LD = 1024, NW = 8, QBLK = 32, KVBLK = 64, QB = NW * QBLK, SEQ = 2048;
constexpr int SHM_V = KVBLK * 128 * 2, SHM_K = KVBLK * 64 * 2;
constexpr int OFF_K = 2 * SHM_V, OFF_WS = OFF_K + 2 * SHM_K, OFF_OST = OFF_WS + NW * 64 * 4, LDS_BYTES = OFF_OST + NW * 8192;
constexpr float THR = 8.f;
#define KSWZ(row, colB) ((row) * 128 + ((colB) ^ (((row) & 7) << 4)))
#define SBAR() __builtin_amdgcn_sched_barrier(0)
__device__ __forceinline__ int v_st(int k, int c) { const int kk = (k & ~0xC) | ((k & 4) << 1) | ((k & 8) >> 1); return ((kk >> 3) * 4 + (c >> 5)) * 512 + ((kk & 7) * 32 + (c & 31)) * 2; }
__device__ __forceinline__ int v_rd_base(int lane) { return ((lane & 3) << 3) | (((lane >> 2) & 3) << 6) | (((lane >> 4) & 1) << 5) | (((lane >> 5) & 1) << 8); }
constexpr int v_rd_off(int d0, int ks, int half) { return d0 * 512 + ks * 4096 + half * 2048; }
__device__ __forceinline__ int crow(int r, int hi) { return (r & 3) + 8 * (r >> 2) + 4 * hi; }
__device__ __forceinline__ unsigned cvtpk(float lo, float hi) { return pg8::cvt_pk_bf16(lo, hi); }
__device__ __forceinline__ void mask_tile(f32x16& p0, f32x16& p1, int dq) {
    const float NEG = -__builtin_inff();
#pragma unroll
    for (int r = 0; r < 16; ++r) { const int c = (r & 3) + 8 * (r >> 2); if (dq - c < 0) p0[r] = NEG; if (dq - c - 32 < 0) p1[r] = NEG; }
}
__device__ __forceinline__ void partialSM(f32x16& p0, f32x16& p1, float& m_reg, float& mn, float& alpha) {
    float pmax = p0[0];
#pragma unroll
    for (int r = 1; r < 16; ++r) pmax = fmaxf(pmax, p0[r]);
#pragma unroll
    for (int r = 0; r < 16; ++r) pmax = fmaxf(pmax, p1[r]);
    { auto rr = __builtin_amdgcn_permlane32_swap(__float_as_uint(pmax), __float_as_uint(pmax), false, false); pmax = fmaxf(__uint_as_float(rr[0]), __uint_as_float(rr[1])); }
    if (__builtin_expect(__all((pmax - m_reg) <= THR), 1)) { mn = m_reg; alpha = 1.f; }
    else { mn = fmaxf(m_reg, pmax); alpha = __builtin_amdgcn_exp2f(m_reg - mn); m_reg = mn; }
#pragma unroll
    for (int r = 0; r < 16; ++r) { p0[r] -= mn; p1[r] -= mn; }
#pragma unroll
    for (int r = 0; r < 16; ++r) p0[r] = __builtin_amdgcn_exp2f(p0[r]);
}
__device__ __forceinline__ void finishSM(f32x16& p0, f32x16& p1, float alpha, float& l_reg, bf16x8& pa0, bf16x8& pa1, bf16x8& pa2, bf16x8& pa3) {
#pragma unroll
    for (int r = 0; r < 16; ++r) p1[r] = __builtin_amdgcn_exp2f(p1[r]);
    float ps = 0;
#pragma unroll
    for (int r = 0; r < 16; ++r) ps += p0[r];
#pragma unroll
    for (int r = 0; r < 16; ++r) ps += p1[r];
    { auto rr = __builtin_amdgcn_permlane32_swap(__float_as_uint(ps), __float_as_uint(ps), false, false); ps = __uint_as_float(rr[0]) + __uint_as_float(rr[1]); }
    l_reg = l_reg * alpha + ps;
#define PK4(P, B_, OUT) do { unsigned a0 = cvtpk(P[B_+0], P[B_+1]), a1 = cvtpk(P[B_+2], P[B_+3]);                          \
        unsigned b0 = cvtpk(P[B_+4], P[B_+5]), b1 = cvtpk(P[B_+6], P[B_+7]);                                             \
        auto r0 = __builtin_amdgcn_permlane32_swap(a0, b0, false, false); auto r1 = __builtin_amdgcn_permlane32_swap(a1, b1, false, false); \
        u32x4 w = {r0[0], r1[0], r0[1], r1[1]}; OUT = __builtin_bit_cast(bf16x8, w); } while (0)
    PK4(p0, 0, pa0); PK4(p0, 8, pa1); PK4(p1, 0, pa2); PK4(p1, 8, pa3);
#undef PK4
}
template <int KB>
__device__ __forceinline__ void qkt(f32x16& p0, f32x16& p1, const char* K_lds, int r32, int hi, const bf16x8* qr) {
    p0 = f32x16{}; p1 = f32x16{};
#pragma unroll
    for (int d0 = 0; d0 < 4; ++d0) { const char* a = K_lds + KB * SHM_K + KSWZ(r32, (d0 * 16 + hi * 8) * 2);
        const bf16x8 b0 = *reinterpret_cast<const bf16x8*>(a);
        const bf16x8 b1 = *reinterpret_cast<const bf16x8*>(a + 32 * 128);
        p0 = __builtin_amdgcn_mfma_f32_32x32x16_bf16(b0, qr[d0], p0, 0, 0, 0);
        p1 = __builtin_amdgcn_mfma_f32_32x32x16_bf16(b1, qr[d0], p1, 0, 0, 0); }
}
template <int VB>
__device__ __forceinline__ void pv_tile(f32x16* o, int vb0, bf16x8 pa0, bf16x8 pa1, bf16x8 pa2, bf16x8 pa3) {
#define TRRD(dst, off) asm volatile("ds_read_b64_tr_b16 %0, %1 offset:%2" : "=&v"(dst) : "v"(vb0), "i"(off) : "memory")
#define PV_D0(d0) do { s16x4 l0, l1, l2, l3, h0, h1, h2, h3; constexpr int b_ = VB * SHM_V + v_rd_off(d0, 0, 0); \
        TRRD(l0, b_); TRRD(h0, b_ + 2048); TRRD(l1, b_ + 4096); TRRD(h1, b_ + 6144); TRRD(l2, b_ + 8192); TRRD(h2, b_ + 10240); TRRD(l3, b_ + 12288); TRRD(h3, b_ + 14336); \
        asm volatile("s_waitcnt lgkmcnt(0)" ::: "memory"); SBAR();   \
        o[d0] = __builtin_amdgcn_mfma_f32_32x32x16_bf16(pa0, (bf16x8){l0[0], l0[1], l0[2], l0[3], h0[0], h0[1], h0[2], h0[3]}, o[d0], 0, 0, 0);   \
        o[d0] = __builtin_amdgcn_mfma_f32_32x32x16_bf16(pa1, (bf16x8){l1[0], l1[1], l1[2], l1[3], h1[0], h1[1], h1[2], h1[3]}, o[d0], 0, 0, 0);   \
        o[d0] = __builtin_amdgcn_mfma_f32_32x32x16_bf16(pa2, (bf16x8){l2[0], l2[1], l2[2], l2[3], h2[0], h2[1], h2[2], h2[3]}, o[d0], 0, 0, 0);   \
        o[d0] = __builtin_amdgcn_mfma_f32_32x32x16_bf16(pa3, (bf16x8){l3[0], l3[1], l3[2], l3[3], h3[0], h3[1], h3[2], h3[3]}, o[d0], 0, 0, 0); } while (0)
    PV_D0(0); PV_D0(1); PV_D0(2); PV_D0(3);
#undef PV_D0
#undef TRRD
}
struct BlockRef { const bf16* Q; const bf16* K; const bf16* V; bf16* O; int P0; int mode; };
struct Seam { bf16x8 qr[4]; bf16x8 st_v0, st_v1, st_k0; };
#define VMW() asm volatile("s_waitcnt vmcnt(0)" ::: "memory")
#define VMWN(n) asm volatile("s_waitcnt vmcnt(%0)" :: "i"(n) : "memory")
#define SLOAD_H(Kp, Vp, k0) do { S.st_v0 = *(const bf16x8*)((Vp) + (size_t)((k0) + sr) * LD + sc); S.st_v1 = *(const bf16x8*)((Vp) + (size_t)((k0) + 32 + sr) * LD + sc); \
                                 S.st_k0 = *(const bf16x8*)((Kp) + (size_t)((k0) + kr) * LD + kc); } while (0)
#define SWRITE_HK(bf) do { *(bf16x8*)(K_lds + (bf) * SHM_K + kws) = S.st_k0; } while (0)
#define SWRITE_HV(bf) do { *(bf16x8*)(V_lds + (bf) * SHM_V + vst0) = S.st_v0; *(bf16x8*)(V_lds + (bf) * SHM_V + vst1) = S.st_v1; } while (0)
#define SWRITE_H(bf) do { SWRITE_HV(bf); SWRITE_HK(bf); } while (0)
__device__ __forceinline__ void attn_prime(const BlockRef& cur, char* lds, Seam& S) {
    int tid_ = threadIdx.x; asm volatile("" : "+v"(tid_)); const int tid = tid_, wid = __builtin_amdgcn_readfirstlane(tid >> 6), lane = tid & 63, r32 = lane & 31, hi = lane >> 5;
    const int sr = tid >> 4, sc = (tid & 15) * 8, kr = tid >> 3, kc = (tid & 7) * 8, kws = KSWZ(kr, kc * 2); char* K_lds = lds + OFF_K;
#pragma unroll
    for (int d0 = 0; d0 < 4; ++d0) S.qr[d0] = *(const bf16x8*)(cur.Q + (size_t)(wid * QBLK + r32) * LD + d0 * 16 + hi * 8);
    SLOAD_H(cur.K, cur.V, 0); VMW(); SWRITE_HK(0);
    __syncthreads();
}
__device__ __forceinline__ void attn_block(const BlockRef& cur, const BlockRef& nxt, char* lds, Seam& S, float lam, const float* subg) {
    int tid_ = threadIdx.x; asm volatile("" : "+v"(tid_)); const int tid = tid_, wid = __builtin_amdgcn_readfirstlane(tid >> 6), lane = tid & 63, r32 = lane & 31, hi = lane >> 5;
    const int NT = cur.P0 / KVBLK + QB / KVBLK;
    const int qlo = cur.P0 + wid * QBLK, qm = qlo + r32 - 4 * hi;
    char* V_lds = lds; char* K_lds = lds + OFF_K;
    float* ws = (float*)(lds + OFF_WS) + wid * 64; float* li_l = ws, * al_l = ws + 32;
    float m_reg = -1e30f, l_reg = 0; f32x16 o[4] = {};
    const int sr = tid >> 4, sc = (tid & 15) * 8, vst0 = v_st(sr, sc), vst1 = v_st(32 + sr, sc), kr = tid >> 3, kc = (tid & 7) * 8, kws = KSWZ(kr, kc * 2);
    const int vb0 = (int)(uintptr_t)V_lds + v_rd_base(lane);
    const bf16* Kh = cur.K; const bf16* Vh = cur.V;
#define RESC(a) do { if (__any((a) < 1.f)) { if (hi == 0) al_l[r32] = (a); asm volatile("s_waitcnt lgkmcnt(0)" ::: "memory");              \
                     _Pragma("unroll") for (int d_ = 0; d_ < 4; ++d_) _Pragma("unroll") for (int r = 0; r < 16; ++r) o[d_][r] *= al_l[crow(r, hi)]; } } while (0)
#define KBASE(t) ((t) * KVBLK)
#define MASKT(P0_, P1_, t) do { const int kb_ = KBASE(t); if (kb_ + KVBLK - 1 > qlo) mask_tile(P0_, P1_, qm - kb_); } while (0)
#define SEAM_K0() do { VMWN(4); SWRITE_HK(0); SBAR(); } while (0)
    f32x16 pA0, pA1, pB0, pB1; float mnA, mnB, alA, alB; bf16x8 pa0, pa1, pa2, pa3;
    SWRITE_HV(0); SBAR();
    if (NT > 1) { SLOAD_H(Kh, Vh, KBASE(1)); }
    SBAR(); qkt<0>(pA0, pA1, K_lds, r32, hi, S.qr);
    MASKT(pA0, pA1, 0); partialSM(pA0, pA1, m_reg, mnA, alA);
    if (NT > 1) { VMW(); SWRITE_H(1); }
    __syncthreads();
#define HALF_STEP(PX0, PX1, mnX, alX, PY0, PY1, alY, t, KB, VB, SB) do {                                                      \
        SBAR(); qkt<KB>(PX0, PX1, K_lds, r32, hi, S.qr);                                             \
        finishSM(PY0, PY1, alY, l_reg, pa0, pa1, pa2, pa3); SBAR();                                                           \
        if ((t) + 1 < NT) { SLOAD_H(Kh, Vh, KBASE((t) + 1)); SBAR(); }                                               \
        pv_tile<VB>(o, vb0, pa0, pa1, pa2, pa3); MASKT(PX0, PX1, (t)); partialSM(PX0, PX1, m_reg, mnX, alX);                                        \
        __syncthreads();                                                                                                      \
        if ((t) + 1 < NT) { VMW(); SWRITE_H(SB); }                                                                          \
        RESC(alX); __syncthreads(); } while (0)
    for (int t = 1; t + 1 < NT; t += 2) {
        HALF_STEP(pB0, pB1, mnB, alB, pA0, pA1, alA, t, 1, 0, 0);
        HALF_STEP(pA0, pA1, mnA, alA, pB0, pB1, alB, t + 1, 0, 1, 1);
    }
    SBAR(); qkt<1>(pB0, pB1, K_lds, r32, hi, S.qr); SBAR();
    SLOAD_H(nxt.K, nxt.V, 0); SBAR();
#pragma unroll
    for (int d0 = 0; d0 < 4; ++d0) S.qr[d0] = *(const bf16x8*)(nxt.Q + (size_t)(wid * QBLK + r32) * LD + d0 * 16 + hi * 8);
    SBAR();
    finishSM(pA0, pA1, alA, l_reg, pa0, pa1, pa2, pa3); SBAR();
    pv_tile<0>(o, vb0, pa0, pa1, pa2, pa3);
    MASKT(pB0, pB1, NT - 1); partialSM(pB0, pB1, m_reg, mnB, alB); __syncthreads(); RESC(alB);
    finishSM(pB0, pB1, alB, l_reg, pa0, pa1, pa2, pa3); SBAR(); pv_tile<1>(o, vb0, pa0, pa1, pa2, pa3);
    SBAR(); SEAM_K0();
    if (hi == 0) li_l[r32] = l_reg; asm volatile("s_waitcnt lgkmcnt(0)" ::: "memory");
    float rli[16];
#pragma unroll
    for (int r = 0; r < 16; ++r) rli[r] = __builtin_amdgcn_rcpf(li_l[crow(r, hi)]);
    bf16* stg = (bf16*)(lds + OFF_OST) + wid * 4096;
#pragma unroll
    for (int r = 0; r < 16; ++r) { const int orow = crow(r, hi);
#pragma unroll
        for (int d0 = 0; d0 < 4; ++d0) { const float v = o[d0][r] * rli[r]; stg[orow * 128 + d0 * 32 + r32] = (bf16)(cvtpk(v, v) & 0xffffu); } }
    asm volatile("s_waitcnt lgkmcnt(0)" ::: "memory");
    bf16* Ow = cur.O + (size_t)(wid * QBLK) * LD;
    if (cur.mode == 0) {
#pragma unroll
        for (int i = 0; i < 8; ++i) { const int row = i * 4 + (lane >> 4), ch = lane & 15; *(u32x4*)(Ow + (size_t)row * LD + ch * 8) = *(const u32x4*)(stg + row * 128 + ch * 8); }
    } else {
        f32x4 ga = *(const f32x4*)(subg + (lane & 15) * 8), gb = *(const f32x4*)(subg + (lane & 15) * 8 + 4);
#pragma unroll
        for (int i = 0; i < 8; ++i) { const int row = i * 4 + (lane >> 4), ch = lane & 15; bf16* p = Ow + (size_t)row * LD + ch * 8;
            const u32x4 v = *(const u32x4*)(stg + row * 128 + ch * 8), pv = *(const u32x4*)p; float d[8]; float ss = 0.f;
#pragma unroll
            for (int j = 0; j < 4; ++j) { d[2 * j] = __uint_as_float(pv[j] << 16) - lam * __uint_as_float(v[j] << 16); d[2 * j + 1] = __uint_as_float(pv[j] & 0xffff0000u) - lam * __uint_as_float(v[j] & 0xffff0000u); }
#pragma unroll
            for (int j = 0; j < 8; ++j) ss += d[j] * d[j];
            ss += pg8::swz_xor<1>(ss); ss += pg8::swz_xor<2>(ss); ss += pg8::swz_xor<4>(ss); ss += pg8::swz_xor<8>(ss);
            const float rs = rsqrtf(ss * (1.f / 128.f) + 1e-6f) * 0.8f;
            u32x4 w; w[0] = cvtpk(d[0] * rs * ga[0], d[1] * rs * ga[1]); w[1] = cvtpk(d[2] * rs * ga[2], d[3] * rs * ga[3]); w[2] = cvtpk(d[4] * rs * gb[0], d[5] * rs * gb[1]); w[3] = cvtpk(d[6] * rs * gb[2], d[7] * rs * gb[3]);
            *(u32x4*)p = w; }
    }
    __syncthreads();
#undef RESC
#undef KBASE
#undef MASKT
#undef SEAM_K0
#undef HALF_STEP
}
#undef VMW
#undef VMWN
#undef SLOAD_H
#undef SWRITE_HK
#undef SWRITE_HV
#undef SWRITE_H
__device__ __forceinline__ BlockRef block_ref(int n, int vcu, int G, const bf16* Q, const bf16* K, const bf16* V, bf16* O) {
    const int w = vcu + (n >> 2) * G, i = (n >> 1) & 1, c = n & 1, bh = w >> 2, s = w & 3, b = bh >> 3, h = bh & 7, qb = i == 0 ? s : 7 - s;
    const size_t r0 = (size_t)b * SEQ; BlockRef r;
    r.Q = Q + (r0 + (size_t)qb * QB) * LD + (2 * h + c) * 64; r.K = K + r0 * LD + (2 * h + c) * 64; r.V = V + r0 * LD + h * 128; r.O = O + (r0 + (size_t)qb * QB) * LD + h * 128; r.P0 = qb * QB; r.mode = c;
    return r;
}
__device__ __forceinline__ void attn_phase(char* lds, const bf16* Q, const bf16* K, const bf16* V, bf16* O, int vcu, int G, float lam, const float* subg) {
    const int nblk = ((1024 - vcu + G - 1) / G) * 4;
    if (nblk <= 0) return;
    BlockRef cur = block_ref(0, vcu, G, Q, K, V, O); Seam S;
    attn_prime(cur, lds, S);
    for (int n = 0; n < nblk; ++n) {
        const BlockRef nxt = (n + 1 < nblk) ? block_ref(n + 1, vcu, G, Q, K, V, O) : cur;
        attn_block(cur, nxt, lds, S, lam, subg);
        cur = nxt;
    }
}
#undef KSWZ
#undef SBAR
}

constexpr int NWAVES = 8;
constexpr int BATCH = 32, SEQ = 2048, D = 1024, M = BATCH * SEQ, DIN = 8192, DFF = 2816, NGU = 2 * DFF, NMOD = 6 * D;
constexpr size_t MiB = 1u << 20;
constexpr size_t WS_S0 = 0, WS_S1 = 128 * MiB, WS_S2 = 256 * MiB, WS_S3 = 384 * MiB, WS_S4 = 512 * MiB, WS_S5 = 640 * MiB;
constexpr size_t WS_WIN = 768 * MiB, WS_WA = WS_WIN + 16 * MiB, WS_WB = WS_WA + 2 * MiB, WS_WO = WS_WB + 2 * MiB, WS_WGU = WS_WO + 2 * MiB, WS_WDN = WS_WGU + 11 * MiB, WS_MOD = WS_WDN + 6 * MiB, WS_CTL = WS_MOD + 1 * MiB, WS_END = WS_CTL + 1 * MiB;
constexpr int RING_BYTES = 131072, LDS_BYTES = 147456;
#define LAS __attribute__((address_space(3)))
typedef unsigned short bf16;
typedef unsigned v4u __attribute__((ext_vector_type(4)));
typedef unsigned v2u __attribute__((ext_vector_type(2)));
typedef float f32x4 __attribute__((ext_vector_type(4)));
__device__ __forceinline__ unsigned pk2(float lo, float hi) { return pg8::cvt_pk_bf16(lo, hi); }
__device__ __forceinline__ float wave_sum(float v) { return pg8::wave_sum64(v); }
__device__ __forceinline__ void transpose_item(const float* W, int K, int N, int src_col0, bf16* WT, int dst_row0, int k0, LAS float* scr, int lane) {
#pragma unroll 8
    for (int i = 0; i < 32; ++i) { const int kk = 2 * i + (lane >> 5); scr[kk * 33 + (lane & 31)] = W[(size_t)(k0 + kk) * N + src_col0 + (lane & 31)]; }
    asm volatile("s_waitcnt lgkmcnt(0)" ::: "memory");
    const int c = lane & 7;
#pragma unroll
    for (int j = 0; j < 4; ++j) { const int n = (lane >> 3) + 8 * j; const LAS float* s = scr + (8 * c) * 33 + n;
        v4u o; o.x = pk2(s[0 * 33], s[1 * 33]); o.y = pk2(s[2 * 33], s[3 * 33]); o.z = pk2(s[4 * 33], s[5 * 33]); o.w = pk2(s[6 * 33], s[7 * 33]);
        *(v4u*)(WT + (size_t)(dst_row0 + n) * K + k0 + 8 * c) = o; }
    asm volatile("s_waitcnt lgkmcnt(0)" ::: "memory");
}
__device__ __forceinline__ int win_src(int n0) {
    if (n0 < 1024) return 3072 + n0;
    if (n0 < 3072) { const int p = (n0 - 1024) >> 8, s = n0 & 255; return s < 128 ? 4096 + 128 * p + s : 5120 + 128 * p + (s - 128); }
    if (n0 < 4096) return 6144 + (n0 - 3072);
    if (n0 < 6144) { const int m = n0 - 4096, pn = m >> 8, s = m & 255, bj = s >> 7, wc = (s & 127) >> 5; return pn * 256 + 64 * wc + 32 * bj; }
    if (n0 < 7168) return 2048 + (n0 - 6144);
    return n0;
}
__device__ __forceinline__ int wgu_src(int n0) { const int p = n0 >> 8, s = n0 & 255; return s < 128 ? 128 * p + s : DFF + 128 * p + (s - 128); }

__device__ __forceinline__ void norm_rows(const float* X, const float* g, const float* modsh, const float* modsc, bf16* H, int rb, int lane) {
    const size_t row0 = (size_t)rb * 32; const int b = (int)(row0 >> 11);
    f32x4 av[4], sv[4];
#pragma unroll
    for (int j = 0; j < 4; ++j) { const int idx = 4 * lane + 256 * j; const f32x4 gg = *(const f32x4*)(g + idx), sc = *(const f32x4*)(modsc + (size_t)b * NMOD + idx); av[j] = gg * (sc + 1.0f); sv[j] = *(const f32x4*)(modsh + (size_t)b * NMOD + idx); }
#pragma unroll 2
    for (int r = 0; r < 32; ++r) {
        const f32x4* xr = (const f32x4*)(X + (row0 + r) * D) + lane;
        f32x4 v[4]; float s = 0.f;
#pragma unroll
        for (int j = 0; j < 4; ++j) { v[j] = xr[64 * j]; s += (v[j].x * v[j].x + v[j].y * v[j].y) + (v[j].z * v[j].z + v[j].w * v[j].w); }
        const float rstd = rsqrtf(wave_sum(s) * (1.f / D) + 1e-6f);
        v2u* o8 = (v2u*)(H + (row0 + r) * D) + lane;
#pragma unroll
        for (int j = 0; j < 4; ++j) { const f32x4 y = v[j] * rstd * av[j] + sv[j]; v2u w; w.x = pk2(y.x, y.y); w.y = pk2(y.z, y.w); o8[64 * j] = w; }
    }
}

struct Args { const float* in[20]; float* out; unsigned char* ws; };
__global__ void __launch_bounds__(NWAVES * 64, 2) fwd_megakernel(Args args) {
    extern __shared__ __attribute__((aligned(16))) unsigned char lds[];
    cg::grid_group grid = cg::this_grid();
    const int G = gridDim.x, bx = blockIdx.x, vcu = (G % 8 == 0) ? (bx % 8) * (G / 8) + bx / 8 : bx;
    const int NGW = G * NWAVES;
#define GRID_SYNC() do { asm volatile("s_waitcnt vmcnt(0) lgkmcnt(0)" ::: "memory"); __syncthreads(); \
    if (threadIdx.x == 0) { __builtin_amdgcn_fence(__ATOMIC_RELEASE, "agent"); asm volatile("s_waitcnt vmcnt(0)" ::: "memory"); \
        __hip_atomic_fetch_add(barw, 1u, __ATOMIC_RELAXED, __HIP_MEMORY_SCOPE_AGENT); ++nbar; const unsigned want = nbar * (unsigned)G; \
        while (__hip_atomic_load(barw, __ATOMIC_RELAXED, __HIP_MEMORY_SCOPE_AGENT) < want) __builtin_amdgcn_s_sleep(2); } \
    __syncthreads(); __builtin_amdgcn_fence(__ATOMIC_ACQUIRE, "agent"); asm volatile("s_waitcnt vmcnt(0)" ::: "memory"); __syncthreads(); } while (0)
#define PHASE_IDS() int tid = threadIdx.x; asm volatile("" : "+v"(tid)); const int lane = tid & 63, wave = __builtin_amdgcn_readfirstlane(tid >> 6), gw = vcu * NWAVES + wave; (void)lane; (void)gw
    unsigned char* ws = args.ws;
    const float* x = args.in[0];
    bf16* S0 = (bf16*)(ws + WS_S0); bf16* S1 = (bf16*)(ws + WS_S1); bf16* S2 = (bf16*)(ws + WS_S2); bf16* S3 = (bf16*)(ws + WS_S3); bf16* S4 = (bf16*)(ws + WS_S4); bf16* S5 = (bf16*)(ws + WS_S5);
    bf16* WIN = (bf16*)(ws + WS_WIN); bf16* WA = (bf16*)(ws + WS_WA); bf16* WB = (bf16*)(ws + WS_WB); bf16* WO = (bf16*)(ws + WS_WO); bf16* WGU = (bf16*)(ws + WS_WGU); bf16* WDN = (bf16*)(ws + WS_WDN);
    float* mod = (float*)(ws + WS_MOD);
    float* X1 = (float*)(ws + WS_S1);
    LAS unsigned char* ldsl = (LAS unsigned char*)lds;
    unsigned* barw = (unsigned*)(ws + WS_CTL); unsigned nbar = 0;
    grid.sync();

    if (bx < 96) {
        PHASE_IDS();
        LAS float* cact = (LAS float*)ldsl;
        const float* c = args.in[1];
        for (int i = tid; i < BATCH * D; i += NWAVES * 64) { const int b = i >> 10, k = i & 1023; const float cv = c[i]; cact[k * 32 + b] = cv / (1.f + __expf(-cv)); }
        __syncthreads();
        const float* wada = args.in[2]; const int col = bx * 64 + lane, k0 = wave * 128;
        float acc[32];
#pragma unroll
        for (int b = 0; b < 32; ++b) acc[b] = 0.f;
#pragma unroll 4
        for (int kk = 0; kk < 128; ++kk) { const float w = wada[(size_t)(k0 + kk) * NMOD + col]; const LAS f32x4* cp = (const LAS f32x4*)(cact + (k0 + kk) * 32);
#pragma unroll
            for (int j = 0; j < 8; ++j) { const f32x4 cv = cp[j]; acc[4 * j] += w * cv.x; acc[4 * j + 1] += w * cv.y; acc[4 * j + 2] += w * cv.z; acc[4 * j + 3] += w * cv.w; } }
        __syncthreads();
        LAS float* part = (LAS float*)ldsl;
#pragma unroll
        for (int b = 0; b < 32; ++b) part[(wave * 32 + b) * 64 + lane] = acc[b];
        __syncthreads();
        const float* bada = args.in[3];
        for (int o = tid; o < 2048; o += NWAVES * 64) { const int b = o >> 6, cl = o & 63; float s = 0.f;
#pragma unroll
            for (int w = 0; w < 8; ++w) s += part[(w * 32 + b) * 64 + cl];
            mod[(size_t)b * NMOD + bx * 64 + cl] = s + bada[bx * 64 + cl]; }
        __syncthreads();
    }
    {
        PHASE_IDS();
        LAS float* scr = (LAS float*)(ldsl + wave * 16384);
        constexpr int I_IN = 16 * 256, I_SQ = 16 * 32, I_GU = 16 * 176, I_DN = 44 * 32, NITEMS = I_IN + 3 * I_SQ + I_GU + I_DN;
        for (int it = gw; it < NITEMS; it += NGW) {
            int r = it;
            if (r < I_IN) { const int kb = r >> 8, nb = r & 255; transpose_item(args.in[5], D, DIN, win_src(32 * nb), WIN, 32 * nb, 64 * kb, scr, lane); continue; } r -= I_IN;
            if (r < I_SQ) { const int kb = r >> 5, nb = r & 31; transpose_item(args.in[14], D, D, 32 * nb, WA, 32 * nb, 64 * kb, scr, lane); continue; } r -= I_SQ;
            if (r < I_SQ) { const int kb = r >> 5, nb = r & 31; transpose_item(args.in[15], D, D, 32 * nb, WB, 32 * nb, 64 * kb, scr, lane); continue; } r -= I_SQ;
            if (r < I_SQ) { const int kb = r >> 5, nb = r & 31; transpose_item(args.in[16], D, D, 32 * nb, WO, 32 * nb, 64 * kb, scr, lane); continue; } r -= I_SQ;
            if (r < I_GU) { const int kb = r / 176, nb = r % 176; transpose_item(args.in[18], D, NGU, wgu_src(32 * nb), WGU, 32 * nb, 64 * kb, scr, lane); continue; } r -= I_GU;
            { const int kb = r >> 5, nb = r & 31; transpose_item(args.in[19], DFF, D, 32 * nb, WDN, 32 * nb, 64 * kb, scr, lane); }
        }
    }
    GRID_SYNC();
    { PHASE_IDS(); for (int rb = gw; rb < M / 32; rb += NGW) norm_rows(x, args.in[4], mod, mod + D, S0, rb, lane); }
    GRID_SYNC();

    pg8::StaticOrder SO; pg8::Gemm g; pg8::EpiAll E{};
    g = pg8::Gemm{S0, WIN, M, 4096, D}; SO.init(M, 4096, G, bx);
    E.mode = 5; E.o3 = S1; E.o4 = S2; E.o5 = S3;
    pg8::gemm_phase<pg8::EpiAll, pg8::StaticOrder, true, true>(ldsl, g, SO, E);
    GRID_SYNC();
    {
        PHASE_IDS();
        const float* cw = args.in[6]; const int NT = G * NWAVES * 64, gt = vcu * (NWAVES * 64) + tid;
        for (int it = gt; it < (M / 16) * 128; it += NT) {
            const int cgp = it & 127, rbk = it >> 7; const size_t t0 = (size_t)rbk * 16; const int c0 = cgp * 8;
            f32x4 w0a = *(const f32x4*)(cw + c0), w0b = *(const f32x4*)(cw + c0 + 4), w1a = *(const f32x4*)(cw + D + c0), w1b = *(const f32x4*)(cw + D + c0 + 4), w2a = *(const f32x4*)(cw + 2 * D + c0), w2b = *(const f32x4*)(cw + 2 * D + c0 + 4);
            f32x4 p2a = {0.f, 0.f, 0.f, 0.f}, p2b = p2a, p1a = p2a, p1b = p2a;
            if ((t0 & (SEQ - 1)) != 0) { pg8::unpack8(*(const v4u*)(S2 + (t0 - 2) * D + c0), p2a, p2b); pg8::unpack8(*(const v4u*)(S2 + (t0 - 1) * D + c0), p1a, p1b); }
#pragma unroll 4
            for (int r = 0; r < 16; ++r) { f32x4 ua, ub, ba, bb; pg8::unpack8(*(const v4u*)(S2 + (t0 + r) * D + c0), ua, ub); pg8::unpack8(*(const v4u*)(S1 + (t0 + r) * D + c0), ba, bb);
                const f32x4 ya = ba * (w0a * p2a + w1a * p1a + w2a * ua), yb = bb * (w0b * p2b + w1b * p1b + w2b * ub);
                *(v4u*)(S1 + (t0 + r) * D + c0) = pg8::pack8(ya, yb); p2a = p1a; p2b = p1b; p1a = ua; p1b = ub; }
        }
    }
    GRID_SYNC();
    SO.init(M, D, G, bx);
    g = pg8::Gemm{S1, WA, M, D, D}; E.mode = 1; E.o0 = S3; E.o1 = S3;
    pg8::gemm_phase<pg8::EpiAll, pg8::StaticOrder, true, true>(ldsl, g, SO, E);
    GRID_SYNC();
    g = pg8::Gemm{S0, WIN + (size_t)4096 * D, M, 4096, D}; SO.init(M, 4096, G, bx);
    E.mode = 0; E.o0 = S1; E.o1 = S2; E.o2 = S4; E.o6 = S5; E.f0 = args.in[7]; E.f1 = args.in[8];
    pg8::gemm_phase<pg8::EpiAll, pg8::StaticOrder, true, true>(ldsl, g, SO, E);
    GRID_SYNC();
    {
        PHASE_IDS();
        float l1 = args.in[9][lane] * args.in[10][lane], l2 = args.in[11][lane] * args.in[12][lane];
        l1 = wave_sum(l1); l2 = wave_sum(l2);
        const float lam = __uint_as_float(__builtin_amdgcn_readfirstlane(__float_as_uint(__expf(l1) - __expf(l2) + 0.2f)));
        attn2::attn_phase((char*)lds, S1, S2, S4, S0, vcu, G, lam, args.in[13]);
    }
    GRID_SYNC();
    SO.init(M, D, G, bx);
    g = pg8::Gemm{S0, WB, M, D, D}; E.mode = 2; E.o0 = S3; E.o1 = S5;
    pg8::gemm_phase<pg8::EpiAll, pg8::StaticOrder, true, true>(ldsl, g, SO, E);
    GRID_SYNC();
#ifdef EXP_NOFFN
    g = pg8::Gemm{S3, WO, M, D, D}; E.mode = 3; E.f0 = x; E.f1 = mod + 2 * D; E.fo = args.out;
    pg8::gemm_phase<pg8::EpiAll, pg8::StaticOrder, true, true>(ldsl, g, SO, E);
    return;
#endif
    g = pg8::Gemm{S3, WO, M, D, D}; E.mode = 3; E.f0 = x; E.f1 = mod + 2 * D; E.fo = X1;
    pg8::gemm_phase<pg8::EpiAll, pg8::StaticOrder, true, true>(ldsl, g, SO, E);
    GRID_SYNC();
    { PHASE_IDS(); for (int rb = gw; rb < M / 32; rb += NGW) norm_rows(X1, args.in[17], mod + 3 * D, mod + 4 * D, S0, rb, lane); }
    GRID_SYNC();
    g = pg8::Gemm{S0, WGU, M, NGU, D}; SO.init(M, NGU, G, bx); E.mode = 4; E.o0 = S3;
    pg8::gemm_phase<pg8::EpiAll, pg8::StaticOrder, true, true>(ldsl, g, SO, E);
    GRID_SYNC();
    g = pg8::Gemm{S3, WDN, M, D, DFF}; SO.init(M, D, G, bx); E.mode = 3; E.f0 = X1; E.f1 = mod + 5 * D; E.fo = args.out;
    pg8::gemm_phase<pg8::EpiAll, pg8::StaticOrder, true, true>(ldsl, g, SO, E);
}

extern "C" void kernel_launch(void* const* d_in, const int* in_sizes, int n_in, void* d_out, int out_size, void* d_ws, size_t ws_size, hipStream_t stream) {
    static int grid = 0;
    if (grid == 0) {
        if (n_in != 20 || in_sizes[0] != M * D || out_size != M * D || ws_size < WS_END) { fprintf(stderr, "kernel_launch: unexpected shapes (n_in %d, in0 %d, out %d, ws %zu)\n", n_in, n_in > 0 ? in_sizes[0] : -1, out_size, ws_size); grid = -1; return; }
        int dev = 0, cus = 0, per_cu = 0;
        (void)hipGetDevice(&dev); (void)hipDeviceGetAttribute(&cus, hipDeviceAttributeMultiprocessorCount, dev);
        (void)hipFuncSetAttribute((const void*)fwd_megakernel, hipFuncAttributeMaxDynamicSharedMemorySize, LDS_BYTES);
        if (hipOccupancyMaxActiveBlocksPerMultiprocessor(&per_cu, (const void*)fwd_megakernel, NWAVES * 64, LDS_BYTES) != hipSuccess || per_cu < 1) per_cu = 1;
        (void)hipGetLastError();
        grid = cus * per_cu;
    }
    if (grid < 0) return;
    (void)hipMemsetAsync((unsigned char*)d_ws + WS_CTL, 0, 4096, stream);
    Args a{};
    for (int i = 0; i < 20; ++i) a.in[i] = (const float*)d_in[i];
    a.out = (float*)d_out; a.ws = (unsigned char*)d_ws;
    void* kargs[] = {&a};
    hipError_t e = hipLaunchCooperativeKernel((const void*)fwd_megakernel, dim3(grid), dim3(NWAVES * 64), kargs, LDS_BYTES, stream);
    if (e != hipSuccess) fprintf(stderr, "cooperative launch failed: %s (grid %d)\n", hipGetErrorString(e), grid);
}
```

```cpp
#include <hip/hip_runtime.h>
#include <hip/hip_cooperative_groups.h>
#include <hip/hip_bf16.h>
#include <cstdio>
#include <cstdint>
#include <cmath>
namespace cg = cooperative_groups;
namespace pg8 {
#define PG8_LAS __attribute__((address_space(3)))
typedef unsigned short bf16_t;
typedef short bf16x8 __attribute__((ext_vector_type(8)));
typedef float f32x4 __attribute__((ext_vector_type(4)));
typedef unsigned u32x4 __attribute__((ext_vector_type(4)));
constexpr int BM = 256, BK = 64, HALF = 128, HTB = HALF * BK * 2  , STAGE_BYTES = 8 * HTB, NXCD = 8, WGM = 8;

__host__ __device__ __forceinline__ int lds_byte(int r, int c) { const int st = (r >> 4) * 2 + (c >> 5), rr = r & 15, cc = c & 31, ob = rr * 64 + cc * 2; return st * 1024 + (ob ^ (((ob >> 9) & 1) << 5)); }
__host__ __device__ __forceinline__ void stage_rc(int b, int& R, int& C) { const int st = b / 1024, sb = b % 1024, swz = sb ^ (((sb >> 9) & 1) << 5); R = (st >> 1) * 16 + swz / 64; C = (st & 1) * 32 + (swz % 64) / 2; }
__host__ __device__ __forceinline__ int perm32(int rho) { const int n = rho >> 4, i = rho & 15; return 8 * (i >> 2) + 4 * n + (i & 3); }

struct Unit { int pm, pn; };
struct Gemm { const bf16_t* A; const bf16_t* Bt; int M, N, K; };

struct StaticOrder {
    int nM, nN, nwg, G, c;
    __host__ __device__ void init(int M, int N, int G_, int c_) { nM = M / BM; nN = N / BM; nwg = nM * nN; G = G_; c = c_; }
    __host__ __device__ bool next(int i, Unit& u) const {
        const long L = (long)i * G + c; if (L >= nwg) return false;
        int wgid = (int)L; { const int q = nwg / NXCD, r = nwg % NXCD, xcd = wgid % NXCD, off = wgid / NXCD; wgid = (xcd < r ? xcd * (q + 1) : r * (q + 1) + (xcd - r) * q) + off; }
        const int nig = WGM * nN, gid = wgid / nig, fm = gid * WGM, gsz = (nM - fm) < WGM ? (nM - fm) : WGM;
        u.pm = fm + ((wgid % nig) % gsz); u.pn = (wgid % nig) / gsz; return true;
    }
    __device__ __forceinline__ void a_ready(const Unit&) const {}
    __device__ __forceinline__ void done(const Unit&) const {}
};
typedef float f32x2 __attribute__((ext_vector_type(2))); typedef __bf16 bf16x2_t __attribute__((ext_vector_type(2)));
__device__ __forceinline__ unsigned cvt_pk_bf16(float lo, float hi) { f32x2 v = {lo, hi}; bf16x2_t b = __builtin_convertvector(v, bf16x2_t); return __builtin_bit_cast(unsigned, b); }
constexpr float EPSF = 1e-6f;
constexpr float QC2 = 0.125f * 1.4426950408889634f;
__device__ __forceinline__ u32x4 pack8(const f32x4 a, const f32x4 b) { u32x4 w; w.x = cvt_pk_bf16(a[0], a[1]); w.y = cvt_pk_bf16(a[2], a[3]); w.z = cvt_pk_bf16(b[0], b[1]); w.w = cvt_pk_bf16(b[2], b[3]); return w; }
__device__ __forceinline__ float bf_lo(unsigned u) { return __uint_as_float(u << 16); }
__device__ __forceinline__ float bf_hi(unsigned u) { return __uint_as_float(u & 0xffff0000u); }
__device__ __forceinline__ void unpack8(const u32x4 w, f32x4& a, f32x4& b) { a = (f32x4){bf_lo(w.x), bf_hi(w.x), bf_lo(w.y), bf_hi(w.y)}; b = (f32x4){bf_lo(w.z), bf_hi(w.z), bf_lo(w.w), bf_hi(w.w)}; }
template <int X> __device__ __forceinline__ float swz_xor(float v) { return __uint_as_float((unsigned)__builtin_amdgcn_ds_swizzle((int)__float_as_uint(v), (X << 10) | 0x1f)); }
__device__ __forceinline__ float wave_sum64(float v) { v += swz_xor<1>(v); v += swz_xor<2>(v); v += swz_xor<4>(v); v += swz_xor<8>(v); v += swz_xor<16>(v);
    auto rr = __builtin_amdgcn_permlane32_swap(__float_as_uint(v), __float_as_uint(v), false, false); return __uint_as_float(rr[0]) + __uint_as_float(rr[1]); }
__device__ __forceinline__ float sigm(float x) { return __builtin_amdgcn_rcpf(1.f + __builtin_amdgcn_exp2f(-1.4426950408889634f * x)); }
#ifdef EXP_NOSIG
__device__ __forceinline__ f32x4 sigm4(const f32x4 v) { return v * 0.25f + 0.5f; }
#else
__device__ __forceinline__ f32x4 sigm4(const f32x4 v) { return (f32x4){sigm(v[0]), sigm(v[1]), sigm(v[2]), sigm(v[3])}; }
#endif

struct EpiAll {
    static constexpr bool PERM = true, AFTER_DRAIN = false;
    int mode; bf16_t *o0, *o1, *o2, *o3, *o4, *o5, *o6; const float *f0, *f1; float* fo;
    __device__ __forceinline__ void operator()(const f32x4 (&acc)[2][2][4][2], const Unit& un, int wr, int wc, int fr, int fq) const {
        const int pn = un.pn; const size_t row0 = (size_t)un.pm * BM + wr * 64 + fr;
        if (mode == 0) {
            if (pn < 8) {
                const bool isq = pn < 4; bf16_t* base = isq ? o0 : o1; const float* g = isq ? f0 : f1; const float sc = isq ? QC2 : 1.f;
                f32x4 gv[2][2];
#pragma unroll
                for (int bj = 0; bj < 2; ++bj)
#pragma unroll
                    for (int n = 0; n < 2; ++n) gv[bj][n] = *(const f32x4*)(g + 32 * bj + 8 * fq + 4 * n) * sc;
                const int col0 = (pn & 3) * 256 + 64 * wc + 8 * fq;
#pragma unroll
                for (int ai = 0; ai < 2; ++ai)
#pragma unroll
                    for (int m = 0; m < 4; ++m) {
                        float ss = 0.f;
#pragma unroll
                        for (int bj = 0; bj < 2; ++bj)
#pragma unroll
                            for (int n = 0; n < 2; ++n) { const f32x4 x = acc[ai][bj][m][n]; ss += (x[0] * x[0] + x[1] * x[1]) + (x[2] * x[2] + x[3] * x[3]); }
                        ss += swz_xor<16>(ss); { auto rr = __builtin_amdgcn_permlane32_swap(__float_as_uint(ss), __float_as_uint(ss), false, false); ss = __uint_as_float(rr[0]) + __uint_as_float(rr[1]); }
                        const float rs = rsqrtf(ss * (1.f / 64.f) + EPSF);
                        bf16_t* rowp = base + (row0 + ai * HALF + m * 16) * 1024 + col0;
#pragma unroll
                        for (int bj = 0; bj < 2; ++bj) *(u32x4*)(rowp + 32 * bj) = pack8(acc[ai][bj][m][0] * rs * gv[bj][0], acc[ai][bj][m][1] * rs * gv[bj][1]);
                    }
            } else if (pn < 12) {
                const int col0 = (pn & 3) * 256 + wc * 32 + 8 * fq;
#pragma unroll
                for (int ai = 0; ai < 2; ++ai)
#pragma unroll
                    for (int m = 0; m < 4; ++m) { bf16_t* rowp = o2 + (row0 + ai * HALF + m * 16) * 1024 + col0;
#pragma unroll
                        for (int bj = 0; bj < 2; ++bj) *(u32x4*)(rowp + bj * HALF) = pack8(acc[ai][bj][m][0], acc[ai][bj][m][1]); }
            } else {
                const int col0 = (pn & 3) * 256 + wc * 32 + 8 * fq;
#pragma unroll
                for (int ai = 0; ai < 2; ++ai)
#pragma unroll
                    for (int m = 0; m < 4; ++m) { bf16_t* rowp = o6 + (row0 + ai * HALF + m * 16) * 1024 + col0;
#pragma unroll
                        for (int bj = 0; bj < 2; ++bj) *(u32x4*)(rowp + bj * HALF) = pack8(sigm4(acc[ai][bj][m][0]), sigm4(acc[ai][bj][m][1])); }
            }
        } else if (mode == 5) {
            if (pn < 4) {
                const int col0 = pn * 256 + wc * 32 + 8 * fq;
#pragma unroll
                for (int ai = 0; ai < 2; ++ai)
#pragma unroll
                    for (int m = 0; m < 4; ++m) { bf16_t* rowp = o3 + (row0 + ai * HALF + m * 16) * 1024 + col0;
#pragma unroll
                        for (int bj = 0; bj < 2; ++bj) *(u32x4*)(rowp + bj * HALF) = pack8(acc[ai][bj][m][0], acc[ai][bj][m][1]); }
            } else if (pn < 12) {
                const int col0 = (pn - 4) * 128 + wc * 32 + 8 * fq;
#pragma unroll
                for (int ai = 0; ai < 2; ++ai)
#pragma unroll
                    for (int m = 0; m < 4; ++m)
                        *(u32x4*)(o4 + (row0 + ai * HALF + m * 16) * 1024 + col0) = pack8(acc[ai][0][m][0] * acc[ai][1][m][0], acc[ai][0][m][1] * acc[ai][1][m][1]);
            } else {
                const int col0 = (pn & 3) * 256 + wc * 32 + 8 * fq;
#pragma unroll
                for (int ai = 0; ai < 2; ++ai)
#pragma unroll
                    for (int m = 0; m < 4; ++m) { bf16_t* rowp = o5 + (row0 + ai * HALF + m * 16) * 1024 + col0;
#pragma unroll
                        for (int bj = 0; bj < 2; ++bj) *(u32x4*)(rowp + bj * HALF) = pack8(sigm4(acc[ai][bj][m][0]), sigm4(acc[ai][bj][m][1])); }
            }
        } else if (mode == 1 || mode == 2) {
            const int col0 = pn * 256 + wc * 32 + 8 * fq;
#pragma unroll
            for (int ai = 0; ai < 2; ++ai)
#pragma unroll
                for (int m = 0; m < 4; ++m) { const size_t off = (row0 + ai * HALF + m * 16) * 1024 + col0;
#pragma unroll
                    for (int bj = 0; bj < 2; ++bj) { f32x4 ga, gb; unpack8(*(const u32x4*)(o1 + off + bj * HALF), ga, gb);
                        f32x4 r0 = ga * acc[ai][bj][m][0], r1 = gb * acc[ai][bj][m][1];
                        if (mode == 2) { f32x4 ma, mb; unpack8(*(const u32x4*)(o0 + off + bj * HALF), ma, mb); r0 += ma; r1 += mb; }
                        *(u32x4*)(o0 + off + bj * HALF) = pack8(r0, r1); } }
        } else if (mode == 3) {
            const int col0 = pn * 256 + wc * 32 + 8 * fq; const float* gp = f1 + (size_t)((un.pm * BM) >> 11) * 6144 + col0;
            f32x4 gv[2][2];
#pragma unroll
            for (int bj = 0; bj < 2; ++bj)
#pragma unroll
                for (int n = 0; n < 2; ++n) gv[bj][n] = *(const f32x4*)(gp + bj * HALF + 4 * n);
#pragma unroll
            for (int ai = 0; ai < 2; ++ai)
#pragma unroll
                for (int m = 0; m < 4; ++m) { const size_t off = (row0 + ai * HALF + m * 16) * 1024 + col0;
#pragma unroll
                    for (int bj = 0; bj < 2; ++bj)
#pragma unroll
                        for (int n = 0; n < 2; ++n) *(f32x4*)(fo + off + bj * HALF + 4 * n) = *(const f32x4*)(f0 + off + bj * HALF + 4 * n) + gv[bj][n] * acc[ai][bj][m][n]; }
        } else {
            const int col0 = pn * 128 + wc * 32 + 8 * fq;
#pragma unroll
            for (int ai = 0; ai < 2; ++ai)
#pragma unroll
                for (int m = 0; m < 4; ++m) { const f32x4 g0 = acc[ai][0][m][0], g1 = acc[ai][0][m][1];
                    *(u32x4*)(o0 + (row0 + ai * HALF + m * 16) * 2816 + col0) = pack8(g0 * sigm4(g0) * acc[ai][1][m][0], g1 * sigm4(g1) * acc[ai][1][m][1]); }
        }
    }
};

template <class Epi, class Sched, bool ALIGN_EPI = false, bool SP2 = false>
__device__ __forceinline__ void gemm_phase(PG8_LAS unsigned char* lds, const Gemm g, const Sched& S, const Epi& E) {
    int tid_ = threadIdx.x; asm volatile("" : "+v"(tid_)); const int tid = tid_, wid = __builtin_amdgcn_readfirstlane(tid >> 6), lane = tid & 63, wr = wid >> 2, wc = wid & 3, fr = lane & 15, fq = lane >> 4;
    const int K = g.K, nt = K / BK;
    unsigned voffA[2], voffB[2];
#pragma unroll
    for (int i = 0; i < 2; ++i) { int R, C; stage_rc(tid * 16 + i * 8192, R, C); const int Rb = Epi::PERM ? ((R & ~31) + perm32(R & 31)) : R;
        voffA[i] = (unsigned)(R * K + C) * 2u; voffB[i] = (unsigned)(Rb * K + C) * 2u; }
    const size_t kstep = (size_t)(BK * 2);
    const size_t hstep = (size_t)HALF * K * 2;
    const size_t tstep = 2 * hstep;
    const unsigned ldsw = (unsigned)wid * 1024u;
    const int aoff = lds_byte(wr * 64 + fr, fq * 8), boff = lds_byte(wc * 32 + fr, fq * 8);
#define PG8_SA(b, h) (((b) * 2 + (h)) * HTB)
#define PG8_SB(b, h) ((4 + (b) * 2 + (h)) * HTB)
#define PG8_STAGE(bufoff, gbase, voff) do { _Pragma("unroll") for (int _i = 0; _i < 2; ++_i) \
        __builtin_amdgcn_global_load_lds((const unsigned*)((const char*)(gbase) + (voff)[_i]), (PG8_LAS unsigned*)(lds + (bufoff) + ldsw + _i * 8192), 16, 0, 0); } while (0)
#define PG8_LDA(dst, b, h) do { _Pragma("unroll") for (int m = 0; m < 4; ++m) _Pragma("unroll") for (int k = 0; k < 2; ++k) dst[m][k] = *(const PG8_LAS bf16x8*)(lds + PG8_SA(b, h) + aoff + m * 2048 + k * 1024); } while (0)
#define PG8_LDB(dst, b, h) do { _Pragma("unroll") for (int n = 0; n < 2; ++n) _Pragma("unroll") for (int k = 0; k < 2; ++k) dst[n][k] = *(const PG8_LAS bf16x8*)(lds + PG8_SB(b, h) + boff + n * 2048 + k * 1024); } while (0)
#define PG8_MMA(ai, bj, At, Bt) do { __builtin_amdgcn_s_setprio(1); _Pragma("unroll") for (int m = 0; m < 4; ++m) _Pragma("unroll") for (int n = 0; n < 2; ++n) _Pragma("unroll") for (int k = 0; k < 2; ++k) \
        acc[ai][bj][m][n] = __builtin_amdgcn_mfma_f32_16x16x32_bf16(Bt[n][k], At[m][k], acc[ai][bj][m][n], 0, 0, 0); __builtin_amdgcn_s_setprio(0); } while (0)
#define PG8_WAIT_V(n) asm volatile("s_waitcnt vmcnt(" #n ")" ::: "memory")
#define PG8_WAIT_L(n) asm volatile("s_waitcnt lgkmcnt(" #n ")" ::: "memory")
#define PG8_BAR __builtin_amdgcn_s_barrier()
#define PG8_SCHED __builtin_amdgcn_sched_barrier(0)
    Unit cur, nxt; int ui = 0;
    if (!S.next(0, cur)) return;
    f32x4 acc[2][2][4][2];
#pragma unroll
    for (int a = 0; a < 2; ++a)
#pragma unroll
        for (int b = 0; b < 2; ++b)
#pragma unroll
            for (int m = 0; m < 4; ++m)
#pragma unroll
                for (int n = 0; n < 2; ++n) acc[a][b][m][n] = (f32x4){0.f, 0.f, 0.f, 0.f};
    bf16x8 At[4][2], B0[2][2], B1[2][2];
    const char* cA = (const char*)g.A + (size_t)cur.pm * tstep; const char* cB = (const char*)g.Bt + (size_t)cur.pn * tstep;
    S.a_ready(cur);
    if constexpr (SP2) {
        PG8_STAGE(PG8_SB(0, 0), cB, voffB); PG8_STAGE(PG8_SB(0, 1), cB + hstep, voffB); PG8_STAGE(PG8_SA(0, 0), cA, voffA); PG8_STAGE(PG8_SA(0, 1), cA + hstep, voffA);
        if (wr == 1) PG8_BAR;
        PG8_WAIT_V(2); PG8_BAR;
        PG8_STAGE(PG8_SB(1, 0), cB + kstep, voffB); PG8_STAGE(PG8_SA(1, 0), cA + kstep, voffA); PG8_STAGE(PG8_SB(1, 1), cB + hstep + kstep, voffB);
        PG8_WAIT_V(6); PG8_BAR;
    } else {
        PG8_STAGE(PG8_SB(0, 0), cB, voffB); PG8_STAGE(PG8_SA(0, 0), cA, voffA); PG8_STAGE(PG8_SB(0, 1), cB + hstep, voffB); PG8_STAGE(PG8_SA(0, 1), cA + hstep, voffA);
        if (wr == 1) PG8_BAR;
        PG8_WAIT_V(4); PG8_BAR;
        PG8_STAGE(PG8_SB(1, 0), cB + kstep, voffB); PG8_STAGE(PG8_SA(1, 0), cA + kstep, voffA); PG8_STAGE(PG8_SB(1, 1), cB + hstep + kstep, voffB);
        PG8_WAIT_V(6); PG8_BAR;
    }
    for (;;) {
        const bool has_next = S.next(ui + 1, nxt);
        const char* nA = has_next ? (const char*)g.A + (size_t)nxt.pm * tstep : cA; const char* nB = has_next ? (const char*)g.Bt + (size_t)nxt.pn * tstep : cB;
        for (int t = 0; t < nt; t += 2) {
            const bool last = (t == nt - 2);
            const char* a1 = cA + (size_t)(t + 1) * kstep;
            const char* a2 = last ? nA : cA + (size_t)(t + 2) * kstep; const char* b2 = last ? nB : cB + (size_t)(t + 2) * kstep;
            const char* a3 = a2 + kstep; const char* b3 = b2 + kstep;
            if (last && has_next) S.a_ready(nxt);
            if constexpr (SP2) {
            PG8_LDB(B0, 0, 0); PG8_LDB(B1, 0, 1); PG8_SCHED; PG8_LDA(At, 0, 0); PG8_STAGE(PG8_SA(1, 1), a1 + hstep, voffA);
            PG8_WAIT_V(8); PG8_WAIT_L(0); PG8_BAR; PG8_MMA(0, 0, At, B0); PG8_MMA(0, 1, At, B1); PG8_BAR; PG8_SCHED;
            PG8_LDA(At, 0, 1); PG8_STAGE(PG8_SB(0, 0), b2, voffB); PG8_STAGE(PG8_SB(0, 1), b2 + hstep, voffB); PG8_STAGE(PG8_SA(0, 0), a2, voffA);
            PG8_WAIT_V(8); PG8_WAIT_L(0); PG8_BAR; PG8_MMA(1, 0, At, B0); PG8_MMA(1, 1, At, B1); PG8_BAR; PG8_SCHED;
            PG8_LDB(B0, 1, 0); PG8_LDB(B1, 1, 1); PG8_SCHED; PG8_LDA(At, 1, 0); PG8_STAGE(PG8_SA(0, 1), a2 + hstep, voffA);
            PG8_WAIT_V(8); PG8_WAIT_L(0); PG8_BAR; PG8_MMA(0, 0, At, B0); PG8_MMA(0, 1, At, B1); PG8_BAR; PG8_SCHED;
            PG8_LDA(At, 1, 1); PG8_STAGE(PG8_SB(1, 0), b3, voffB); PG8_STAGE(PG8_SB(1, 1), b3 + hstep, voffB); PG8_STAGE(PG8_SA(1, 0), a3, voffA);
            PG8_WAIT_V(8); PG8_WAIT_L(0); PG8_BAR; PG8_MMA(1, 0, At, B0); PG8_MMA(1, 1, At, B1); PG8_BAR; PG8_SCHED;
            } else {
            PG8_LDB(B0, 0, 0); PG8_SCHED; PG8_LDA(At, 0, 0); PG8_STAGE(PG8_SA(1, 1), a1 + hstep, voffA);
            PG8_WAIT_L(8); PG8_BAR; PG8_WAIT_L(0); PG8_MMA(0, 0, At, B0); PG8_BAR; PG8_SCHED;
            PG8_LDB(B1, 0, 1); PG8_STAGE(PG8_SB(0, 0), b2, voffB);
            PG8_BAR; PG8_WAIT_L(0); PG8_MMA(0, 1, At, B1); PG8_BAR;
            PG8_LDA(At, 0, 1); PG8_STAGE(PG8_SA(0, 0), a2, voffA);
            PG8_BAR; PG8_WAIT_L(0); PG8_MMA(1, 0, At, B0); PG8_BAR; PG8_SCHED;
            PG8_STAGE(PG8_SB(0, 1), b2 + hstep, voffB);
            PG8_WAIT_V(6); PG8_BAR; PG8_MMA(1, 1, At, B1); PG8_BAR;
            PG8_LDB(B0, 1, 0); PG8_SCHED; PG8_LDA(At, 1, 0); PG8_STAGE(PG8_SA(0, 1), a2 + hstep, voffA);
            PG8_WAIT_L(8); PG8_BAR; PG8_WAIT_L(0); PG8_MMA(0, 0, At, B0); PG8_BAR; PG8_SCHED;
            PG8_LDB(B1, 1, 1); PG8_STAGE(PG8_SB(1, 0), b3, voffB);
            PG8_BAR; PG8_WAIT_L(0); PG8_MMA(0, 1, At, B1); PG8_BAR;
            PG8_LDA(At, 1, 1); PG8_STAGE(PG8_SA(1, 0), a3, voffA);
            PG8_BAR; PG8_WAIT_L(0); PG8_MMA(1, 0, At, B0); PG8_BAR; PG8_SCHED;
            PG8_STAGE(PG8_SB(1, 1), b3 + hstep, voffB);
            PG8_WAIT_V(6); PG8_BAR; PG8_MMA(1, 1, At, B1); PG8_BAR;
            }
        }
        if constexpr (ALIGN_EPI) { if (wr == 0) PG8_BAR; }
        if constexpr (!Epi::AFTER_DRAIN) { E(acc, cur, wr, wc, fr, fq); S.done(cur); }
        if (!has_next) break;
#pragma unroll
        for (int a = 0; a < 2; ++a)
#pragma unroll
            for (int b = 0; b < 2; ++b)
#pragma unroll
                for (int m = 0; m < 4; ++m)
#pragma unroll
                    for (int n = 0; n < 2; ++n) acc[a][b][m][n] = (f32x4){0.f, 0.f, 0.f, 0.f};
        cur = nxt; cA = nA; cB = nB; ++ui;
        if constexpr (ALIGN_EPI) { if (wr == 1) PG8_BAR; }
    }
    PG8_WAIT_V(0);
    if constexpr (!ALIGN_EPI) { if (wr == 0) PG8_BAR; }
    PG8_BAR;
    if constexpr (Epi::AFTER_DRAIN) { E.fused(acc, cur, wr, wc, fr, fq, lds, wid, lane); S.done(cur); }
#undef PG8_SA
#undef PG8_SB
#undef PG8_STAGE
#undef PG8_LDA
#undef PG8_LDB
#undef PG8_MMA
#undef PG8_WAIT_V
#undef PG8_WAIT_L
#undef PG8_BAR
#undef PG8_SCHED
}
}
namespace attn2 {
typedef short bf16x8 __attribute__((ext_vector_type(8)));
typedef short s16x4 __attribute__((ext_vector_type(4)));
typedef float f32x16 __attribute__((ext_vector_type(16)));
typedef float f32x4 __attribute__((ext_vector_type(4)));
typedef unsigned u32x4 __attribute__((ext_vector_type(4)));
typedef unsigned short bf16;
constexpr int LD = 1024, NW = 8, QBLK = 32, KVBLK = 64, QB = NW * QBLK, SEQ = 2048;
constexpr int SHM_V = KVBLK * 128 * 2, SHM_K = KVBLK * 64 * 2;
constexpr int OFF_K = 2 * SHM_V, OFF_WS = OFF_K + 2 * SHM_K, OFF_OST = OFF_WS + NW * 64 * 4, LDS_BYTES = OFF_OST + NW * 8192;
constexpr float THR = 8.f;
#define KSWZ(row, colB) ((row) * 128 + ((colB) ^ (((row) & 7) << 4)))
#define SBAR() __builtin_amdgcn_sched_barrier(0)
__device__ __forceinline__ int v_st(int k, int c) { const int kk = (k & ~0xC) | ((k & 4) << 1) | ((k & 8) >> 1); return ((kk >> 3) * 4 + (c >> 5)) * 512 + ((kk & 7) * 32 + (c & 31)) * 2; }
__device__ __forceinline__ int v_rd_base(int lane) { return ((lane & 3) << 3) | (((lane >> 2) & 3) << 6) | (((lane >> 4) & 1) << 5) | (((lane >> 5) & 1) << 8); }
constexpr int v_rd_off(int d0, int ks, int half) { return d0 * 512 + ks * 4096 + half * 2048; }
__device__ __forceinline__ int crow(int r, int hi) { return (r & 3) + 8 * (r >> 2) + 4 * hi; }
__device__ __forceinline__ unsigned cvtpk(float lo, float hi) { return pg8::cvt_pk_bf16(lo, hi); }
__device__ __forceinline__ void mask_tile(f32x16& p0, f32x16& p1, int dq) {
    const float NEG = -__builtin_inff();
#pragma unroll
    for (int r = 0; r < 16; ++r) { const int c = (r & 3) + 8 * (r >> 2); if (dq - c < 0) p0[r] = NEG; if (dq - c - 32 < 0) p1[r] = NEG; }
}
__device__ __forceinline__ void partialSM(f32x16& p0, f32x16& p1, float& m_reg, float& mn, float& alpha) {
    float pmax = p0[0];
#pragma unroll
    for (int r = 1; r < 16; ++r) pmax = fmaxf(pmax, p0[r]);
#pragma unroll
    for (int r = 0; r < 16; ++r) pmax = fmaxf(pmax, p1[r]);
    { auto rr = __builtin_amdgcn_permlane32_swap(__float_as_uint(pmax), __float_as_uint(pmax), false, false); pmax = fmaxf(__uint_as_float(rr[0]), __uint_as_float(rr[1])); }
    if (__builtin_expect(__all((pmax - m_reg) <= THR), 1)) { mn = m_reg; alpha = 1.f; }
    else { mn = fmaxf(m_reg, pmax); alpha = __builtin_amdgcn_exp2f(m_reg - mn); m_reg = mn; }
#pragma unroll
    for (int r = 0; r < 16; ++r) { p0[r] -= mn; p1[r] -= mn; }
#pragma unroll
    for (int r = 0; r < 16; ++r) p0[r] = __builtin_amdgcn_exp2f(p0[r]);
}
__device__ __forceinline__ void finishSM(f32x16& p0, f32x16& p1, float alpha, float& l_reg, bf16x8& pa0, bf16x8& pa1, bf16x8& pa2, bf16x8& pa3) {
#pragma unroll
    for (int r = 0; r < 16; ++r) p1[r] = __builtin_amdgcn_exp2f(p1[r]);
    float ps = 0;
#pragma unroll
    for (int r = 0; r < 16; ++r) ps += p0[r];
#pragma unroll
    for (int r = 0; r < 16; ++r) ps += p1[r];
    { auto rr = __builtin_amdgcn_permlane32_swap(__float_as_uint(ps), __float_as_uint(ps), false, false); ps = __uint_as_float(rr[0]) + __uint_as_float(rr[1]); }
    l_reg = l_reg * alpha + ps;
#define PK4(P, B_, OUT) do { unsigned a0 = cvtpk(P[B_+0], P[B_+1]), a1 = cvtpk(P[B_+2], P[B_+3]);                          \
        unsigned b0 = cvtpk(P[B_+4], P[B_+5]), b1 = cvtpk(P[B_+6], P[B_+7]);                                             \
        auto r0 = __builtin_amdgcn_permlane32_swap(a0, b0, false, false); auto r1 = __builtin_amdgcn_permlane32_swap(a1, b1, false, false); \
        u32x4 w = {r0[0], r1[0], r0[1], r1[1]}; OUT = __builtin_bit_cast(bf16x8, w); } while (0)
    PK4(p0, 0, pa0); PK4(p0, 8, pa1); PK4(p1, 0, pa2); PK4(p1, 8, pa3);
#undef PK4
}
template <int KB>
__device__ __forceinline__ void qkt(f32x16& p0, f32x16& p1, const char* K_lds, int r32, int hi, const bf16x8* qr) {
    p0 = f32x16{}; p1 = f32x16{};
#pragma unroll
    for (int d0 = 0; d0 < 4; ++d0) { const char* a = K_lds + KB * SHM_K + KSWZ(r32, (d0 * 16 + hi * 8) * 2);
        const bf16x8 b0 = *reinterpret_cast<const bf16x8*>(a);
        const bf16x8 b1 = *reinterpret_cast<const bf16x8*>(a + 32 * 128);
        p0 = __builtin_amdgcn_mfma_f32_32x32x16_bf16(b0, qr[d0], p0, 0, 0, 0);
        p1 = __builtin_amdgcn_mfma_f32_32x32x16_bf16(b1, qr[d0], p1, 0, 0, 0); }
}
template <int VB>
__device__ __forceinline__ void pv_tile(f32x16* o, int vb0, bf16x8 pa0, bf16x8 pa1, bf16x8 pa2, bf16x8 pa3) {
#define TRRD(dst, off) asm volatile("ds_read_b64_tr_b16 %0, %1 offset:%2" : "=&v"(dst) : "v"(vb0), "i"(off) : "memory")
#define PV_D0(d0) do { s16x4 l0, l1, l2, l3, h0, h1, h2, h3; constexpr int b_ = VB * SHM_V + v_rd_off(d0, 0, 0); \
        TRRD(l0, b_); TRRD(h0, b_ + 2048); TRRD(l1, b_ + 4096); TRRD(h1, b_ + 6144); TRRD(l2, b_ + 8192); TRRD(h2, b_ + 10240); TRRD(l3, b_ + 12288); TRRD(h3, b_ + 14336); \
        asm volatile("s_waitcnt lgkmcnt(0)" ::: "memory"); SBAR();   \
        o[d0] = __builtin_amdgcn_mfma_f32_32x32x16_bf16(pa0, (bf16x8){l0[0], l0[1], l0[2], l0[3], h0[0], h0[1], h0[2], h0[3]}, o[d0], 0, 0, 0);   \
        o[d0] = __builtin_amdgcn_mfma_f32_32x32x16_bf16(pa1, (bf16x8){l1[0], l1[1], l1[2], l1[3], h1[0], h1[1], h1[2], h1[3]}, o[d0], 0, 0, 0);   \
        o[d0] = __builtin_amdgcn_mfma_f32_32x32x16_bf16(pa2, (bf16x8){l2[0], l2[1], l2[2], l2[3], h2[0], h2[1], h2[2], h2[3]}, o[d0], 0, 0, 0);   \
        o[d0] = __builtin_amdgcn_mfma_f32_32x32x16_bf16(pa3, (bf16x8){l3[0], l3[1], l3[2], l3[3], h3[0], h3[1], h3[2], h3[3]}, o[d0], 0, 0, 0); } while (0)
    PV_D0(0); PV_D0(1); PV_D0(2); PV_D0(3);
#undef PV_D0
#undef TRRD
}
struct BlockRef { const bf16* Q; const bf16* K; const bf16* V; bf16* O; int P0; int mode; };
struct Seam { bf16x8 qr[4]; bf16x8 st_v0, st_v1, st_k0; };
#define VMW() asm volatile("s_waitcnt vmcnt(0)" ::: "memory")
#define VMWN(n) asm volatile("s_waitcnt vmcnt(%0)" :: "i"(n) : "memory")
#define SLOAD_H(Kp, Vp, k0) do { S.st_v0 = *(const bf16x8*)((Vp) + (size_t)((k0) + sr) * LD + sc); S.st_v1 = *(const bf16x8*)((Vp) + (size_t)((k0) + 32 + sr) * LD + sc); \
                                 S.st_k0 = *(const bf16x8*)((Kp) + (size_t)((k0) + kr) * LD + kc); } while (0)
#define SWRITE_HK(bf) do { *(bf16x8*)(K_lds + (bf) * SHM_K + kws) = S.st_k0; } while (0)
#define SWRITE_HV(bf) do { *(bf16x8*)(V_lds + (bf) * SHM_V + vst0) = S.st_v0; *(bf16x8*)(V_lds + (bf) * SHM_V + vst1) = S.st_v1; } while (0)
#define SWRITE_H(bf) do { SWRITE_HV(bf); SWRITE_HK(bf); } while (0)
__device__ __forceinline__ void attn_prime(const BlockRef& cur, char* lds, Seam& S) {
    int tid_ = threadIdx.x; asm volatile("" : "+v"(tid_)); const int tid = tid_, wid = __builtin_amdgcn_readfirstlane(tid >> 6), lane = tid & 63, r32 = lane & 31, hi = lane >> 5;
    const int sr = tid >> 4, sc = (tid & 15) * 8, kr = tid >> 3, kc = (tid & 7) * 8, kws = KSWZ(kr, kc * 2); char* K_lds = lds + OFF_K;
#pragma unroll
    for (int d0 = 0; d0 < 4; ++d0) S.qr[d0] = *(const bf16x8*)(cur.Q + (size_t)(wid * QBLK + r32) * LD + d0 * 16 + hi * 8);
    SLOAD_H(cur.K, cur.V, 0); VMW(); SWRITE_HK(0);
    __syncthreads();
}
__device__ __forceinline__ void attn_block(const BlockRef& cur, const BlockRef& nxt, char* lds, Seam& S, float lam, const float* subg) {
    int tid_ = threadIdx.x; asm volatile("" : "+v"(tid_)); const int tid = tid_, wid = __builtin_amdgcn_readfirstlane(tid >> 6), lane = tid & 63, r32 = lane & 31, hi = lane >> 5;
    const int NT = cur.P0 / KVBLK + QB / KVBLK;
    const int qlo = cur.P0 + wid * QBLK, qm = qlo + r32 - 4 * hi;
    char* V_lds = lds; char* K_lds = lds + OFF_K;
    float* ws = (float*)(lds + OFF_WS) + wid * 64; float* li_l = ws, * al_l = ws + 32;
    float m_reg = -1e30f, l_reg = 0; f32x16 o[4] = {};
    const int sr = tid >> 4, sc = (tid & 15) * 8, vst0 = v_st(sr, sc), vst1 = v_st(32 + sr, sc), kr = tid >> 3, kc = (tid & 7) * 8, kws = KSWZ(kr, kc * 2);
    const int vb0 = (int)(uintptr_t)V_lds + v_rd_base(lane);
    const bf16* Kh = cur.K; const bf16* Vh = cur.V;
#define RESC(a) do { if (__any((a) < 1.f)) { if (hi == 0) al_l[r32] = (a); asm volatile("s_waitcnt lgkmcnt(0)" ::: "memory");              \
                     _Pragma("unroll") for (int d_ = 0; d_ < 4; ++d_) _Pragma("unroll") for (int r = 0; r < 16; ++r) o[d_][r] *= al_l[crow(r, hi)]; } } while (0)
#define KBASE(t) ((t) * KVBLK)
#define MASKT(P0_, P1_, t) do { const int kb_ = KBASE(t); if (kb_ + KVBLK - 1 > qlo) mask_tile(P0_, P1_, qm - kb_); } while (0)
#define SEAM_K0() do { VMWN(4); SWRITE_HK(0); SBAR(); } while (0)
    f32x16 pA0, pA1, pB0, pB1; float mnA, mnB, alA, alB; bf16x8 pa0, pa1, pa2, pa3;
    SWRITE_HV(0); SBAR();
    if (NT > 1) { SLOAD_H(Kh, Vh, KBASE(1)); }
    SBAR(); qkt<0>(pA0, pA1, K_lds, r32, hi, S.qr);
    MASKT(pA0, pA1, 0); partialSM(pA0, pA1, m_reg, mnA, alA);
    if (NT > 1) { VMW(); SWRITE_H(1); }
    __syncthreads();
#define HALF_STEP(PX0, PX1, mnX, alX, PY0, PY1, alY, t, KB, VB, SB) do {                                                      \
        SBAR(); qkt<KB>(PX0, PX1, K_lds, r32, hi, S.qr);                                             \
        finishSM(PY0, PY1, alY, l_reg, pa0, pa1, pa2, pa3); SBAR();                                                           \
        if ((t) + 1 < NT) { SLOAD_H(Kh, Vh, KBASE((t) + 1)); SBAR(); }                                               \
        pv_tile<VB>(o, vb0, pa0, pa1, pa2, pa3); MASKT(PX0, PX1, (t)); partialSM(PX0, PX1, m_reg, mnX, alX);                                        \
        __syncthreads();                                                                                                      \
        if ((t) + 1 < NT) { VMW(); SWRITE_H(SB); }                                                                          \
        RESC(alX); __syncthreads(); } while (0)
    for (int t = 1; t + 1 < NT; t += 2) {
        HALF_STEP(pB0, pB1, mnB, alB, pA0, pA1, alA, t, 1, 0, 0);
        HALF_STEP(pA0, pA1, mnA, alA, pB0, pB1, alB, t + 1, 0, 1, 1);
    }
    SBAR(); qkt<1>(pB0, pB1, K_lds, r32, hi, S.qr); SBAR();
    SLOAD_H(nxt.K, nxt.V, 0); SBAR();
#pragma unroll
    for (int d0 = 0; d0 < 4; ++d0) S.qr[d0] = *(const bf16x8*)(nxt.Q + (size_t)(wid * QBLK + r32) * LD + d0 * 16 + hi * 8);
    SBAR();
    finishSM(pA0, pA1, alA, l_reg, pa0, pa1, pa2, pa3); SBAR();
    pv_tile<0>(o, vb0, pa0, pa1, pa2, pa3);
    MASKT(pB0, pB1, NT - 1); partialSM(pB0, pB1, m_reg, mnB, alB); __syncthreads(); RESC(alB);
    finishSM(pB0, pB1, alB, l_reg, pa0, pa1, pa2, pa3); SBAR(); pv_tile<1>(o, vb0, pa0, pa1, pa2, pa3);
    SBAR(); SEAM_K0();
    if (hi == 0) li_l[r32] = l_reg; asm volatile("s_waitcnt lgkmcnt(0)" ::: "memory");
    float rli[16];
#pragma unroll
    for (int r = 0; r < 16; ++r) rli[r] = __builtin_amdgcn_rcpf(li_l[crow(r, hi)]);
    bf16* stg = (bf16*)(lds + OFF_OST) + wid * 4096;
#pragma unroll
    for (int r = 0; r < 16; ++r) { const int orow = crow(r, hi);
#pragma unroll
        for (int d0 = 0; d0 < 4; ++d0) { const float v = o[d0][r] * rli[r]; stg[orow * 128 + d0 * 32 + r32] = (bf16)(cvtpk(v, v) & 0xffffu); } }
    asm volatile("s_waitcnt lgkmcnt(0)" ::: "memory");
    bf16* Ow = cur.O + (size_t)(wid * QBLK) * LD;
    if (cur.mode == 0) {
#pragma unroll
        for (int i = 0; i < 8; ++i) { const int row = i * 4 + (lane >> 4), ch = lane & 15; *(u32x4*)(Ow + (size_t)row * LD + ch * 8) = *(const u32x4*)(stg + row * 128 + ch * 8); }
    } else {
        f32x4 ga = *(const f32x4*)(subg + (lane & 15) * 8), gb = *(const f32x4*)(subg + (lane & 15) * 8 + 4);
#pragma unroll
        for (int i = 0; i < 8; ++i) { const int row = i * 4 + (lane >> 4), ch = lane & 15; bf16* p = Ow + (size_t)row * LD + ch * 8;
            const u32x4 v = *(const u32x4*)(stg + row * 128 + ch * 8), pv = *(const u32x4*)p; float d[8]; float ss = 0.f;
#pragma unroll
            for (int j = 0; j < 4; ++j) { d[2 * j] = __uint_as_float(pv[j] << 16) - lam * __uint_as_float(v[j] << 16); d[2 * j + 1] = __uint_as_float(pv[j] & 0xffff0000u) - lam * __uint_as_float(v[j] & 0xffff0000u); }
#pragma unroll
            for (int j = 0; j < 8; ++j) ss += d[j] * d[j];
            ss += pg8::swz_xor<1>(ss); ss += pg8::swz_xor<2>(ss); ss += pg8::swz_xor<4>(ss); ss += pg8::swz_xor<8>(ss);
            const float rs = rsqrtf(ss * (1.f / 128.f) + 1e-6f) * 0.8f;
            u32x4 w; w[0] = cvtpk(d[0] * rs * ga[0], d[1] * rs * ga[1]); w[1] = cvtpk(d[2] * rs * ga[2], d[3] * rs * ga[3]); w[2] = cvtpk(d[4] * rs * gb[0], d[5] * rs * gb[1]); w[3] = cvtpk(d[6] * rs * gb[2], d[7] * rs * gb[3]);
            *(u32x4*)p = w; }
    }
    __syncthreads();
#undef RESC
#undef KBASE
#undef MASKT
#undef SEAM_K0
#undef HALF_STEP
}
#undef VMW
#undef VMWN
#undef SLOAD_H
#undef SWRITE_HK
#undef SWRITE_HV
#undef SWRITE_H
__device__ __forceinline__ BlockRef block_ref(int n, int vcu, int G, const bf16* Q, const bf16* K, const bf16* V, bf16* O) {
    const int w = vcu + (n >> 2) * G, i = (n >> 1) & 1, c = n & 1, bh = w >> 2, s = w & 3, b = bh >> 3, h = bh & 7, qb = i == 0 ? s : 7 - s;
    const size_t r0 = (size_t)b * SEQ; BlockRef r;
    r.Q = Q + (r0 + (size_t)qb * QB) * LD + (2 * h + c) * 64; r.K = K + r0 * LD + (2 * h + c) * 64; r.V = V + r0 * LD + h * 128; r.O = O + (r0 + (size_t)qb * QB) * LD + h * 128; r.P0 = qb * QB; r.mode = c;
    return r;
}
__device__ __forceinline__ void attn_phase(char* lds, const bf16* Q, const bf16* K, const bf16* V, bf16* O, int vcu, int G, float lam, const float* subg) {
    const int nblk = ((1024 - vcu + G - 1) / G) * 4;
    if (nblk <= 0) return;
    BlockRef cur = block_ref(0, vcu, G, Q, K, V, O); Seam S;
    attn_prime(cur, lds, S);
    for (int n = 0; n < nblk; ++n) {
        const BlockRef nxt = (n + 1 < nblk) ? block_ref(n + 1, vcu, G, Q, K, V, O) : cur;
        attn_block(cur, nxt, lds, S, lam, subg);
        cur = nxt;
    }
}
#undef KSWZ
#undef SBAR
}

constexpr int NWAVES = 8;
constexpr int BATCH = 32, SEQ = 2048, D = 1024, M = BATCH * SEQ, DIN = 8192, DFF = 2816, NGU = 2 * DFF, NMOD = 6 * D;
constexpr size_t MiB = 1u << 20;
constexpr size_t WS_S0 = 0, WS_S1 = 128 * MiB, WS_S2 = 256 * MiB, WS_S3 = 384 * MiB, WS_S4 = 512 * MiB, WS_S5 = 640 * MiB;
constexpr size_t WS_WIN = 768 * MiB, WS_WA = WS_WIN + 16 * MiB, WS_WB = WS_WA + 2 * MiB, WS_WO = WS_WB + 2 * MiB, WS_WGU = WS_WO + 2 * MiB, WS_WDN = WS_WGU + 11 * MiB, WS_MOD = WS_WDN + 6 * MiB, WS_CTL = WS_MOD + 1 * MiB, WS_END = WS_CTL + 1 * MiB;
constexpr int RING_BYTES = 131072, LDS_BYTES = 147456;
#define LAS __attribute__((address_space(3)))
typedef unsigned short bf16;
typedef unsigned v4u __attribute__((ext_vector_type(4)));
typedef unsigned v2u __attribute__((ext_vector_type(2)));
typedef float f32x4 __attribute__((ext_vector_type(4)));
__device__ __forceinline__ unsigned pk2(float lo, float hi) { return pg8::cvt_pk_bf16(lo, hi); }
__device__ __forceinline__ float wave_sum(float v) { return pg8::wave_sum64(v); }
__device__ __forceinline__ void transpose_item(const float* W, int K, int N, int src_col0, bf16* WT, int dst_row0, int k0, LAS float* scr, int lane) {
#pragma unroll 8
    for (int i = 0; i < 32; ++i) { const int kk = 2 * i + (lane >> 5); scr[kk * 33 + (lane & 31)] = W[(size_t)(k0 + kk) * N + src_col0 + (lane & 31)]; }
    asm volatile("s_waitcnt lgkmcnt(0)" ::: "memory");
    const int c = lane & 7;
#pragma unroll
    for (int j = 0; j < 4; ++j) { const int n = (lane >> 3) + 8 * j; const LAS float* s = scr + (8 * c) * 33 + n;
        v4u o; o.x = pk2(s[0 * 33], s[1 * 33]); o.y = pk2(s[2 * 33], s[3 * 33]); o.z = pk2(s[4 * 33], s[5 * 33]); o.w = pk2(s[6 * 33], s[7 * 33]);
        *(v4u*)(WT + (size_t)(dst_row0 + n) * K + k0 + 8 * c) = o; }
    asm volatile("s_waitcnt lgkmcnt(0)" ::: "memory");
}
__device__ __forceinline__ int win_src(int n0) {
    if (n0 < 1024) return 3072 + n0;
    if (n0 < 3072) { const int p = (n0 - 1024) >> 8, s = n0 & 255; return s < 128 ? 4096 + 128 * p + s : 5120 + 128 * p + (s - 128); }
    if (n0 < 4096) return 6144 + (n0 - 3072);
    if (n0 < 6144) { const int m = n0 - 4096, pn = m >> 8, s = m & 255, bj = s >> 7, wc = (s & 127) >> 5; return pn * 256 + 64 * wc + 32 * bj; }
    if (n0 < 7168) return 2048 + (n0 - 6144);
    return n0;
}
__device__ __forceinline__ int wgu_src(int n0) { const int p = n0 >> 8, s = n0 & 255; return s < 128 ? 128 * p + s : DFF + 128 * p + (s - 128); }

__device__ __forceinline__ void norm_rows(const float* X, const float* g, const float* modsh, const float* modsc, bf16* H, int rb, int lane) {
    const size_t row0 = (size_t)rb * 32; const int b = (int)(row0 >> 11);
    f32x4 av[4], sv[4];
#pragma unroll
    for (int j = 0; j < 4; ++j) { const int idx = 4 * lane + 256 * j; const f32x4 gg = *(const f32x4*)(g + idx), sc = *(const f32x4*)(modsc + (size_t)b * NMOD + idx); av[j] = gg * (sc + 1.0f); sv[j] = *(const f32x4*)(modsh + (size_t)b * NMOD + idx); }
#pragma unroll 2
    for (int r = 0; r < 32; ++r) {
        const f32x4* xr = (const f32x4*)(X + (row0 + r) * D) + lane;
        f32x4 v[4]; float s = 0.f;
#pragma unroll
        for (int j = 0; j < 4; ++j) { v[j] = xr[64 * j]; s += (v[j].x * v[j].x + v[j].y * v[j].y) + (v[j].z * v[j].z + v[j].w * v[j].w); }
        const float rstd = rsqrtf(wave_sum(s) * (1.f / D) + 1e-6f);
        v2u* o8 = (v2u*)(H + (row0 + r) * D) + lane;
#pragma unroll
        for (int j = 0; j < 4; ++j) { const f32x4 y = v[j] * rstd * av[j] + sv[j]; v2u w; w.x = pk2(y.x, y.y); w.y = pk2(y.z, y.w); o8[64 * j] = w; }
    }
}

#define XB_TMO      128
#define XB_XCNT(j)  (256  + 64 * (j))
#define XB_XSUB(j)  (1280 + 64 * (j))
#define XB_XGEN(j)  (2304 + 64 * (j))
#define XB_TOP      3328
#define XB_TOPGEN   3392
#define XCD_BAR_WORDS 3456
#define XB_SPIN_CAP (1u << 18)

__device__ __forceinline__ unsigned xb_ld(unsigned* p)              { return __hip_atomic_load(p, __ATOMIC_RELAXED, __HIP_MEMORY_SCOPE_AGENT); }
__device__ __forceinline__ unsigned xb_add(unsigned* p, unsigned v) { return __hip_atomic_fetch_add(p, v, __ATOMIC_RELAXED, __HIP_MEMORY_SCOPE_AGENT); }
__device__ __forceinline__ unsigned xb_xcc_id() { return (unsigned)__builtin_amdgcn_s_getreg((3 << 11) | 20) & 0xFu; }
#define XB_SPIN(cond, bar) do { unsigned _sp = 0; while (cond) { __builtin_amdgcn_s_sleep(1); \
    if ((++_sp & 255u) == 0u) { if (xb_ld(&(bar)[XB_TMO])) break; if (_sp > XB_SPIN_CAP) { atomicAdd(&(bar)[XB_TMO], 1u); break; } } } } while (0)

struct XcdBarrier {
    unsigned* bar; unsigned x;
    volatile LAS unsigned* st;
};

__device__ __forceinline__ XcdBarrier xcd_barrier_post(unsigned* bar, volatile LAS unsigned* st) {
    XcdBarrier b; b.bar = bar; b.x = xb_xcc_id(); b.st = st;
    if (threadIdx.x == 0) (void)xb_add(&bar[XB_XCNT(b.x)], 1u);
    return b;
}
__device__ __forceinline__ void xcd_barrier_complete(unsigned* bar, unsigned x, unsigned& nloc, unsigned& nx) {
    const unsigned G = gridDim.x * gridDim.y * gridDim.z;
    unsigned sum, cnt, mine, sp = 0u;
    for (;;) {
        sum = 0u; cnt = 0u; mine = 0u;
#pragma unroll
        for (unsigned j = 0; j < 16; ++j) { const unsigned c = xb_ld(&bar[XB_XCNT(j)]); sum += c; cnt += (c > 0u) ? 1u : 0u; mine = (j == x) ? c : mine; }
        if (sum == G) break;
        __builtin_amdgcn_s_sleep(1);
        if ((++sp & 255u) == 0u) { if (xb_ld(&bar[XB_TMO])) break; if (sp > XB_SPIN_CAP) { atomicAdd(&bar[XB_TMO], 1u); break; } }
    }
    nloc = mine > 0u ? mine : 1u; nx = cnt > 0u ? cnt : 1u;
}

__device__ __forceinline__ void xcd_barrier(const XcdBarrier& b) {
    asm volatile("s_waitcnt vmcnt(0)" ::: "memory");
    __syncthreads();
    if (threadIdx.x == 0) {
        unsigned* bar = b.bar;
        __builtin_amdgcn_s_waitcnt(0);
        unsigned nloc = b.st[0], nx = b.st[1];
        if (nloc == 0u) { xcd_barrier_complete(bar, b.x, nloc, nx); b.st[0] = nloc; b.st[1] = nx; }
        const unsigned old = xb_add(&bar[XB_XSUB(b.x)], 1u);
        const unsigned gen = old / nloc;
        if (old + 1u == (gen + 1u) * nloc) {
            __builtin_amdgcn_fence(__ATOMIC_RELEASE, "agent");
            asm volatile("s_waitcnt vmcnt(0)" ::: "memory");
            const unsigned og = xb_add(&bar[XB_TOP], 1u);
            const unsigned tg = og / nx;
            if (og + 1u == (tg + 1u) * nx) xb_add(&bar[XB_TOPGEN], 1u);
            else XB_SPIN(xb_ld(&bar[XB_TOPGEN]) == tg, bar);
            __builtin_amdgcn_fence(__ATOMIC_ACQUIRE, "agent");
            xb_add(&bar[XB_XGEN(b.x)], 1u);
            asm volatile("s_waitcnt vmcnt(0)" ::: "memory");
        } else {
            XB_SPIN(xb_ld(&bar[XB_XGEN(b.x)]) == gen, bar);
            __builtin_amdgcn_fence(__ATOMIC_ACQUIRE, "agent");
            asm volatile("s_waitcnt vmcnt(0)" ::: "memory");
        }
    }
    __syncthreads();
}

struct Args { const float* in[20]; float* out; unsigned char* ws; };
__global__ void __launch_bounds__(NWAVES * 64, 2) fwd_megakernel(Args args) {
    extern __shared__ __attribute__((aligned(16))) unsigned char lds[];
    cg::grid_group grid = cg::this_grid();
    const int G = gridDim.x, bx = blockIdx.x, vcu = (G % 8 == 0) ? (bx % 8) * (G / 8) + bx / 8 : bx;
    const int NGW = G * NWAVES;
#define GRID_SYNC() do { xcd_barrier(xbar); asm volatile("" ::: "memory"); } while (0)
#define PHASE_IDS() int tid = threadIdx.x; asm volatile("" : "+v"(tid)); const int lane = tid & 63, wave = __builtin_amdgcn_readfirstlane(tid >> 6), gw = vcu * NWAVES + wave; (void)lane; (void)gw
    unsigned char* ws = args.ws;
    const float* x = args.in[0];
    bf16* S0 = (bf16*)(ws + WS_S0); bf16* S1 = (bf16*)(ws + WS_S1); bf16* S2 = (bf16*)(ws + WS_S2); bf16* S3 = (bf16*)(ws + WS_S3); bf16* S4 = (bf16*)(ws + WS_S4); bf16* S5 = (bf16*)(ws + WS_S5);
    bf16* WIN = (bf16*)(ws + WS_WIN); bf16* WA = (bf16*)(ws + WS_WA); bf16* WB = (bf16*)(ws + WS_WB); bf16* WO = (bf16*)(ws + WS_WO); bf16* WGU = (bf16*)(ws + WS_WGU); bf16* WDN = (bf16*)(ws + WS_WDN);
    float* mod = (float*)(ws + WS_MOD);
    float* X1 = (float*)(ws + WS_S1);
    LAS unsigned char* ldsl = (LAS unsigned char*)lds;
    volatile LAS unsigned* MISC = (volatile LAS unsigned*)(ldsl + RING_BYTES + 320);
    if (threadIdx.x < 32) MISC[threadIdx.x] = 0u;
    __syncthreads();
    XcdBarrier xbar = xcd_barrier_post((unsigned*)(ws + WS_CTL), MISC + 8);
    grid.sync();

    if (bx < 96) {
        PHASE_IDS();
        LAS float* cact = (LAS float*)ldsl;
        const float* c = args.in[1];
        for (int i = tid; i < BATCH * D; i += NWAVES * 64) { const int b = i >> 10, k = i & 1023; const float cv = c[i]; cact[k * 32 + b] = cv / (1.f + __expf(-cv)); }
        __syncthreads();
        const float* wada = args.in[2]; const int col = bx * 64 + lane, k0 = wave * 128;
        float acc[32];
#pragma unroll
        for (int b = 0; b < 32; ++b) acc[b] = 0.f;
#pragma unroll 4
        for (int kk = 0; kk < 128; ++kk) { const float w = wada[(size_t)(k0 + kk) * NMOD + col]; const LAS f32x4* cp = (const LAS f32x4*)(cact + (k0 + kk) * 32);
#pragma unroll
            for (int j = 0; j < 8; ++j) { const f32x4 cv = cp[j]; acc[4 * j] += w * cv.x; acc[4 * j + 1] += w * cv.y; acc[4 * j + 2] += w * cv.z; acc[4 * j + 3] += w * cv.w; } }
        __syncthreads();
        LAS float* part = (LAS float*)ldsl;
#pragma unroll
        for (int b = 0; b < 32; ++b) part[(wave * 32 + b) * 64 + lane] = acc[b];
        __syncthreads();
        const float* bada = args.in[3];
        for (int o = tid; o < 2048; o += NWAVES * 64) { const int b = o >> 6, cl = o & 63; float s = 0.f;
#pragma unroll
            for (int w = 0; w < 8; ++w) s += part[(w * 32 + b) * 64 + cl];
            mod[(size_t)b * NMOD + bx * 64 + cl] = s + bada[bx * 64 + cl]; }
        __syncthreads();
    }
    {
        PHASE_IDS();
        LAS float* scr = (LAS float*)(ldsl + wave * 16384);
        constexpr int I_IN = 16 * 256, I_SQ = 16 * 32, I_GU = 16 * 176, I_DN = 44 * 32, NITEMS = I_IN + 3 * I_SQ + I_GU + I_DN;
        for (int it = gw; it < NITEMS; it += NGW) {
            int r = it;
            if (r < I_IN) { const int kb = r >> 8, nb = r & 255; transpose_item(args.in[5], D, DIN, win_src(32 * nb), WIN, 32 * nb, 64 * kb, scr, lane); continue; } r -= I_IN;
            if (r < I_SQ) { const int kb = r >> 5, nb = r & 31; transpose_item(args.in[14], D, D, 32 * nb, WA, 32 * nb, 64 * kb, scr, lane); continue; } r -= I_SQ;
            if (r < I_SQ) { const int kb = r >> 5, nb = r & 31; transpose_item(args.in[15], D, D, 32 * nb, WB, 32 * nb, 64 * kb, scr, lane); continue; } r -= I_SQ;
            if (r < I_SQ) { const int kb = r >> 5, nb = r & 31; transpose_item(args.in[16], D, D, 32 * nb, WO, 32 * nb, 64 * kb, scr, lane); continue; } r -= I_SQ;
            if (r < I_GU) { const int kb = r / 176, nb = r % 176; transpose_item(args.in[18], D, NGU, wgu_src(32 * nb), WGU, 32 * nb, 64 * kb, scr, lane); continue; } r -= I_GU;
            { const int kb = r >> 5, nb = r & 31; transpose_item(args.in[19], DFF, D, 32 * nb, WDN, 32 * nb, 64 * kb, scr, lane); }
        }
    }
    GRID_SYNC();
#ifdef EXP_BAR10
    GRID_SYNC(); GRID_SYNC(); GRID_SYNC(); GRID_SYNC(); GRID_SYNC(); GRID_SYNC(); GRID_SYNC(); GRID_SYNC(); GRID_SYNC(); GRID_SYNC();
#endif
    { PHASE_IDS(); for (int rb = gw; rb < M / 32; rb += NGW) norm_rows(x, args.in[4], mod, mod + D, S0, rb, lane); }
    GRID_SYNC();

    pg8::StaticOrder SO; pg8::Gemm g; pg8::EpiAll E{};
    g = pg8::Gemm{S0, WIN, M, 4096, D}; SO.init(M, 4096, G, bx);
    E.mode = 5; E.o3 = S1; E.o4 = S2; E.o5 = S3;
    pg8::gemm_phase<pg8::EpiAll, pg8::StaticOrder, true, true>(ldsl, g, SO, E);
    GRID_SYNC();
    {
        PHASE_IDS();
        const float* cw = args.in[6]; const int NT = G * NWAVES * 64, gt = vcu * (NWAVES * 64) + tid;
        for (int it = gt; it < (M / 16) * 128; it += NT) {
            const int cgp = it & 127, rbk = it >> 7; const size_t t0 = (size_t)rbk * 16; const int c0 = cgp * 8;
            f32x4 w0a = *(const f32x4*)(cw + c0), w0b = *(const f32x4*)(cw + c0 + 4), w1a = *(const f32x4*)(cw + D + c0), w1b = *(const f32x4*)(cw + D + c0 + 4), w2a = *(const f32x4*)(cw + 2 * D + c0), w2b = *(const f32x4*)(cw + 2 * D + c0 + 4);
            f32x4 p2a = {0.f, 0.f, 0.f, 0.f}, p2b = p2a, p1a = p2a, p1b = p2a;
            if ((t0 & (SEQ - 1)) != 0) { pg8::unpack8(*(const v4u*)(S2 + (t0 - 2) * D + c0), p2a, p2b); pg8::unpack8(*(const v4u*)(S2 + (t0 - 1) * D + c0), p1a, p1b); }
#pragma unroll 4
            for (int r = 0; r < 16; ++r) { f32x4 ua, ub, ba, bb; pg8::unpack8(*(const v4u*)(S2 + (t0 + r) * D + c0), ua, ub); pg8::unpack8(*(const v4u*)(S1 + (t0 + r) * D + c0), ba, bb);
                const f32x4 ya = ba * (w0a * p2a + w1a * p1a + w2a * ua), yb = bb * (w0b * p2b + w1b * p1b + w2b * ub);
                *(v4u*)(S1 + (t0 + r) * D + c0) = pg8::pack8(ya, yb); p2a = p1a; p2b = p1b; p1a = ua; p1b = ub; }
        }
    }
    GRID_SYNC();
    SO.init(M, D, G, bx);
    g = pg8::Gemm{S1, WA, M, D, D}; E.mode = 1; E.o0 = S3; E.o1 = S3;
    pg8::gemm_phase<pg8::EpiAll, pg8::StaticOrder, true, true>(ldsl, g, SO, E);
    GRID_SYNC();
    g = pg8::Gemm{S0, WIN + (size_t)4096 * D, M, 4096, D}; SO.init(M, 4096, G, bx);
    E.mode = 0; E.o0 = S1; E.o1 = S2; E.o2 = S4; E.o6 = S5; E.f0 = args.in[7]; E.f1 = args.in[8];
    pg8::gemm_phase<pg8::EpiAll, pg8::StaticOrder, true, true>(ldsl, g, SO, E);
    GRID_SYNC();
    {
        PHASE_IDS();
        float l1 = args.in[9][lane] * args.in[10][lane], l2 = args.in[11][lane] * args.in[12][lane];
        l1 = wave_sum(l1); l2 = wave_sum(l2);
        const float lam = __uint_as_float(__builtin_amdgcn_readfirstlane(__float_as_uint(__expf(l1) - __expf(l2) + 0.2f)));
        attn2::attn_phase((char*)lds, S1, S2, S4, S0, vcu, G, lam, args.in[13]);
    }
    GRID_SYNC();
    SO.init(M, D, G, bx);
    g = pg8::Gemm{S0, WB, M, D, D}; E.mode = 2; E.o0 = S3; E.o1 = S5;
    pg8::gemm_phase<pg8::EpiAll, pg8::StaticOrder, true, true>(ldsl, g, SO, E);
    GRID_SYNC();
#ifdef EXP_NOFFN
    g = pg8::Gemm{S3, WO, M, D, D}; E.mode = 3; E.f0 = x; E.f1 = mod + 2 * D; E.fo = args.out;
    pg8::gemm_phase<pg8::EpiAll, pg8::StaticOrder, true, true>(ldsl, g, SO, E);
    return;
#endif
    g = pg8::Gemm{S3, WO, M, D, D}; E.mode = 3; E.f0 = x; E.f1 = mod + 2 * D; E.fo = X1;
    pg8::gemm_phase<pg8::EpiAll, pg8::StaticOrder, true, true>(ldsl, g, SO, E);
    GRID_SYNC();
    { PHASE_IDS(); for (int rb = gw; rb < M / 32; rb += NGW) norm_rows(X1, args.in[17], mod + 3 * D, mod + 4 * D, S0, rb, lane); }
    GRID_SYNC();
    g = pg8::Gemm{S0, WGU, M, NGU, D}; SO.init(M, NGU, G, bx); E.mode = 4; E.o0 = S3;
    pg8::gemm_phase<pg8::EpiAll, pg8::StaticOrder, true, true>(ldsl, g, SO, E);
    GRID_SYNC();
    g = pg8::Gemm{S3, WDN, M, D, DFF}; SO.init(M, D, G, bx); E.mode = 3; E.f0 = X1; E.f1 = mod + 5 * D; E.fo = args.out;
    pg8::gemm_phase<pg8::EpiAll, pg8::StaticOrder, true, true>(ldsl, g, SO, E);
}

extern "C" void kernel_launch(void* const* d_in, const int* in_sizes, int n_in, void* d_out, int out_size, void* d_ws, size_t ws_size, hipStream_t stream) {
    static int grid = 0;
    if (grid == 0) {
        if (n_in != 20 || in_sizes[0] != M * D || out_size != M * D || ws_size < WS_END) { fprintf(stderr, "kernel_launch: unexpected shapes (n_in %d, in0 %d, out %d, ws %zu)\n", n_in, n_in > 0 ? in_sizes[0] : -1, out_size, ws_size); grid = -1; return; }
        int dev = 0, cus = 0, per_cu = 0;
        (void)hipGetDevice(&dev); (void)hipDeviceGetAttribute(&cus, hipDeviceAttributeMultiprocessorCount, dev);
        (void)hipFuncSetAttribute((const void*)fwd_megakernel, hipFuncAttributeMaxDynamicSharedMemorySize, LDS_BYTES);
        if (hipOccupancyMaxActiveBlocksPerMultiprocessor(&per_cu, (const void*)fwd_megakernel, NWAVES * 64, LDS_BYTES) != hipSuccess || per_cu < 1) per_cu = 1;
        (void)hipGetLastError();
        grid = cus * per_cu;
    }
    if (grid < 0) return;
    (void)hipMemsetAsync((unsigned char*)d_ws + WS_CTL, 0, 16384, stream);
    Args a{};
    for (int i = 0; i < 20; ++i) a.in[i] = (const float*)d_in[i];
    a.out = (float*)d_out; a.ws = (unsigned char*)d_ws;
    void* kargs[] = {&a};
    hipError_t e = hipLaunchCooperativeKernel((const void*)fwd_megakernel, dim3(grid), dim3(NWAVES * 64), kargs, LDS_BYTES, stream);
    if (e != hipSuccess) fprintf(stderr, "cooperative launch failed: %s (grid %d)\n", hipGetErrorString(e), grid);
}
```

```cpp
#define FULL_LINE 1
#include <hip/hip_runtime.h>
#include <hip/hip_cooperative_groups.h>
#include <hip/hip_bf16.h>
#include <cstdio>
#include <cstdint>
#include <cmath>
namespace cg = cooperative_groups;
#ifndef PG8_WGM
#define PG8_WGM 8
#endif
namespace pg8 {
#define PG8_LAS __attribute__((address_space(3)))
typedef unsigned short bf16_t;
typedef short bf16x8 __attribute__((ext_vector_type(8)));
typedef float f32x4 __attribute__((ext_vector_type(4)));
typedef unsigned u32x4 __attribute__((ext_vector_type(4)));
constexpr int BM = 256, BK = 64, HALF = 128, HTB = HALF * BK * 2  , STAGE_BYTES = 8 * HTB, NXCD = 8, WGM = PG8_WGM;

__host__ __device__ __forceinline__ int lds_byte(int r, int c) { const int st = (r >> 4) * 2 + (c >> 5), rr = r & 15, cc = c & 31, ob = rr * 64 + cc * 2; return st * 1024 + (ob ^ (((ob >> 9) & 1) << 5)); }
__host__ __device__ __forceinline__ void stage_rc(int b, int& R, int& C) { const int st = b / 1024, sb = b % 1024, swz = sb ^ (((sb >> 9) & 1) << 5); R = (st >> 1) * 16 + swz / 64; C = (st & 1) * 32 + (swz % 64) / 2; }
__host__ __device__ __forceinline__ int perm32(int rho) { const int n = rho >> 4, i = rho & 15; return 8 * (i >> 2) + 4 * n + (i & 3); }

struct Unit { int pm, pn; };
struct Gemm { const bf16_t* A; const bf16_t* Bt; int M, N, K; };

struct StaticOrder {
    int nM, nN, nwg, G, c, panel;
    __host__ __device__ void init(int M, int N, int G_, int c_) { nM = M / BM; nN = N / BM; nwg = nM * nN; G = G_; c = c_; panel = 0; }
    __host__ __device__ bool next(int i, Unit& u) const {
        if (panel) { const int p_ = c + G * (i / nN); if (p_ >= nM) return false; u.pm = p_; u.pn = i % nN; return true; }
        const long L = (long)i * G + c; if (L >= nwg) return false;
        int wgid = (int)L; { const int q = nwg / NXCD, r = nwg % NXCD, xcd = wgid % NXCD, off = wgid / NXCD; wgid = (xcd < r ? xcd * (q + 1) : r * (q + 1) + (xcd - r) * q) + off; }
        const int nig = WGM * nN, gid = wgid / nig, fm = gid * WGM, gsz = (nM - fm) < WGM ? (nM - fm) : WGM;
        u.pm = fm + ((wgid % nig) % gsz); u.pn = (wgid % nig) / gsz; return true;
    }
    __device__ __forceinline__ void a_ready(const Unit&) const {}
    __device__ __forceinline__ void done(const Unit&) const {}
};
typedef float f32x2 __attribute__((ext_vector_type(2))); typedef __bf16 bf16x2_t __attribute__((ext_vector_type(2)));
__device__ __forceinline__ unsigned cvt_pk_bf16(float lo, float hi) { f32x2 v = {lo, hi}; bf16x2_t b = __builtin_convertvector(v, bf16x2_t); return __builtin_bit_cast(unsigned, b); }
constexpr float EPSF = 1e-6f;
constexpr float QC2 = 0.125f * 1.4426950408889634f;
__device__ __forceinline__ u32x4 pack8(const f32x4 a, const f32x4 b) { u32x4 w; w.x = cvt_pk_bf16(a[0], a[1]); w.y = cvt_pk_bf16(a[2], a[3]); w.z = cvt_pk_bf16(b[0], b[1]); w.w = cvt_pk_bf16(b[2], b[3]); return w; }
__device__ __forceinline__ float bf_lo(unsigned u) { return __uint_as_float(u << 16); }
__device__ __forceinline__ float bf_hi(unsigned u) { return __uint_as_float(u & 0xffff0000u); }
__device__ __forceinline__ void unpack8(const u32x4 w, f32x4& a, f32x4& b) { a = (f32x4){bf_lo(w.x), bf_hi(w.x), bf_lo(w.y), bf_hi(w.y)}; b = (f32x4){bf_lo(w.z), bf_hi(w.z), bf_lo(w.w), bf_hi(w.w)}; }
template <int X> __device__ __forceinline__ float swz_xor(float v) { return __uint_as_float((unsigned)__builtin_amdgcn_ds_swizzle((int)__float_as_uint(v), (X << 10) | 0x1f)); }
__device__ __forceinline__ float wave_sum64(float v) { v += swz_xor<1>(v); v += swz_xor<2>(v); v += swz_xor<4>(v); v += swz_xor<8>(v); v += swz_xor<16>(v);
    auto rr = __builtin_amdgcn_permlane32_swap(__float_as_uint(v), __float_as_uint(v), false, false); return __uint_as_float(rr[0]) + __uint_as_float(rr[1]); }
__device__ __forceinline__ float sigm(float x) { return __builtin_amdgcn_rcpf(1.f + __builtin_amdgcn_exp2f(-1.4426950408889634f * x)); }
#ifdef EXP_NOSIG
__device__ __forceinline__ f32x4 sigm4(const f32x4 v) { return v * 0.25f + 0.5f; }
#else
__device__ __forceinline__ f32x4 sigm4(const f32x4 v) { return (f32x4){sigm(v[0]), sigm(v[1]), sigm(v[2]), sigm(v[3])}; }
#endif

template <class T> __device__ __forceinline__ void st_g(T* p, const T v) { *(__attribute__((address_space(1))) T*)p = v; }
template <class T> __device__ __forceinline__ T ld_g(const T* p) { return *(const __attribute__((address_space(1))) T*)p; }
#ifndef EPI_NT_STORES
#define ST_NT(p, v) st_g((p), (v))
#else
#define ST_NT(p, v) __builtin_nontemporal_store((v), (p))
#endif
struct EpiP { bf16_t *o0, *o1, *o2, *o3, *o4, *o5, *o6; const float *f0, *f1; float* fo; };
constexpr unsigned EPI_LDS_ADDR = 131072 + 512;
#ifdef FULL_LINE
#define PL_COL (64 * wc + 8 * fq)
#define PL_BJ 32
#else
#define PL_COL (wc * 32 + 8 * fq)
#define PL_BJ HALF
#endif
struct EpiAll {
    static constexpr bool PERM = true, AFTER_DRAIN = false;
    int mode;
    __device__ __forceinline__ int vm_ops(const Unit& un) const {
        if (mode == 0 || mode == 1 || mode == 2) return 16;
        if (mode == 5) return (un.pn >= 4 && un.pn < 12) ? 8 : 16;
        if (mode == 3) return 32;
        if (mode == 4 || mode == 6) return 8;
        return 0; }
    __device__ __forceinline__ void operator()(const f32x4 (&acc)[2][2][4][2], const Unit& un, int wr, int wc, int fr, int fq) const {
        const PG8_LAS EpiP* P = (const PG8_LAS EpiP*)EPI_LDS_ADDR; const int pn = un.pn; const size_t row0 = (size_t)(mode == 98 ? 0 : un.pm) * BM + wr * 64 + fr;
        if (mode == 99) {
            f32x4 s = {0.f, 0.f, 0.f, 0.f};
#pragma unroll
            for (int ai = 0; ai < 2; ++ai)
#pragma unroll
                for (int bj = 0; bj < 2; ++bj)
#pragma unroll
                    for (int m = 0; m < 4; ++m) { s += acc[ai][bj][m][0]; s += acc[ai][bj][m][1]; }
            if (s[0] + s[1] + s[2] + s[3] == 12345.678f) P->o0[0] = 1;
            return; }
        if (mode == 0) {
            if (pn < 8) {
                const bool isq = pn < 4; bf16_t* base = isq ? P->o0 : P->o1; const float* g = isq ? P->f0 : P->f1; const float sc = isq ? QC2 : 1.f;
                f32x4 gv[2][2];
#pragma unroll
                for (int bj = 0; bj < 2; ++bj)
#pragma unroll
                    for (int n = 0; n < 2; ++n) gv[bj][n] = ld_g((const f32x4*)(g + 32 * bj + 8 * fq + 4 * n)) * sc;
                const int col0 = (pn & 3) * 256 + 64 * wc + 8 * fq;
#pragma unroll
                for (int ai = 0; ai < 2; ++ai)
#pragma unroll
                    for (int m = 0; m < 4; ++m) {
                        float ss = 0.f;
#pragma unroll
                        for (int bj = 0; bj < 2; ++bj)
#pragma unroll
                            for (int n = 0; n < 2; ++n) { const f32x4 x = acc[ai][bj][m][n]; ss += (x[0] * x[0] + x[1] * x[1]) + (x[2] * x[2] + x[3] * x[3]); }
                        ss += swz_xor<16>(ss); { auto rr = __builtin_amdgcn_permlane32_swap(__float_as_uint(ss), __float_as_uint(ss), false, false); ss = __uint_as_float(rr[0]) + __uint_as_float(rr[1]); }
                        const float rs = rsqrtf(ss * (1.f / 64.f) + EPSF);
                        bf16_t* rowp = base + (row0 + ai * HALF + m * 16) * 1024 + col0;
#pragma unroll
                        for (int bj = 0; bj < 2; ++bj) ST_NT((u32x4*)(rowp + 32 * bj), pack8(acc[ai][bj][m][0] * rs * gv[bj][0], acc[ai][bj][m][1] * rs * gv[bj][1]));
                    }
            } else if (pn < 12) {
                const int col0 = (pn & 3) * 256 + PL_COL;
#pragma unroll
                for (int ai = 0; ai < 2; ++ai)
#pragma unroll
                    for (int m = 0; m < 4; ++m) { bf16_t* rowp = P->o2 + (row0 + ai * HALF + m * 16) * 1024 + col0;
#pragma unroll
                        for (int bj = 0; bj < 2; ++bj) ST_NT((u32x4*)(rowp + bj * PL_BJ), pack8(acc[ai][bj][m][0], acc[ai][bj][m][1])); }
            } else {
                const int col0 = (pn & 3) * 256 + PL_COL;
#pragma unroll
                for (int ai = 0; ai < 2; ++ai)
#pragma unroll
                    for (int m = 0; m < 4; ++m) { bf16_t* rowp = P->o6 + (row0 + ai * HALF + m * 16) * 1024 + col0;
#pragma unroll
                        for (int bj = 0; bj < 2; ++bj) ST_NT((u32x4*)(rowp + bj * PL_BJ), pack8(sigm4(acc[ai][bj][m][0]), sigm4(acc[ai][bj][m][1]))); }
            }
        } else if (mode == 5 || mode == 98 || mode == 97) {
            const bool probe_ = mode == 97; u32x4 xa_ = {0u, 0u, 0u, 0u};
#define ST5(p, v) do { const u32x4 v_ = (v); if (probe_) xa_ ^= v_; else st_g((p), v_); } while (0)
            if (pn < 4) {
                const int col0 = pn * 256 + PL_COL;
#pragma unroll
                for (int ai = 0; ai < 2; ++ai)
#pragma unroll
                    for (int m = 0; m < 4; ++m) { bf16_t* rowp = P->o3 + (row0 + ai * HALF + m * 16) * 1024 + col0;
#pragma unroll
                        for (int bj = 0; bj < 2; ++bj) ST5((u32x4*)(rowp + bj * PL_BJ), pack8(acc[ai][bj][m][0], acc[ai][bj][m][1])); }
            } else if (pn < 12) {
                const int col0 = (pn - 4) * 128 + wc * 32 + 8 * fq;
#pragma unroll
                for (int ai = 0; ai < 2; ++ai)
#pragma unroll
                    for (int m = 0; m < 4; ++m)
                        ST5((u32x4*)(P->o4 + (row0 + ai * HALF + m * 16) * 1024 + col0), pack8(acc[ai][0][m][0] * acc[ai][1][m][0], acc[ai][0][m][1] * acc[ai][1][m][1]));
            } else {
                const int col0 = (pn & 3) * 256 + PL_COL;
#pragma unroll
                for (int ai = 0; ai < 2; ++ai)
#pragma unroll
                    for (int m = 0; m < 4; ++m) { bf16_t* rowp = P->o5 + (row0 + ai * HALF + m * 16) * 1024 + col0;
#pragma unroll
                        for (int bj = 0; bj < 2; ++bj) ST5((u32x4*)(rowp + bj * PL_BJ), pack8(sigm4(acc[ai][bj][m][0]), sigm4(acc[ai][bj][m][1]))); }
            }
            if (probe_ && (xa_.x ^ xa_.y ^ xa_.z ^ xa_.w) == 0x12345678u) *(unsigned*)P->o3 = 1u;
#undef ST5
        } else if (mode == 1 || mode == 2) {
            const int col0 = pn * 256 + wc * 32 + 8 * fq;
#pragma unroll
            for (int ai = 0; ai < 2; ++ai)
#pragma unroll
                for (int m = 0; m < 4; ++m) { const size_t off = (row0 + ai * HALF + m * 16) * 1024 + col0;
#pragma unroll
                    for (int bj = 0; bj < 2; ++bj) { f32x4 ga, gb; unpack8(ld_g((const u32x4*)(P->o1 + off + bj * HALF)), ga, gb);
                        f32x4 r0 = ga * acc[ai][bj][m][0], r1 = gb * acc[ai][bj][m][1];
                        if (mode == 2) { f32x4 ma, mb; unpack8(ld_g((const u32x4*)(P->o0 + off + bj * HALF)), ma, mb); r0 += ma; r1 += mb; }
                        ST_NT((u32x4*)(P->o0 + off + bj * HALF), pack8(r0, r1)); } }
        } else if (mode == 3) {
            const int col0 = pn * 256 + wc * 32 + 8 * fq; const float* gp = P->f1 + (size_t)((un.pm * BM) >> 11) * 6144 + col0;
            f32x4 gv[2][2];
#pragma unroll
            for (int bj = 0; bj < 2; ++bj)
#pragma unroll
                for (int n = 0; n < 2; ++n) gv[bj][n] = ld_g((const f32x4*)(gp + bj * HALF + 4 * n));
#pragma unroll
            for (int ai = 0; ai < 2; ++ai)
#pragma unroll
                for (int m = 0; m < 4; ++m) { const size_t off = (row0 + ai * HALF + m * 16) * 1024 + col0;
#pragma unroll
                    for (int bj = 0; bj < 2; ++bj)
#pragma unroll
                        for (int n = 0; n < 2; ++n) ST_NT((f32x4*)(P->fo + off + bj * HALF + 4 * n), ld_g((const f32x4*)(P->f0 + off + bj * HALF + 4 * n)) + gv[bj][n] * acc[ai][bj][m][n]); }
        } else {
            const int col0 = pn * 128 + wc * 32 + 8 * fq;
            const float sc6 = (mode == 6) ? (1.f / 32.f) : 1.f;
#pragma unroll
            for (int ai = 0; ai < 2; ++ai)
#pragma unroll
                for (int m = 0; m < 4; ++m) { const f32x4 g0 = acc[ai][0][m][0] * sc6, g1 = acc[ai][0][m][1] * sc6;
                    ST_NT((u32x4*)(P->o0 + (row0 + ai * HALF + m * 16) * 2816 + col0), pack8(g0 * sigm4(g0) * (acc[ai][1][m][0] * sc6), g1 * sigm4(g1) * (acc[ai][1][m][1] * sc6))); }
        }
    }
};

struct EpiSw {
    static constexpr bool PERM = true, AFTER_DRAIN = false; float sc;
    __device__ __forceinline__ int vm_ops(const Unit&) const { return 8; }
    __device__ __forceinline__ void operator()(const f32x4 (&acc)[2][2][4][2], const Unit& un, int wr, int wc, int fr, int fq) const {
        const PG8_LAS EpiP* P = (const PG8_LAS EpiP*)EPI_LDS_ADDR; const size_t row0 = (size_t)un.pm * BM + wr * 64 + fr; const int col0 = un.pn * 128 + wc * 32 + 8 * fq;
        bf16_t* ob = P->o0;
#pragma unroll
        for (int ai = 0; ai < 2; ++ai)
#pragma unroll
            for (int m = 0; m < 4; ++m) { const f32x4 g0 = acc[ai][0][m][0] * sc, g1 = acc[ai][0][m][1] * sc;
                st_g((u32x4*)(ob + (row0 + ai * HALF + m * 16) * 2816 + col0), pack8(g0 * sigm4(g0) * (acc[ai][1][m][0] * sc), g1 * sigm4(g1) * (acc[ai][1][m][1] * sc))); }
    }
};

template <class Epi, class Sched, bool ALIGN_EPI = false, bool SP2 = false, bool FP8 = false>
__device__ __forceinline__ void gemm_phase(PG8_LAS unsigned char* lds, const Gemm g, const Sched& S, const Epi& E) {
    int tid_ = threadIdx.x; asm volatile("" : "+v"(tid_)); const int tid = tid_, wid = __builtin_amdgcn_readfirstlane(tid >> 6), lane = tid & 63, wr = wid >> 2, wc = wid & 3, fr = lane & 15, fq = lane >> 4;
    const int K = g.K, nt = K / BK;
    unsigned voffA[2], voffB[2];
#pragma unroll
    for (int i = 0; i < 2; ++i) { int R, C; stage_rc(tid * 16 + i * 8192, R, C); const int Rb = Epi::PERM ? ((R & ~31) + perm32(R & 31)) : R;
        voffA[i] = (unsigned)(R * K + C) * 2u; voffB[i] = (unsigned)(Rb * K + C) * 2u; }
    const size_t kstep = (size_t)(BK * 2);
    const size_t hstep = (size_t)HALF * K * 2;
    const size_t tstep = 2 * hstep;
    const unsigned ldsw = (unsigned)wid * 1024u;
    const int aoff = FP8 ? lds_byte(wr * 64 + fr, fq * 16) : lds_byte(wr * 64 + fr, fq * 8), boff = FP8 ? lds_byte(wc * 32 + fr, fq * 16) : lds_byte(wc * 32 + fr, fq * 8);
    const int aoff1 = aoff + (FP8 ? 16 : 1024), boff1 = boff + (FP8 ? 16 : 1024);
#define PG8_SA(b, h) (((b) * 2 + (h)) * HTB)
#define PG8_SB(b, h) ((4 + (b) * 2 + (h)) * HTB)
#define PG8_STAGE(bufoff, gbase, voff) do { _Pragma("unroll") for (int _i = 0; _i < 2; ++_i) \
        __builtin_amdgcn_global_load_lds((const unsigned*)((const char*)(gbase) + (voff)[_i]), (PG8_LAS unsigned*)(lds + (bufoff) + ldsw + _i * 8192), 16, 0, 0); } while (0)
#define PG8_LDA(dst, b, h) do { _Pragma("unroll") for (int m = 0; m < 4; ++m) { if constexpr (FP8) { int ao_ = aoff; asm volatile("" : "+v"(ao_));   const v4i_ lo_ = *(const PG8_LAS v4i_*)(lds + PG8_SA(b, h) + ao_ + m * 2048), hi_ = *(const PG8_LAS v4i_*)(lds + PG8_SA(b, h) + ao_ + 16 + m * 2048); dst##8[m] = __builtin_shufflevector(lo_, hi_, 0, 1, 2, 3, 4, 5, 6, 7); } \
        else { _Pragma("unroll") for (int k = 0; k < 2; ++k) dst[m][k] = *(const PG8_LAS bf16x8*)(lds + PG8_SA(b, h) + aoff + m * 2048 + k * 1024); } } } while (0)
#define PG8_LDB(dst, b, h) do { _Pragma("unroll") for (int n = 0; n < 2; ++n) { if constexpr (FP8) { int bo_ = boff; asm volatile("" : "+v"(bo_)); const v4i_ lo_ = *(const PG8_LAS v4i_*)(lds + PG8_SB(b, h) + bo_ + n * 2048), hi_ = *(const PG8_LAS v4i_*)(lds + PG8_SB(b, h) + bo_ + 16 + n * 2048); dst##8[n] = __builtin_shufflevector(lo_, hi_, 0, 1, 2, 3, 4, 5, 6, 7); } \
        else { _Pragma("unroll") for (int k = 0; k < 2; ++k) dst[n][k] = *(const PG8_LAS bf16x8*)(lds + PG8_SB(b, h) + boff + n * 2048 + k * 1024); } } } while (0)
#define PG8_MMA(ai, bj, At, Bt) do { __builtin_amdgcn_s_setprio(1); _Pragma("unroll") for (int m = 0; m < 4; ++m) _Pragma("unroll") for (int n = 0; n < 2; ++n) { \
        if constexpr (FP8) { acc[ai][bj][m][n] = __builtin_amdgcn_mfma_scale_f32_16x16x128_f8f6f4(Bt##8[n], At##8[m], acc[ai][bj][m][n], 0, 0, 0, 0, 0, 0); } \
        else { _Pragma("unroll") for (int k = 0; k < 2; ++k) acc[ai][bj][m][n] = __builtin_amdgcn_mfma_f32_16x16x32_bf16(Bt[n][k], At[m][k], acc[ai][bj][m][n], 0, 0, 0); } } \
        __builtin_amdgcn_s_setprio(0); } while (0)
#define PG8_WAIT_V(n) asm volatile("s_waitcnt vmcnt(" #n ")" ::: "memory")
#define PG8_WAIT_L(n) asm volatile("s_waitcnt lgkmcnt(" #n ")" ::: "memory")
#define PG8_BAR __builtin_amdgcn_s_barrier()
#define PG8_SCHED __builtin_amdgcn_sched_barrier(0)
#ifdef GEMM_STAG
    { const unsigned g_ = (blockIdx.x >> 3) & (GEMM_STAGN - 1u); if (g_) { const unsigned long long t0_ = __builtin_amdgcn_s_memrealtime(); while (__builtin_amdgcn_s_memrealtime() - t0_ < (unsigned long long)(g_ * GEMM_STAG)) __builtin_amdgcn_s_sleep(8); } }
#endif
    Unit cur, nxt; int ui = 0;
    if (!S.next(0, cur)) return;
    f32x4 acc[2][2][4][2];
#pragma unroll
    for (int a = 0; a < 2; ++a)
#pragma unroll
        for (int b = 0; b < 2; ++b)
#pragma unroll
            for (int m = 0; m < 4; ++m)
#pragma unroll
                for (int n = 0; n < 2; ++n) acc[a][b][m][n] = (f32x4){0.f, 0.f, 0.f, 0.f};
    typedef int v4i_ __attribute__((ext_vector_type(4))); typedef int v8i_ __attribute__((ext_vector_type(8)));
    bf16x8 At[4][2], B0[2][2], B1[2][2]; v8i_ At8[4], B08[2], B18[2];
    const char* cA = (const char*)g.A + (size_t)cur.pm * tstep; const char* cB = (const char*)g.Bt + (size_t)cur.pn * tstep;
    S.a_ready(cur);
    if constexpr (SP2) {
        PG8_STAGE(PG8_SB(0, 0), cB, voffB); PG8_STAGE(PG8_SB(0, 1), cB + hstep, voffB); PG8_STAGE(PG8_SA(0, 0), cA, voffA); PG8_STAGE(PG8_SA(0, 1), cA + hstep, voffA);
        if (wr == 1) PG8_BAR;
        PG8_WAIT_V(2); PG8_BAR;
        PG8_STAGE(PG8_SB(1, 0), cB + kstep, voffB); PG8_STAGE(PG8_SA(1, 0), cA + kstep, voffA); PG8_STAGE(PG8_SB(1, 1), cB + hstep + kstep, voffB);
        PG8_WAIT_V(6); PG8_BAR;
    } else {
        PG8_STAGE(PG8_SB(0, 0), cB, voffB); PG8_STAGE(PG8_SA(0, 0), cA, voffA); PG8_STAGE(PG8_SB(0, 1), cB + hstep, voffB); PG8_STAGE(PG8_SA(0, 1), cA + hstep, voffA);
        if (wr == 1) PG8_BAR;
        PG8_WAIT_V(4); PG8_BAR;
        PG8_STAGE(PG8_SB(1, 0), cB + kstep, voffB); PG8_STAGE(PG8_SA(1, 0), cA + kstep, voffA); PG8_STAGE(PG8_SB(1, 1), cB + hstep + kstep, voffB);
        PG8_WAIT_V(6); PG8_BAR;
    }
    for (;;) {
        const bool has_next = S.next(ui + 1, nxt);
        const char* nA = has_next ? (const char*)g.A + (size_t)nxt.pm * tstep : cA; const char* nB = has_next ? (const char*)g.Bt + (size_t)nxt.pn * tstep : cB;
        for (int t = 0; t < nt; t += 2) {
            const bool last = (t == nt - 2);
            const char* a1 = cA + (size_t)(t + 1) * kstep;
            const char* a2 = last ? nA : cA + (size_t)(t + 2) * kstep; const char* b2 = last ? nB : cB + (size_t)(t + 2) * kstep;
            const char* a3 = a2 + kstep; const char* b3 = b2 + kstep;
            if (last && has_next) S.a_ready(nxt);
            if constexpr (SP2) {
            PG8_LDB(B0, 0, 0); PG8_LDB(B1, 0, 1); PG8_SCHED; PG8_LDA(At, 0, 0); PG8_STAGE(PG8_SA(1, 1), a1 + hstep, voffA);
            PG8_WAIT_V(8); PG8_WAIT_L(0); PG8_BAR; PG8_MMA(0, 0, At, B0); PG8_MMA(0, 1, At, B1); PG8_BAR; PG8_SCHED;
            PG8_LDA(At, 0, 1); PG8_STAGE(PG8_SB(0, 0), b2, voffB); PG8_STAGE(PG8_SB(0, 1), b2 + hstep, voffB); PG8_STAGE(PG8_SA(0, 0), a2, voffA);
            PG8_WAIT_V(8); PG8_WAIT_L(0); PG8_BAR; PG8_MMA(1, 0, At, B0); PG8_MMA(1, 1, At, B1); PG8_BAR; PG8_SCHED;
            PG8_LDB(B0, 1, 0); PG8_LDB(B1, 1, 1); PG8_SCHED; PG8_LDA(At, 1, 0); PG8_STAGE(PG8_SA(0, 1), a2 + hstep, voffA);
            PG8_WAIT_V(8); PG8_WAIT_L(0); PG8_BAR; PG8_MMA(0, 0, At, B0); PG8_MMA(0, 1, At, B1); PG8_BAR; PG8_SCHED;
            PG8_LDA(At, 1, 1); PG8_STAGE(PG8_SB(1, 0), b3, voffB); PG8_STAGE(PG8_SB(1, 1), b3 + hstep, voffB); PG8_STAGE(PG8_SA(1, 0), a3, voffA);
            PG8_WAIT_V(8); PG8_WAIT_L(0); PG8_BAR; PG8_MMA(1, 0, At, B0); PG8_MMA(1, 1, At, B1); PG8_BAR; PG8_SCHED;
            } else {
            PG8_LDB(B0, 0, 0); PG8_SCHED; PG8_LDA(At, 0, 0); PG8_STAGE(PG8_SA(1, 1), a1 + hstep, voffA);
            PG8_WAIT_L(8); PG8_BAR; PG8_WAIT_L(0); PG8_MMA(0, 0, At, B0); PG8_BAR; PG8_SCHED;
            PG8_LDB(B1, 0, 1); PG8_STAGE(PG8_SB(0, 0), b2, voffB);
            PG8_BAR; PG8_WAIT_L(0); PG8_MMA(0, 1, At, B1); PG8_BAR;
            PG8_LDA(At, 0, 1); PG8_STAGE(PG8_SA(0, 0), a2, voffA);
            PG8_BAR; PG8_WAIT_L(0); PG8_MMA(1, 0, At, B0); PG8_BAR; PG8_SCHED;
            PG8_STAGE(PG8_SB(0, 1), b2 + hstep, voffB);
            PG8_WAIT_V(6); PG8_BAR; PG8_MMA(1, 1, At, B1); PG8_BAR;
            PG8_LDB(B0, 1, 0); PG8_SCHED; PG8_LDA(At, 1, 0); PG8_STAGE(PG8_SA(0, 1), a2 + hstep, voffA);
            PG8_WAIT_L(8); PG8_BAR; PG8_WAIT_L(0); PG8_MMA(0, 0, At, B0); PG8_BAR; PG8_SCHED;
            PG8_LDB(B1, 1, 1); PG8_STAGE(PG8_SB(1, 0), b3, voffB);
            PG8_BAR; PG8_WAIT_L(0); PG8_MMA(0, 1, At, B1); PG8_BAR;
            PG8_LDA(At, 1, 1); PG8_STAGE(PG8_SA(1, 0), a3, voffA);
            PG8_BAR; PG8_WAIT_L(0); PG8_MMA(1, 0, At, B0); PG8_BAR; PG8_SCHED;
            PG8_STAGE(PG8_SB(1, 1), b3 + hstep, voffB);
            PG8_WAIT_V(6); PG8_BAR; PG8_MMA(1, 1, At, B1); PG8_BAR;
            }
        }
        if constexpr (ALIGN_EPI) { if (wr == 0) PG8_BAR; }
        if constexpr (!Epi::AFTER_DRAIN) { E(acc, cur, wr, wc, fr, fq); S.done(cur); }
        if (!has_next) break;
#pragma unroll
        for (int a = 0; a < 2; ++a)
#pragma unroll
            for (int b = 0; b < 2; ++b)
#pragma unroll
                for (int m = 0; m < 4; ++m)
#pragma unroll
                    for (int n = 0; n < 2; ++n) acc[a][b][m][n] = (f32x4){0.f, 0.f, 0.f, 0.f};
        cur = nxt; cA = nA; cB = nB; ++ui;
        if constexpr (ALIGN_EPI) { if (wr == 1) PG8_BAR; }
    }
    PG8_WAIT_V(0);
    if constexpr (!ALIGN_EPI) { if (wr == 0) PG8_BAR; }
    PG8_BAR;
    if constexpr (Epi::AFTER_DRAIN) { E.fused(acc, cur, wr, wc, fr, fq, lds, wid, lane); S.done(cur); }
#undef PG8_SA
#undef PG8_SB
#undef PG8_STAGE
#undef PG8_LDA
#undef PG8_LDB
#undef PG8_MMA
#undef PG8_WAIT_V
#undef PG8_WAIT_L
#undef PG8_BAR
#undef PG8_SCHED
}
}
namespace attn2 {
typedef short bf16x8 __attribute__((ext_vector_type(8)));
typedef short s16x4 __attribute__((ext_vector_type(4)));
typedef float f32x16 __attribute__((ext_vector_type(16)));
typedef float f32x4 __attribute__((ext_vector_type(4)));
typedef unsigned u32x4 __attribute__((ext_vector_type(4)));
typedef unsigned short bf16;
constexpr int LD = 1024, NW = 8, QBLK = 32, KVBLK = 64, QB = NW * QBLK, SEQ = 2048;
constexpr int SHM_V = KVBLK * 128 * 2, SHM_K = KVBLK * 64 * 2;
constexpr int OFF_K = 2 * SHM_V, OFF_WS = OFF_K + 2 * SHM_K, OFF_OST = OFF_WS + NW * 64 * 4, LDS_BYTES = OFF_OST + NW * 8192;
constexpr float THR = 8.f;
#define KSWZ(row, colB) ((row) * 128 + ((colB) ^ (((row) & 7) << 4)))
#define SBAR() __builtin_amdgcn_sched_barrier(0)
#ifdef ATTN_SGB
#define SGB_QK() do { __builtin_amdgcn_sched_group_barrier(0x100, 4, 0); _Pragma("unroll") for (int i_ = 0; i_ < 8; ++i_) { __builtin_amdgcn_sched_group_barrier(0x008, 1, 0); __builtin_amdgcn_sched_group_barrier(0x100, 1, 0); __builtin_amdgcn_sched_group_barrier(0x002, ATTN_SGB, 0); } } while (0)
#else
#define SGB_QK() do {} while (0)
#endif
__device__ __forceinline__ int v_st(int k, int c) { const int kk = (k & ~0xC) | ((k & 4) << 1) | ((k & 8) >> 1); return ((kk >> 3) * 4 + (c >> 5)) * 512 + ((kk & 7) * 32 + (c & 31)) * 2; }
__device__ __forceinline__ int v_rd_base(int lane) { return ((lane & 3) << 3) | (((lane >> 2) & 3) << 6) | (((lane >> 4) & 1) << 5) | (((lane >> 5) & 1) << 8); }
constexpr int v_rd_off(int d0, int ks, int half) { return d0 * 512 + ks * 4096 + half * 2048; }
__device__ __forceinline__ int crow(int r, int hi) { return (r & 3) + 8 * (r >> 2) + 4 * hi; }
__device__ __forceinline__ unsigned cvtpk(float lo, float hi) { return pg8::cvt_pk_bf16(lo, hi); }
__device__ __forceinline__ void mask_tile(f32x16& p0, f32x16& p1, int dq) {
    const float NEG = -__builtin_inff();
#pragma unroll
    for (int r = 0; r < 16; ++r) { const int c = (r & 3) + 8 * (r >> 2); if (dq - c < 0) p0[r] = NEG; if (dq - c - 32 < 0) p1[r] = NEG; }
}
__device__ __forceinline__ void partialSM(f32x16& p0, f32x16& p1, float& m_reg, float& mn, float& alpha) {
    float pmax = p0[0];
#pragma unroll
    for (int r = 1; r < 16; ++r) pmax = fmaxf(pmax, p0[r]);
#pragma unroll
    for (int r = 0; r < 16; ++r) pmax = fmaxf(pmax, p1[r]);
    { auto rr = __builtin_amdgcn_permlane32_swap(__float_as_uint(pmax), __float_as_uint(pmax), false, false); pmax = fmaxf(__uint_as_float(rr[0]), __uint_as_float(rr[1])); }
    if (__builtin_expect(__all((pmax - m_reg) <= THR), 1)) { mn = m_reg; alpha = 1.f; }
    else { mn = fmaxf(m_reg, pmax); alpha = __builtin_amdgcn_exp2f(m_reg - mn); m_reg = mn; }
#pragma unroll
    for (int r = 0; r < 16; ++r) { p0[r] -= mn; p1[r] -= mn; }
#pragma unroll
    for (int r = 0; r < 16; ++r) p0[r] = __builtin_amdgcn_exp2f(p0[r]);
}
__device__ __forceinline__ void finishSM(f32x16& p0, f32x16& p1, float alpha, float& l_reg, bf16x8& pa0, bf16x8& pa1, bf16x8& pa2, bf16x8& pa3) {
#pragma unroll
    for (int r = 0; r < 16; ++r) p1[r] = __builtin_amdgcn_exp2f(p1[r]);
    typedef float f32x2_ __attribute__((ext_vector_type(2)));
    f32x2_ ps2 = {0.f, 0.f};
#pragma unroll
    for (int r = 0; r < 16; r += 2) { ps2 += (f32x2_){p0[r], p0[r + 1]}; ps2 += (f32x2_){p1[r], p1[r + 1]}; }
    float ps = ps2.x + ps2.y;
    { auto rr = __builtin_amdgcn_permlane32_swap(__float_as_uint(ps), __float_as_uint(ps), false, false); ps = __uint_as_float(rr[0]) + __uint_as_float(rr[1]); }
    l_reg = l_reg * alpha + ps;
#define PK4(P, B_, OUT) do { unsigned a0 = cvtpk(P[B_+0], P[B_+1]), a1 = cvtpk(P[B_+2], P[B_+3]);                          \
        unsigned b0 = cvtpk(P[B_+4], P[B_+5]), b1 = cvtpk(P[B_+6], P[B_+7]);                                             \
        auto r0 = __builtin_amdgcn_permlane32_swap(a0, b0, false, false); auto r1 = __builtin_amdgcn_permlane32_swap(a1, b1, false, false); \
        u32x4 w = {r0[0], r1[0], r0[1], r1[1]}; OUT = __builtin_bit_cast(bf16x8, w); } while (0)
    PK4(p0, 0, pa0); PK4(p0, 8, pa1); PK4(p1, 0, pa2); PK4(p1, 8, pa3);
#undef PK4
}
template <int KB>
__device__ __forceinline__ void qkt(f32x16& p0, f32x16& p1, const char* K_lds, int r32, int hi, const bf16x8* qr, bool act) {
#ifdef ATTN_WSKIP
    if (!act) { const float NEG = -__builtin_inff();
#pragma unroll
        for (int r = 0; r < 16; ++r) { p0[r] = NEG; p1[r] = NEG; } return; }
#endif
    p0 = f32x16{}; p1 = f32x16{};
#pragma unroll
    for (int d0 = 0; d0 < 4; ++d0) { const char* a = K_lds + KB * SHM_K + KSWZ(r32, (d0 * 16 + hi * 8) * 2);
        const bf16x8 b0 = *reinterpret_cast<const bf16x8*>(a);
        const bf16x8 b1 = *reinterpret_cast<const bf16x8*>(a + 32 * 128);
        p0 = __builtin_amdgcn_mfma_f32_32x32x16_bf16(b0, qr[d0], p0, 0, 0, 0);
        p1 = __builtin_amdgcn_mfma_f32_32x32x16_bf16(b1, qr[d0], p1, 0, 0, 0); }
}
template <int VB>
__device__ __forceinline__ void pv_tile(f32x16* o, int vb0, bf16x8 pa0, bf16x8 pa1, bf16x8 pa2, bf16x8 pa3, bool act) {
#ifdef ATTN_WSKIP
    if (!act) return;
#endif
#define TRRD(dst, off) asm volatile("ds_read_b64_tr_b16 %0, %1 offset:%2" : "=&v"(dst) : "v"(vb0), "i"(off) : "memory")
#define PV_D0(d0) do { s16x4 l0, l1, l2, l3, h0, h1, h2, h3; constexpr int b_ = VB * SHM_V + v_rd_off(d0, 0, 0); \
        TRRD(l0, b_); TRRD(h0, b_ + 2048); TRRD(l1, b_ + 4096); TRRD(h1, b_ + 6144); TRRD(l2, b_ + 8192); TRRD(h2, b_ + 10240); TRRD(l3, b_ + 12288); TRRD(h3, b_ + 14336); \
        asm volatile("s_waitcnt lgkmcnt(0)" ::: "memory"); SBAR();   \
        o[d0] = __builtin_amdgcn_mfma_f32_32x32x16_bf16(pa0, (bf16x8){l0[0], l0[1], l0[2], l0[3], h0[0], h0[1], h0[2], h0[3]}, o[d0], 0, 0, 0);   \
        o[d0] = __builtin_amdgcn_mfma_f32_32x32x16_bf16(pa1, (bf16x8){l1[0], l1[1], l1[2], l1[3], h1[0], h1[1], h1[2], h1[3]}, o[d0], 0, 0, 0);   \
        o[d0] = __builtin_amdgcn_mfma_f32_32x32x16_bf16(pa2, (bf16x8){l2[0], l2[1], l2[2], l2[3], h2[0], h2[1], h2[2], h2[3]}, o[d0], 0, 0, 0);   \
        o[d0] = __builtin_amdgcn_mfma_f32_32x32x16_bf16(pa3, (bf16x8){l3[0], l3[1], l3[2], l3[3], h3[0], h3[1], h3[2], h3[3]}, o[d0], 0, 0, 0); } while (0)
    PV_D0(0); PV_D0(1); PV_D0(2); PV_D0(3);
#undef PV_D0
#undef TRRD
}
#ifndef ATTN_NO_FUSE
template <int VB>
__device__ __forceinline__ void pv_softmax(f32x16* o, int vb0, bf16x8 pa0, bf16x8 pa1, bf16x8 pa2, bf16x8 pa3, f32x16& p0, f32x16& p1, float& m_reg, float& mn, float& alpha) {
#define TRRD(dst, off) asm volatile("ds_read_b64_tr_b16 %0, %1 offset:%2" : "=&v"(dst) : "v"(vb0), "i"(off) : "memory")
#define RD8(F, ks) do { constexpr int b_ = VB * SHM_V + (ks) * 4096; \
        TRRD(F##00, b_); TRRD(F##01, b_ + 2048); TRRD(F##10, b_ + 512); TRRD(F##11, b_ + 512 + 2048); TRRD(F##20, b_ + 1024); TRRD(F##21, b_ + 1024 + 2048); TRRD(F##30, b_ + 1536); TRRD(F##31, b_ + 1536 + 2048); } while (0)
#define FR(L_, H_) (bf16x8){L_[0], L_[1], L_[2], L_[3], H_[0], H_[1], H_[2], H_[3]}
#define LGK(n) asm volatile("s_waitcnt lgkmcnt(" #n ")" ::: "memory")
#define MM(d0, PA, L_, H_) o[d0] = __builtin_amdgcn_mfma_f32_32x32x16_bf16(PA, FR(L_, H_), o[d0], 0, 0, 0)
#define MX4(P, b) fmaxf(fmaxf(fmaxf(P[b], P[(b) + 1]), P[(b) + 2]), P[(b) + 3])
#define SE4(P, b) do { typedef float f32x2_ __attribute__((ext_vector_type(2))); const f32x2_ m2_ = {mn, mn}; const f32x2_ d0_ = (f32x2_){P[b], P[(b) + 1]} - m2_, d1_ = (f32x2_){P[(b) + 2], P[(b) + 3]} - m2_; P[b] = __builtin_amdgcn_exp2f(d0_.x); P[(b) + 1] = __builtin_amdgcn_exp2f(d0_.y); P[(b) + 2] = __builtin_amdgcn_exp2f(d1_.x); P[(b) + 3] = __builtin_amdgcn_exp2f(d1_.y); } while (0)
#define SB8(P, b) do { typedef float f32x2_ __attribute__((ext_vector_type(2))); const f32x2_ m2_ = {mn, mn}; _Pragma("unroll") for (int r_ = 0; r_ < 8; r_ += 2) { const f32x2_ d_ = (f32x2_){P[(b) + r_], P[(b) + r_ + 1]} - m2_; P[(b) + r_] = d_.x; P[(b) + r_ + 1] = d_.y; } } while (0)
    s16x4 A00, A01, A10, A11, A20, A21, A30, A31, B00, B01, B10, B11, B20, B21, B30, B31;
    float t0, t1, t2, t3, t4, t5, t6, t7;
#define PINV(x) asm volatile("" : "+v"(x))
    RD8(A, 0); RD8(B, 1); LGK(8); SBAR();
    MM(0, pa0, A00, A01); t0 = MX4(p0, 0);  PINV(t0); SBAR();
    MM(1, pa0, A10, A11); t1 = MX4(p0, 4);  PINV(t1); SBAR();
    MM(2, pa0, A20, A21); t2 = MX4(p0, 8);  PINV(t2); SBAR();
    MM(3, pa0, A30, A31); t3 = MX4(p0, 12); PINV(t3); SBAR();
    RD8(A, 2); LGK(8); SBAR();
    MM(0, pa1, B00, B01); t4 = MX4(p1, 0);  PINV(t4); SBAR();
    MM(1, pa1, B10, B11); t5 = MX4(p1, 4);  PINV(t5); SBAR();
    MM(2, pa1, B20, B21); t6 = MX4(p1, 8);  PINV(t6); SBAR();
    MM(3, pa1, B30, B31); t7 = MX4(p1, 12); PINV(t7); SBAR();
    RD8(B, 3); LGK(8); SBAR();
    MM(0, pa2, A00, A01);
    float pmax = fmaxf(fmaxf(fmaxf(fmaxf(fmaxf(fmaxf(fmaxf(t0, t1), t2), t3), t4), t5), t6), t7);
    { auto rr = __builtin_amdgcn_permlane32_swap(__float_as_uint(pmax), __float_as_uint(pmax), false, false); pmax = fmaxf(__uint_as_float(rr[0]), __uint_as_float(rr[1])); }
    PINV(pmax); SBAR();
    MM(1, pa2, A10, A11);
    { const bool keep = __all((pmax - m_reg) <= THR); mn = keep ? m_reg : fmaxf(m_reg, pmax); alpha = __builtin_amdgcn_exp2f(m_reg - mn); m_reg = mn; }
    PINV(mn); PINV(alpha); SBAR();
    MM(2, pa2, A20, A21); SE4(p0, 0);  PINV(p0); SBAR();
    MM(3, pa2, A30, A31); SE4(p0, 4);  PINV(p0); SBAR();
    LGK(0); SBAR();
    MM(0, pa3, B00, B01); SE4(p0, 8);  PINV(p0); SBAR();
    MM(1, pa3, B10, B11); SE4(p0, 12); PINV(p0); SBAR();
    MM(2, pa3, B20, B21); SB8(p1, 0);  PINV(p1); SBAR();
    MM(3, pa3, B30, B31); SB8(p1, 8);  PINV(p1); SBAR();
#undef PINV
#undef TRRD
#undef RD8
#undef FR
#undef LGK
#undef MM
#undef MX4
#undef SE4
#undef SB8
}
#endif
struct BlockRef { const bf16* Q; const bf16* K; const bf16* V; bf16* O; int P0; int mode; };
struct Seam { bf16x8 qr[4]; bf16x8 st_v0, st_v1, st_k0; };
struct Stage2 { bf16x8 sv0, sv1, sk0; };
#define VMW() asm volatile("s_waitcnt vmcnt(0)" ::: "memory")
#define VMWN(n) asm volatile("s_waitcnt vmcnt(%0)" :: "i"(n) : "memory")
#define SLOAD_H(Kp, Vp, k0) do { S.st_v0 = *(const bf16x8*)((Vp) + (size_t)((k0) + sr) * LD + sc); S.st_v1 = *(const bf16x8*)((Vp) + (size_t)((k0) + 32 + sr) * LD + sc); \
                                 S.st_k0 = *(const bf16x8*)((Kp) + (size_t)((k0) + kr) * LD + kc); } while (0)
#define SWRITE_HK(bf) do { *(bf16x8*)(K_lds + (bf) * SHM_K + kws) = S.st_k0; } while (0)
#define SWRITE_HV(bf) do { *(bf16x8*)(V_lds + (bf) * SHM_V + vst0) = S.st_v0; *(bf16x8*)(V_lds + (bf) * SHM_V + vst1) = S.st_v1; } while (0)
#define SWRITE_H(bf) do { SWRITE_HV(bf); SWRITE_HK(bf); } while (0)
#define SLOAD_B(Kp, Vp, k0) do { T2.sv0 = *(const bf16x8*)((Vp) + (size_t)((k0) + sr) * LD + sc); T2.sv1 = *(const bf16x8*)((Vp) + (size_t)((k0) + 32 + sr) * LD + sc); \
                                 T2.sk0 = *(const bf16x8*)((Kp) + (size_t)((k0) + kr) * LD + kc); } while (0)
#define SWRITE_B(bf) do { *(bf16x8*)(V_lds + (bf) * SHM_V + vst0) = T2.sv0; *(bf16x8*)(V_lds + (bf) * SHM_V + vst1) = T2.sv1; *(bf16x8*)(K_lds + (bf) * SHM_K + kws) = T2.sk0; } while (0)
__device__ __forceinline__ void attn_prime(const BlockRef& cur, char* lds, Seam& S) {
    int tid_ = threadIdx.x; asm volatile("" : "+v"(tid_)); const int tid = tid_, wid = __builtin_amdgcn_readfirstlane(tid >> 6), lane = tid & 63, r32 = lane & 31, hi = lane >> 5;
    const int sr = tid >> 4, sc = (tid & 15) * 8, kr = tid >> 3, kc = (tid & 7) * 8, kws = KSWZ(kr, kc * 2); char* K_lds = lds + OFF_K;
#pragma unroll
    for (int d0 = 0; d0 < 4; ++d0) S.qr[d0] = *(const bf16x8*)(cur.Q + (size_t)(wid * QBLK + r32) * LD + d0 * 16 + hi * 8);
    SLOAD_H(cur.K, cur.V, 0); VMW(); SWRITE_HK(0);
    __syncthreads();
}
template <int ABL>
__device__ __forceinline__ void attn_block(const BlockRef& cur, const BlockRef& nxt, char* lds, Seam& S, float lam, const float* subg) {
    int tid_ = threadIdx.x; asm volatile("" : "+v"(tid_)); const int tid = tid_, wid = __builtin_amdgcn_readfirstlane(tid >> 6), lane = tid & 63, r32 = lane & 31, hi = lane >> 5;
    const int NT = cur.P0 / KVBLK + QB / KVBLK;
    const int qlo = cur.P0 + wid * QBLK, qm = qlo + r32 - 4 * hi;
    char* V_lds = lds; char* K_lds = lds + OFF_K;
    float* ws = (float*)(lds + OFF_WS) + wid * 64; float* li_l = ws, * al_l = ws + 32;
    float m_reg = -1e30f, l_reg = 0; f32x16 o[4] = {};
    const int sr = tid >> 4, sc = (tid & 15) * 8, vst0 = v_st(sr, sc), vst1 = v_st(32 + sr, sc), kr = tid >> 3, kc = (tid & 7) * 8, kws = KSWZ(kr, kc * 2);
    const int vb0 = (int)(uintptr_t)V_lds + v_rd_base(lane);
    const bf16* Kh = cur.K; const bf16* Vh = cur.V;
#define RESC(a) do { if (__any((a) < 1.f)) { if (hi == 0) al_l[r32] = (a); asm volatile("s_waitcnt lgkmcnt(0)" ::: "memory");              \
                     _Pragma("unroll") for (int d_ = 0; d_ < 4; ++d_) _Pragma("unroll") for (int r = 0; r < 16; ++r) o[d_][r] *= al_l[crow(r, hi)]; } } while (0)
#define KBASE(t) ((t) * KVBLK)
#define ACT(t) (KBASE(t) <= qlo + QBLK - 1)
#define MASKT(P0_, P1_, t) do { const int kb_ = KBASE(t); if (kb_ + KVBLK - 1 > qlo) mask_tile(P0_, P1_, qm - kb_); } while (0)
#ifndef ATTN_NO_FUSE
#define PVSM(VB, PX0, PX1, mnX, alX, t) do { MASKT(PX0, PX1, (t)); SBAR(); pv_softmax<VB>(o, vb0, pa0, pa1, pa2, pa3, PX0, PX1, m_reg, mnX, alX); } while (0)
#else
#define PVSM(VB, PX0, PX1, mnX, alX, t) do { pv_tile<VB>(o, vb0, pa0, pa1, pa2, pa3, ACT((t) - 1)); MASKT(PX0, PX1, (t)); partialSM(PX0, PX1, m_reg, mnX, alX); } while (0)
#endif
#define SEAM_K0() do { VMWN(4); SWRITE_HK(0); SBAR(); } while (0)
    f32x16 pA0, pA1, pB0, pB1; float mnA, mnB, alA, alB; bf16x8 pa0, pa1, pa2, pa3;
    Stage2 T2;
    SWRITE_HV(0); SBAR();
    SLOAD_H(Kh, Vh, KBASE(1)); SBAR(); SLOAD_B(Kh, Vh, KBASE(2)); SBAR();
    qkt<0>(pA0, pA1, K_lds, r32, hi, S.qr, true);
    MASKT(pA0, pA1, 0); partialSM(pA0, pA1, m_reg, mnA, alA);
    VMWN(3); SWRITE_H(1);
    __syncthreads();
#define BARX() do { if (!(ABL & 1)) __syncthreads(); } while (0)
#define HALF_STEP(PX0, PX1, mnX, alX, PY0, PY1, alY, t, KB, VB, SB, LOADM, WRITEM) do {                                      \
        SBAR(); if (!(ABL & 2)) qkt<KB>(PX0, PX1, K_lds, r32, hi, S.qr, ACT(t));                                             \
        finishSM(PY0, PY1, alY, l_reg, pa0, pa1, pa2, pa3); SGB_QK(); SBAR();                                                           \
        if ((t) + 2 < NT) { LOADM(Kh, Vh, KBASE((t) + 2)); SBAR(); }                                               \
        if (!(ABL & 4)) PVSM(VB, PX0, PX1, mnX, alX, t);                                        \
        BARX();                                                                                                      \
        if ((t) + 1 < NT) { if ((t) + 2 < NT) { VMWN(3); } else { VMW(); } WRITEM(SB); }        \
        RESC(alX); BARX(); } while (0)
    for (int t = 1; t + 1 < NT; t += 2) {
        HALF_STEP(pB0, pB1, mnB, alB, pA0, pA1, alA, t, 1, 0, 0, SLOAD_H, SWRITE_B);
        HALF_STEP(pA0, pA1, mnA, alA, pB0, pB1, alB, t + 1, 0, 1, 1, SLOAD_B, SWRITE_H);
    }
    SBAR(); qkt<1>(pB0, pB1, K_lds, r32, hi, S.qr, ACT(NT - 1)); SBAR();
    SLOAD_H(nxt.K, nxt.V, 0); SBAR();
#pragma unroll
    for (int d0 = 0; d0 < 4; ++d0) S.qr[d0] = *(const bf16x8*)(nxt.Q + (size_t)(wid * QBLK + r32) * LD + d0 * 16 + hi * 8);
    SBAR();
    finishSM(pA0, pA1, alA, l_reg, pa0, pa1, pa2, pa3); SBAR();
    PVSM(0, pB0, pB1, mnB, alB, NT - 1); __syncthreads(); RESC(alB);
    finishSM(pB0, pB1, alB, l_reg, pa0, pa1, pa2, pa3); SBAR(); pv_tile<1>(o, vb0, pa0, pa1, pa2, pa3, ACT(NT - 1));
    SBAR(); SEAM_K0();
    if (hi == 0) li_l[r32] = l_reg; asm volatile("s_waitcnt lgkmcnt(0)" ::: "memory");
    float rli[16];
#pragma unroll
    for (int r = 0; r < 16; ++r) rli[r] = __builtin_amdgcn_rcpf(li_l[crow(r, hi)]);
    bf16* stg = (bf16*)(lds + OFF_OST) + wid * 4096;
#pragma unroll
    for (int r = 0; r < 16; ++r) { const int orow = crow(r, hi);
#pragma unroll
        for (int d0 = 0; d0 < 4; ++d0) { const float v = o[d0][r] * rli[r]; stg[orow * 128 + d0 * 32 + r32] = (bf16)(cvtpk(v, v) & 0xffffu); } }
    asm volatile("s_waitcnt lgkmcnt(0)" ::: "memory");
    bf16* Ow = cur.O + (size_t)(wid * QBLK) * LD;
    if (cur.mode == 0) {
#pragma unroll
        for (int i = 0; i < 8; ++i) { const int row = i * 4 + (lane >> 4), ch = lane & 15; *(u32x4*)(Ow + (size_t)row * LD + ch * 8) = *(const u32x4*)(stg + row * 128 + ch * 8); }
    } else {
        f32x4 ga = *(const f32x4*)(subg + (lane & 15) * 8), gb = *(const f32x4*)(subg + (lane & 15) * 8 + 4);
#pragma unroll
        for (int i = 0; i < 8; ++i) { const int row = i * 4 + (lane >> 4), ch = lane & 15; bf16* p = Ow + (size_t)row * LD + ch * 8;
            const u32x4 v = *(const u32x4*)(stg + row * 128 + ch * 8), pv = *(const u32x4*)p; float d[8]; float ss = 0.f;
#pragma unroll
            for (int j = 0; j < 4; ++j) { d[2 * j] = __uint_as_float(pv[j] << 16) - lam * __uint_as_float(v[j] << 16); d[2 * j + 1] = __uint_as_float(pv[j] & 0xffff0000u) - lam * __uint_as_float(v[j] & 0xffff0000u); }
#pragma unroll
            for (int j = 0; j < 8; ++j) ss += d[j] * d[j];
            ss += pg8::swz_xor<1>(ss); ss += pg8::swz_xor<2>(ss); ss += pg8::swz_xor<4>(ss); ss += pg8::swz_xor<8>(ss);
            const float rs = rsqrtf(ss * (1.f / 128.f) + 1e-6f) * 0.8f;
            u32x4 w; w[0] = cvtpk(d[0] * rs * ga[0], d[1] * rs * ga[1]); w[1] = cvtpk(d[2] * rs * ga[2], d[3] * rs * ga[3]); w[2] = cvtpk(d[4] * rs * gb[0], d[5] * rs * gb[1]); w[3] = cvtpk(d[6] * rs * gb[2], d[7] * rs * gb[3]);
            *(u32x4*)p = w; }
    }
    __syncthreads();
#undef RESC
#undef KBASE
#undef ACT
#undef MASKT
#undef SEAM_K0
#undef PVSM
#undef HALF_STEP
#undef BARX
}
#undef VMW
#undef VMWN
#undef SLOAD_H
#undef SWRITE_HK
#undef SWRITE_HV
#undef SWRITE_H
#undef SLOAD_B
#undef SWRITE_B
__device__ __forceinline__ BlockRef block_ref(int n, int vcu, int G, const bf16* Q, const bf16* K, const bf16* V, bf16* O) {
    const int w = vcu + (n >> 2) * G, i = (n >> 1) & 1, c = n & 1, bh = w >> 2, s = w & 3, b = bh >> 3, h = bh & 7, qb = i == 0 ? s : 7 - s;
    const size_t r0 = (size_t)b * SEQ; BlockRef r;
    r.Q = Q + (r0 + (size_t)qb * QB) * LD + (2 * h + c) * 64; r.K = K + r0 * LD + (2 * h + c) * 64; r.V = V + r0 * LD + h * 128; r.O = O + (r0 + (size_t)qb * QB) * LD + h * 128; r.P0 = qb * QB; r.mode = c;
    return r;
}
template <int ABL>
__device__ __forceinline__ void attn_phase(char* lds, const bf16* Q, const bf16* K, const bf16* V, bf16* O, int vcu, int G, float lam, const float* subg) {
    const int nblk = ((1024 - vcu + G - 1) / G) * 4;
    if (nblk <= 0) return;
    BlockRef cur = block_ref(0, vcu, G, Q, K, V, O); Seam S;
#ifdef ATTN_PRIO
    if ((threadIdx.x >> 8) != 0) __builtin_amdgcn_s_setprio(1);
#endif
    attn_prime(cur, lds, S);
    for (int n = 0; n < nblk; ++n) {
        const BlockRef nxt = (n + 1 < nblk) ? block_ref(n + 1, vcu, G, Q, K, V, O) : cur;
        attn_block<ABL>(cur, nxt, lds, S, lam, subg);
        cur = nxt;
    }
#ifdef ATTN_PRIO
    __builtin_amdgcn_s_setprio(0);
#endif
}
#undef KSWZ
#undef SBAR
}

constexpr int NWAVES = 8;
constexpr int BATCH = 32, SEQ = 2048, D = 1024, M = BATCH * SEQ, DIN = 8192, DFF = 2816, NGU = 2 * DFF, NMOD = 6 * D;
constexpr size_t MiB = 1u << 20;
constexpr size_t WS_S0 = 0, WS_S1 = 128 * MiB, WS_S2 = 256 * MiB, WS_S3 = 384 * MiB, WS_S4 = 512 * MiB, WS_S5 = 640 * MiB;
constexpr size_t WS_WIN = 768 * MiB, WS_WA = WS_WIN + 16 * MiB, WS_WB = WS_WA + 2 * MiB, WS_WO = WS_WB + 2 * MiB, WS_WGU = WS_WO + 2 * MiB, WS_WDN = WS_WGU + 11 * MiB, WS_MOD = WS_WDN + 6 * MiB, WS_CTL = WS_MOD + 1 * MiB, WS_END = WS_CTL + 1 * MiB;
constexpr int RING_BYTES = 131072, LDS_BYTES = 147456;
#define LAS __attribute__((address_space(3)))
typedef unsigned short bf16;
typedef unsigned v4u __attribute__((ext_vector_type(4)));
typedef unsigned v2u __attribute__((ext_vector_type(2)));
typedef float f32x4 __attribute__((ext_vector_type(4)));
__device__ __forceinline__ unsigned pk2(float lo, float hi) { return pg8::cvt_pk_bf16(lo, hi); }
__device__ __forceinline__ float wave_sum(float v) { return pg8::wave_sum64(v); }
__device__ __forceinline__ void transpose_item(const float* W, int K, int N, int src_col0, bf16* WT, int dst_row0, int k0, LAS float* scr, int lane) {
#pragma unroll 8
    for (int i = 0; i < 32; ++i) { const int kk = 2 * i + (lane >> 5); scr[kk * 33 + (lane & 31)] = W[(size_t)(k0 + kk) * N + src_col0 + (lane & 31)]; }
    asm volatile("s_waitcnt lgkmcnt(0)" ::: "memory");
    const int c = lane & 7;
#pragma unroll
    for (int j = 0; j < 4; ++j) { const int n = (lane >> 3) + 8 * j; const LAS float* s = scr + (8 * c) * 33 + n;
        v4u o; o.x = pk2(s[0 * 33], s[1 * 33]); o.y = pk2(s[2 * 33], s[3 * 33]); o.z = pk2(s[4 * 33], s[5 * 33]); o.w = pk2(s[6 * 33], s[7 * 33]);
        *(v4u*)(WT + (size_t)(dst_row0 + n) * K + k0 + 8 * c) = o; }
    asm volatile("s_waitcnt lgkmcnt(0)" ::: "memory");
}
#ifdef FULL_LINE
__device__ __forceinline__ int grp64(int s) { return 64 * ((s & 127) >> 5) + 32 * (s >> 7); }
#else
__device__ __forceinline__ int grp64(int s) { return s; }
#endif
__device__ __forceinline__ int win_src(int n0) {
    if (n0 < 1024) return 3072 + (n0 & ~255) + grp64(n0 & 255);
    if (n0 < 3072) { const int p = (n0 - 1024) >> 8, s = n0 & 255; return s < 128 ? 4096 + 128 * p + s : 5120 + 128 * p + (s - 128); }
    if (n0 < 4096) { const int m = n0 - 3072; return 6144 + (m & ~255) + grp64(m & 255); }
    if (n0 < 6144) { const int m = n0 - 4096, pn = m >> 8, s = m & 255, bj = s >> 7, wc = (s & 127) >> 5; return pn * 256 + 64 * wc + 32 * bj; }
    if (n0 < 7168) { const int m = n0 - 6144; return 2048 + (m & ~255) + grp64(m & 255); }
    { const int m = n0 - 7168; return 7168 + (m & ~255) + grp64(m & 255); }
}
__device__ __forceinline__ int wgu_src(int n0) { const int p = n0 >> 8, s = n0 & 255; return s < 128 ? 128 * p + s : DFF + 128 * p + (s - 128); }

#ifndef P0_EARLY
#define P0_EARLY 3
#endif
#ifndef NORM_RB
#define NORM_RB 4
#endif
__device__ __forceinline__ void norm_rows(const float* X, const float* g, const float* modsh, const float* modsc, bf16* H, int rb, int lane) {
    const size_t row0 = (size_t)rb * 32; const int b = (int)(row0 >> 11);
    f32x4 av[4], sv[4];
#pragma unroll
    for (int j = 0; j < 4; ++j) { const int idx = 4 * lane + 256 * j; const f32x4 gg = *(const f32x4*)(g + idx), sc = *(const f32x4*)(modsc + (size_t)b * NMOD + idx); av[j] = gg * (sc + 1.0f); sv[j] = *(const f32x4*)(modsh + (size_t)b * NMOD + idx); }
    for (int r0 = 0; r0 < 32; r0 += NORM_RB) {
        f32x4 v[NORM_RB][4];
#pragma unroll
        for (int rr = 0; rr < NORM_RB; ++rr) { const f32x4* xr = (const f32x4*)(X + (row0 + r0 + rr) * D) + lane;
#pragma unroll
            for (int j = 0; j < 4; ++j) v[rr][j] = xr[64 * j]; }
#pragma unroll
        for (int rr = 0; rr < NORM_RB; ++rr) { float s = 0.f;
#pragma unroll
            for (int j = 0; j < 4; ++j) s += (v[rr][j].x * v[rr][j].x + v[rr][j].y * v[rr][j].y) + (v[rr][j].z * v[rr][j].z + v[rr][j].w * v[rr][j].w);
            const float rstd = rsqrtf(wave_sum(s) * (1.f / D) + 1e-6f);
            v2u* o8 = (v2u*)(H + (row0 + r0 + rr) * D) + lane;
#pragma unroll
            for (int j = 0; j < 4; ++j) { const f32x4 y = v[rr][j] * rstd * av[j] + sv[j]; v2u w; w.x = pk2(y.x, y.y); w.y = pk2(y.z, y.w); o8[64 * j] = w; } }
    }
}

#define XB_TMO      128
#define XB_XCNT(j)  (256  + 64 * (j))
#define XB_XSUB(j)  (1280 + 64 * (j))
#define XB_XGEN(j)  (2304 + 64 * (j))
#define XB_TOP      3328
#define XB_TOPGEN   3392
#define XCD_BAR_WORDS 3456
#define XB_SPIN_CAP (1u << 18)

__device__ __forceinline__ unsigned xb_ld(unsigned* p)              { return __hip_atomic_load(p, __ATOMIC_RELAXED, __HIP_MEMORY_SCOPE_AGENT); }
__device__ __forceinline__ unsigned xb_add(unsigned* p, unsigned v) { return __hip_atomic_fetch_add(p, v, __ATOMIC_RELAXED, __HIP_MEMORY_SCOPE_AGENT); }
__device__ __forceinline__ unsigned xb_xcc_id() { return (unsigned)__builtin_amdgcn_s_getreg((3 << 11) | 20) & 0xFu; }
#define XB_SPIN(cond, bar) do { unsigned _sp = 0; while (cond) { __builtin_amdgcn_s_sleep(1); \
    if ((++_sp & 255u) == 0u) { if (xb_ld(&(bar)[XB_TMO])) break; if (_sp > XB_SPIN_CAP) { atomicAdd(&(bar)[XB_TMO], 1u); break; } } } } while (0)

struct XcdBarrier {
    unsigned* bar; unsigned x;
    volatile LAS unsigned* st;
};

__device__ __forceinline__ XcdBarrier xcd_barrier_post(unsigned* bar, volatile LAS unsigned* st) {
    XcdBarrier b; b.bar = bar; b.x = xb_xcc_id(); b.st = st;
    if (threadIdx.x == 0) (void)xb_add(&bar[XB_XCNT(b.x)], 1u);
    return b;
}
__device__ __forceinline__ void xcd_barrier_complete(unsigned* bar, unsigned x, unsigned& nloc, unsigned& nx) {
    const unsigned G = gridDim.x * gridDim.y * gridDim.z;
    unsigned sum, cnt, mine, sp = 0u;
    for (;;) {
        sum = 0u; cnt = 0u; mine = 0u;
#pragma unroll
        for (unsigned j = 0; j < 16; ++j) { const unsigned c = xb_ld(&bar[XB_XCNT(j)]); sum += c; cnt += (c > 0u) ? 1u : 0u; mine = (j == x) ? c : mine; }
        if (sum == G) break;
        __builtin_amdgcn_s_sleep(1);
        if ((++sp & 255u) == 0u) { if (xb_ld(&bar[XB_TMO])) break; if (sp > XB_SPIN_CAP) { atomicAdd(&bar[XB_TMO], 1u); break; } }
    }
    nloc = mine > 0u ? mine : 1u; nx = cnt > 0u ? cnt : 1u;
}

__device__ __forceinline__ void xcd_barrier(const XcdBarrier& b) {
    asm volatile("s_waitcnt vmcnt(0)" ::: "memory");
    __syncthreads();
    if (threadIdx.x == 0) {
        unsigned* bar = b.bar;
        __builtin_amdgcn_s_waitcnt(0);
        unsigned nloc = b.st[0], nx = b.st[1];
        if (nloc == 0u) { xcd_barrier_complete(bar, b.x, nloc, nx); b.st[0] = nloc; b.st[1] = nx; }
        const unsigned old = xb_add(&bar[XB_XSUB(b.x)], 1u);
        const unsigned gen = old / nloc;
        if (old + 1u == (gen + 1u) * nloc) {
            __builtin_amdgcn_fence(__ATOMIC_RELEASE, "agent");
            asm volatile("s_waitcnt vmcnt(0)" ::: "memory");
            const unsigned og = xb_add(&bar[XB_TOP], 1u);
            const unsigned tg = og / nx;
            if (og + 1u == (tg + 1u) * nx) xb_add(&bar[XB_TOPGEN], 1u);
            else XB_SPIN(xb_ld(&bar[XB_TOPGEN]) == tg, bar);
            __builtin_amdgcn_fence(__ATOMIC_ACQUIRE, "agent");
            xb_add(&bar[XB_XGEN(b.x)], 1u);
            asm volatile("s_waitcnt vmcnt(0)" ::: "memory");
        } else {
            XB_SPIN(xb_ld(&bar[XB_XGEN(b.x)]) == gen, bar);
            __builtin_amdgcn_fence(__ATOMIC_ACQUIRE, "agent");
            asm volatile("s_waitcnt vmcnt(0)" ::: "memory");
        }
    }
    __syncthreads();
}


__device__ __forceinline__ unsigned pk4_fp8(float a, float b, float c, float d) { unsigned w = 0u; w = (unsigned)__builtin_amdgcn_cvt_pk_fp8_f32(a, b, (int)w, false); w = (unsigned)__builtin_amdgcn_cvt_pk_fp8_f32(c, d, (int)w, true); return w; }
constexpr float WGU_FP8_SCALE = 32.f;
__device__ __forceinline__ void transpose_item8(const float* W, int K, int N, int src_col0, unsigned char* WT, int dst_row0, int k0, LAS float* scr, int lane, float scale) {
#pragma unroll 8
    for (int i = 0; i < 32; ++i) { const int kk = 2 * i + (lane >> 5); scr[kk * 33 + (lane & 31)] = W[(size_t)(k0 + kk) * N + src_col0 + (lane & 31)]; }
    asm volatile("s_waitcnt lgkmcnt(0)" ::: "memory");
    const int n = lane >> 1, kh = (lane & 1) * 32; const LAS float* s = scr + kh * 33 + n;
    v4u o0, o1;
    o0.x = pk4_fp8(s[0 * 33] * scale, s[1 * 33] * scale, s[2 * 33] * scale, s[3 * 33] * scale);     o0.y = pk4_fp8(s[4 * 33] * scale, s[5 * 33] * scale, s[6 * 33] * scale, s[7 * 33] * scale);
    o0.z = pk4_fp8(s[8 * 33] * scale, s[9 * 33] * scale, s[10 * 33] * scale, s[11 * 33] * scale);   o0.w = pk4_fp8(s[12 * 33] * scale, s[13 * 33] * scale, s[14 * 33] * scale, s[15 * 33] * scale);
    o1.x = pk4_fp8(s[16 * 33] * scale, s[17 * 33] * scale, s[18 * 33] * scale, s[19 * 33] * scale); o1.y = pk4_fp8(s[20 * 33] * scale, s[21 * 33] * scale, s[22 * 33] * scale, s[23 * 33] * scale);
    o1.z = pk4_fp8(s[24 * 33] * scale, s[25 * 33] * scale, s[26 * 33] * scale, s[27 * 33] * scale); o1.w = pk4_fp8(s[28 * 33] * scale, s[29 * 33] * scale, s[30 * 33] * scale, s[31 * 33] * scale);
    v4u* dst = (v4u*)(WT + (size_t)(dst_row0 + n) * K + k0 + kh); dst[0] = o0; dst[1] = o1;
    asm volatile("s_waitcnt lgkmcnt(0)" ::: "memory");
}
__device__ __forceinline__ void norm_rows8(const float* X, const float* g, const float* modsh, const float* modsc, unsigned char* H8, int rb, int lane) {
    const size_t row0 = (size_t)rb * 32; const int b = (int)(row0 >> 11);
    f32x4 av[4], sv[4];
#pragma unroll
    for (int j = 0; j < 4; ++j) { const int idx = 4 * lane + 256 * j; const f32x4 gg = *(const f32x4*)(g + idx), sc = *(const f32x4*)(modsc + (size_t)b * NMOD + idx); av[j] = gg * (sc + 1.0f); sv[j] = *(const f32x4*)(modsh + (size_t)b * NMOD + idx); }
    for (int r0 = 0; r0 < 32; r0 += NORM_RB) {
        f32x4 v[NORM_RB][4];
#pragma unroll
        for (int rr = 0; rr < NORM_RB; ++rr) { const f32x4* xr = (const f32x4*)(X + (row0 + r0 + rr) * D) + lane;
#pragma unroll
            for (int j = 0; j < 4; ++j) v[rr][j] = xr[64 * j]; }
#pragma unroll
        for (int rr = 0; rr < NORM_RB; ++rr) { float s = 0.f;
#pragma unroll
            for (int j = 0; j < 4; ++j) s += (v[rr][j].x * v[rr][j].x + v[rr][j].y * v[rr][j].y) + (v[rr][j].z * v[rr][j].z + v[rr][j].w * v[rr][j].w);
            const float rstd = rsqrtf(wave_sum(s) * (1.f / D) + 1e-6f);
            unsigned* o4 = (unsigned*)(H8 + (row0 + r0 + rr) * D) + lane;
#pragma unroll
            for (int j = 0; j < 4; ++j) { const f32x4 y = v[rr][j] * rstd * av[j] + sv[j]; o4[64 * j] = pk4_fp8(y.x, y.y, y.z, y.w); } }
    }
}
#ifndef FP8_SP2
#define FP8_SP2 true
#endif
#ifndef GEMM_ALIGN
#define GEMM_ALIGN true
#endif
#ifndef GEMM_SP2
#define GEMM_SP2 true
#endif
struct Args { const float* in[20]; float* out; unsigned char* ws; };
__global__ void __launch_bounds__(NWAVES * 64, 2) fwd_megakernel(Args args) {
    extern __shared__ __attribute__((aligned(16))) unsigned char lds[];
    cg::grid_group grid = cg::this_grid();
    const int G = gridDim.x, bx = blockIdx.x, vcu = (G % 8 == 0) ? (bx % 8) * (G / 8) + bx / 8 : bx;
    const int NGW = G * NWAVES;
#define GRID_SYNC() do { xcd_barrier(xbar); asm volatile("" ::: "memory"); } while (0)
#define PHASE_IDS() int tid = threadIdx.x; asm volatile("" : "+v"(tid)); const int lane = tid & 63, wave = __builtin_amdgcn_readfirstlane(tid >> 6), gw = vcu * NWAVES + wave; (void)lane; (void)gw
    unsigned char* ws = args.ws;
    const float* x = args.in[0];
    bf16* S0 = (bf16*)(ws + WS_S0); bf16* S1 = (bf16*)(ws + WS_S1); bf16* S2 = (bf16*)(ws + WS_S2); bf16* S3 = (bf16*)(ws + WS_S3); bf16* S4 = (bf16*)(ws + WS_S4); bf16* S5 = (bf16*)(ws + WS_S5);
    bf16* WIN = (bf16*)(ws + WS_WIN); bf16* WA = (bf16*)(ws + WS_WA); bf16* WB = (bf16*)(ws + WS_WB); bf16* WO = (bf16*)(ws + WS_WO); bf16* WGU = (bf16*)(ws + WS_WGU); bf16* WDN = (bf16*)(ws + WS_WDN);
    float* mod = (float*)(ws + WS_MOD);
    float* X1 = (float*)(ws + WS_S1);
    LAS unsigned char* ldsl = (LAS unsigned char*)lds;
    volatile LAS unsigned* MISC = (volatile LAS unsigned*)(ldsl + RING_BYTES + 320);
    if (threadIdx.x < 32) MISC[threadIdx.x] = 0u;
    __syncthreads();
    XcdBarrier xbar = xcd_barrier_post((unsigned*)(ws + WS_CTL), MISC + 8);
    if (args.out == nullptr) grid.sync();

    if (bx < 96) {
        PHASE_IDS();
        LAS float* cact = (LAS float*)ldsl;
        const float* c = args.in[1];
        for (int i = tid; i < BATCH * D; i += NWAVES * 64) { const int b = i >> 10, k = i & 1023; const float cv = c[i]; cact[k * 32 + b] = cv / (1.f + __expf(-cv)); }
        __syncthreads();
        const float* wada = args.in[2]; const int col = bx * 64 + lane, k0 = wave * 128;
        float acc[32];
#pragma unroll
        for (int b = 0; b < 32; ++b) acc[b] = 0.f;
#pragma unroll 4
        for (int kk = 0; kk < 128; ++kk) { const float w = wada[(size_t)(k0 + kk) * NMOD + col]; const LAS f32x4* cp = (const LAS f32x4*)(cact + (k0 + kk) * 32);
#pragma unroll
            for (int j = 0; j < 8; ++j) { const f32x4 cv = cp[j]; acc[4 * j] += w * cv.x; acc[4 * j + 1] += w * cv.y; acc[4 * j + 2] += w * cv.z; acc[4 * j + 3] += w * cv.w; } }
        __syncthreads();
        LAS float* part = (LAS float*)ldsl;
#pragma unroll
        for (int b = 0; b < 32; ++b) part[(wave * 32 + b) * 64 + lane] = acc[b];
        __syncthreads();
        const float* bada = args.in[3];
        for (int o = tid; o < 2048; o += NWAVES * 64) { const int b = o >> 6, cl = o & 63; float s = 0.f;
#pragma unroll
            for (int w = 0; w < 8; ++w) s += part[(w * 32 + b) * 64 + cl];
            mod[(size_t)b * NMOD + bx * 64 + cl] = s + bada[bx * 64 + cl]; }
        __syncthreads();
    }
    {
        PHASE_IDS();
        LAS float* scr = (LAS float*)(ldsl + wave * 16384);
        constexpr int I_IN = 16 * 256, I_SQ = 16 * 32, I_GU = 16 * 176, I_DN = 44 * 32, NITEMS = I_IN + 3 * I_SQ + I_GU + I_DN;
        for (int it = gw; it < NITEMS; it += NGW) {
            int r = it;
            if (r < I_IN) { const int kb = r >> 8, nb = r & 255; transpose_item(args.in[5], D, DIN, win_src(32 * nb), WIN, 32 * nb, 64 * kb, scr, lane); continue; } r -= I_IN;
            if (r < I_SQ) { const int kb = r >> 5, nb = r & 31; transpose_item(args.in[14], D, D, 32 * nb, WA, 32 * nb, 64 * kb, scr, lane); continue; } r -= I_SQ;
            if (r < I_SQ) { const int kb = r >> 5, nb = r & 31; transpose_item(args.in[15], D, D, 32 * nb, WB, 32 * nb, 64 * kb, scr, lane); continue; } r -= I_SQ;
            if (r < I_SQ) { const int kb = r >> 5, nb = r & 31; transpose_item(args.in[16], D, D, 32 * nb, WO, 32 * nb, 64 * kb, scr, lane); continue; } r -= I_SQ;
#ifdef FFN_FP8
            if (r < I_GU) { const int kb = r / 176, nb = r % 176; transpose_item8(args.in[18], D, NGU, wgu_src(32 * nb), (unsigned char*)WGU, 32 * nb, 64 * kb, scr, lane, WGU_FP8_SCALE); continue; } r -= I_GU;
#else
            if (r < I_GU) { const int kb = r / 176, nb = r % 176; transpose_item(args.in[18], D, NGU, wgu_src(32 * nb), WGU, 32 * nb, 64 * kb, scr, lane); continue; } r -= I_GU;
#endif
            { const int kb = r >> 5, nb = r & 31; transpose_item(args.in[19], DFF, D, 32 * nb, WDN, 32 * nb, 64 * kb, scr, lane); }
        }
    }
    GRID_SYNC();
#ifdef EXP_BAR10
    GRID_SYNC(); GRID_SYNC(); GRID_SYNC(); GRID_SYNC(); GRID_SYNC(); GRID_SYNC(); GRID_SYNC(); GRID_SYNC(); GRID_SYNC(); GRID_SYNC();
#endif
    { PHASE_IDS(); for (int rb = gw; rb < M / 32; rb += NGW) norm_rows(x, args.in[4], mod, mod + D, S0, rb, lane); }
    GRID_SYNC();

    pg8::StaticOrder SO; pg8::Gemm g; pg8::EpiAll E{};
    LAS pg8::EpiP* EP = (LAS pg8::EpiP*)pg8::EPI_LDS_ADDR;
#define EPI_SET(stmts) do { if (threadIdx.x == 0) { stmts; } __syncthreads(); } while (0)
    g = pg8::Gemm{S0, WIN, M, 4096, D}; SO.init(M, 4096, G, bx);
    E.mode = 5; EPI_SET(EP->o3 = S1; EP->o4 = S2; EP->o5 = S3);
    pg8::gemm_phase<pg8::EpiAll, pg8::StaticOrder, GEMM_ALIGN, GEMM_SP2>(ldsl, g, SO, E);
    GRID_SYNC();
#ifdef EXP_KLOOP
    E.mode = EXP_KLOOP; EPI_SET(EP->o3 = S4; EP->o4 = S4; EP->o5 = S5); pg8::gemm_phase<pg8::EpiAll, pg8::StaticOrder, GEMM_ALIGN, GEMM_SP2>(ldsl, g, SO, E);
    GRID_SYNC();
#endif
    {
        PHASE_IDS();
        const float* cw = args.in[6]; const int NT = G * NWAVES * 64, gt = vcu * (NWAVES * 64) + tid;
        for (int it = gt; it < (M / 16) * 128; it += NT) {
            const int cgp = it & 127, rbk = it >> 7; const size_t t0 = (size_t)rbk * 16; const int c0 = cgp * 8;
            f32x4 w0a = *(const f32x4*)(cw + c0), w0b = *(const f32x4*)(cw + c0 + 4), w1a = *(const f32x4*)(cw + D + c0), w1b = *(const f32x4*)(cw + D + c0 + 4), w2a = *(const f32x4*)(cw + 2 * D + c0), w2b = *(const f32x4*)(cw + 2 * D + c0 + 4);
            f32x4 p2a = {0.f, 0.f, 0.f, 0.f}, p2b = p2a, p1a = p2a, p1b = p2a;
            if ((t0 & (SEQ - 1)) != 0) { pg8::unpack8(*(const v4u*)(S2 + (t0 - 2) * D + c0), p2a, p2b); pg8::unpack8(*(const v4u*)(S2 + (t0 - 1) * D + c0), p1a, p1b); }
#pragma unroll 4
            for (int r = 0; r < 16; ++r) { f32x4 ua, ub, ba, bb; pg8::unpack8(*(const v4u*)(S2 + (t0 + r) * D + c0), ua, ub); pg8::unpack8(*(const v4u*)(S1 + (t0 + r) * D + c0), ba, bb);
                const f32x4 ya = ba * (w0a * p2a + w1a * p1a + w2a * ua), yb = bb * (w0b * p2b + w1b * p1b + w2b * ub);
                *(v4u*)(S1 + (t0 + r) * D + c0) = pg8::pack8(ya, yb); p2a = p1a; p2b = p1b; p1a = ua; p1b = ub; }
        }
    }
    GRID_SYNC();
    SO.init(M, D, G, bx);
    g = pg8::Gemm{S1, WA, M, D, D}; E.mode = 1; EPI_SET(EP->o0 = S3; EP->o1 = S3);
    pg8::gemm_phase<pg8::EpiAll, pg8::StaticOrder, GEMM_ALIGN, GEMM_SP2>(ldsl, g, SO, E);
    GRID_SYNC();
    g = pg8::Gemm{S0, WIN + (size_t)4096 * D, M, 4096, D}; SO.init(M, 4096, G, bx);
    E.mode = 0; EPI_SET(EP->o0 = S1; EP->o1 = S2; EP->o2 = S4; EP->o6 = S5; EP->f0 = args.in[7]; EP->f1 = args.in[8]);
    pg8::gemm_phase<pg8::EpiAll, pg8::StaticOrder, GEMM_ALIGN, GEMM_SP2>(ldsl, g, SO, E);
    GRID_SYNC();
    {
        PHASE_IDS();
        float l1 = args.in[9][lane] * args.in[10][lane], l2 = args.in[11][lane] * args.in[12][lane];
        l1 = wave_sum(l1); l2 = wave_sum(l2);
        const float lam = __uint_as_float(__builtin_amdgcn_readfirstlane(__float_as_uint(__expf(l1) - __expf(l2) + 0.2f)));
        attn2::attn_phase<0>((char*)lds, S1, S2, S4, S0, vcu, G, lam, args.in[13]);
#ifdef EXP_ATTN
        GRID_SYNC(); attn2::attn_phase<EXP_ATTN>((char*)lds, S1, S2, S4, (bf16*)(ws + 816 * MiB), vcu, G, lam, args.in[13]);
#endif
    }
    GRID_SYNC();
    SO.init(M, D, G, bx);
    g = pg8::Gemm{S0, WB, M, D, D}; E.mode = 2; EPI_SET(EP->o0 = S3; EP->o1 = S5);
    pg8::gemm_phase<pg8::EpiAll, pg8::StaticOrder, GEMM_ALIGN, GEMM_SP2>(ldsl, g, SO, E);
    GRID_SYNC();
#ifdef EXP_NOFFN
    g = pg8::Gemm{S3, WO, M, D, D}; E.mode = 3; EPI_SET(EP->f0 = x; EP->f1 = mod + 2 * D; EP->fo = args.out);
    pg8::gemm_phase<pg8::EpiAll, pg8::StaticOrder, GEMM_ALIGN, GEMM_SP2>(ldsl, g, SO, E);
    return;
#endif
#ifdef P5_PANEL
    g = pg8::Gemm{S3, WO, M, D, D}; SO.init(M, D, G, bx); SO.panel = 1; E.mode = 3; EPI_SET(EP->f0 = x; EP->f1 = mod + 2 * D; EP->fo = X1);
    pg8::gemm_phase<pg8::EpiAll, pg8::StaticOrder, GEMM_ALIGN, GEMM_SP2>(ldsl, g, SO, E);
#else
    g = pg8::Gemm{S3, WO, M, D, D}; SO.init(M, D, G, bx); E.mode = 3; EPI_SET(EP->f0 = x; EP->f1 = mod + 2 * D; EP->fo = X1);
    pg8::gemm_phase<pg8::EpiAll, pg8::StaticOrder, GEMM_ALIGN, GEMM_SP2>(ldsl, g, SO, E);
    GRID_SYNC();
#endif
#ifdef P5_PANEL
    { PHASE_IDS(); for (int pnl = bx; pnl < M / 256; pnl += G) norm_rows(X1, args.in[17], mod + 3 * D, mod + 4 * D, S0, pnl * 8 + wave, lane); }
#else
#ifdef FFN_FP8
    { PHASE_IDS(); for (int rb = gw; rb < M / 32; rb += NGW) norm_rows8(X1, args.in[17], mod + 3 * D, mod + 4 * D, (unsigned char*)S0, rb, lane); }
#else
    { PHASE_IDS(); for (int rb = gw; rb < M / 32; rb += NGW) norm_rows(X1, args.in[17], mod + 3 * D, mod + 4 * D, S0, rb, lane); }
#endif
#endif
    GRID_SYNC();
#ifdef FFN_FP8
    g = pg8::Gemm{S0, WGU, M, NGU, D / 2}; SO.init(M, NGU, G, bx); E.mode = 6; EPI_SET(EP->o0 = S3);
    { pg8::EpiSw E8{1.f / WGU_FP8_SCALE}; pg8::gemm_phase<pg8::EpiSw, pg8::StaticOrder, GEMM_ALIGN, FP8_SP2, true>(ldsl, g, SO, E8); }
#else
    g = pg8::Gemm{S0, WGU, M, NGU, D}; SO.init(M, NGU, G, bx); E.mode = 4; EPI_SET(EP->o0 = S3);
    pg8::gemm_phase<pg8::EpiAll, pg8::StaticOrder, GEMM_ALIGN, GEMM_SP2>(ldsl, g, SO, E);
#endif
    GRID_SYNC();
    g = pg8::Gemm{S3, WDN, M, D, DFF}; SO.init(M, D, G, bx); E.mode = 3; EPI_SET(EP->f0 = X1; EP->f1 = mod + 5 * D; EP->fo = args.out);
    pg8::gemm_phase<pg8::EpiAll, pg8::StaticOrder, GEMM_ALIGN, GEMM_SP2>(ldsl, g, SO, E);
}

#ifdef FP8_TEST
__global__ void __launch_bounds__(NWAVES * 64, 2) fp8_only(const bf16* A, const bf16* Bt, bf16* out) {
    extern __shared__ __attribute__((aligned(16))) unsigned char lds[];
    LAS unsigned char* ldsl = (LAS unsigned char*)lds;
    LAS pg8::EpiP* EP = (LAS pg8::EpiP*)pg8::EPI_LDS_ADDR; if (threadIdx.x == 0) EP->o0 = out; __syncthreads();
    pg8::StaticOrder SO; SO.init(M, NGU, gridDim.x, blockIdx.x); pg8::Gemm g{A, Bt, M, NGU, D / 2};
    pg8::EpiSw E8{1.f / 32.f}; pg8::gemm_phase<pg8::EpiSw, pg8::StaticOrder, GEMM_ALIGN, FP8_SP2, true>(ldsl, g, SO, E8);
}
__global__ void __launch_bounds__(NWAVES * 64, 2) bf16_only(const bf16* A, const bf16* Bt, bf16* out) {
    extern __shared__ __attribute__((aligned(16))) unsigned char lds[];
    LAS unsigned char* ldsl = (LAS unsigned char*)lds;
    LAS pg8::EpiP* EP = (LAS pg8::EpiP*)pg8::EPI_LDS_ADDR; if (threadIdx.x == 0) EP->o0 = out; __syncthreads();
    pg8::StaticOrder SO; SO.init(M, NGU, gridDim.x, blockIdx.x); pg8::Gemm g{A, Bt, M, NGU, D};
    pg8::EpiSw E8{1.f}; pg8::gemm_phase<pg8::EpiSw, pg8::StaticOrder, GEMM_ALIGN, FP8_SP2, false>(ldsl, g, SO, E8);
}
#endif
extern "C" void kernel_launch(void* const* d_in, const int* in_sizes, int n_in, void* d_out, int out_size, void* d_ws, size_t ws_size, hipStream_t stream) {
    static int grid = 0;
    if (grid == 0) {
        if (n_in != 20 || in_sizes[0] != M * D || out_size != M * D || ws_size < WS_END) { fprintf(stderr, "kernel_launch: unexpected shapes (n_in %d, in0 %d, out %d, ws %zu)\n", n_in, n_in > 0 ? in_sizes[0] : -1, out_size, ws_size); grid = -1; return; }
        int dev = 0, cus = 0, per_cu = 0;
        (void)hipGetDevice(&dev); (void)hipDeviceGetAttribute(&cus, hipDeviceAttributeMultiprocessorCount, dev);
        (void)hipFuncSetAttribute((const void*)fwd_megakernel, hipFuncAttributeMaxDynamicSharedMemorySize, LDS_BYTES);
        if (hipOccupancyMaxActiveBlocksPerMultiprocessor(&per_cu, (const void*)fwd_megakernel, NWAVES * 64, LDS_BYTES) != hipSuccess || per_cu < 1) per_cu = 1;
        (void)hipGetLastError();
        grid = cus * per_cu;
    }
    if (grid < 0) return;
    (void)hipMemsetAsync((unsigned char*)d_ws + WS_CTL, 0, 16384, stream);
    Args a{};
    for (int i = 0; i < 20; ++i) a.in[i] = (const float*)d_in[i];
    a.out = (float*)d_out; a.ws = (unsigned char*)d_ws;
    void* kargs[] = {&a};
    hipError_t e = hipLaunchCooperativeKernel((const void*)fwd_megakernel, dim3(grid), dim3(NWAVES * 64), kargs, LDS_BYTES, stream);
    if (e != hipSuccess) fprintf(stderr, "cooperative launch failed: %s (grid %d)\n", hipGetErrorString(e), grid);
}
```

```cpp
#define FULL_LINE 1
#include <hip/hip_runtime.h>
#include <hip/hip_cooperative_groups.h>
#include <hip/hip_bf16.h>
#include <cstdio>
#include <cstdint>
#include <cmath>
namespace cg = cooperative_groups;
#ifndef PG8_WGM
#define PG8_WGM 8
#endif
namespace pg8 {
#define PG8_LAS __attribute__((address_space(3)))
typedef unsigned short bf16_t;
typedef short bf16x8 __attribute__((ext_vector_type(8)));
typedef float f32x4 __attribute__((ext_vector_type(4)));
typedef unsigned u32x4 __attribute__((ext_vector_type(4)));
constexpr int BM = 256, BK = 64, HALF = 128, HTB = HALF * BK * 2  , STAGE_BYTES = 8 * HTB, NXCD = 8, WGM = PG8_WGM;

__host__ __device__ __forceinline__ int lds_byte(int r, int c) { const int st = (r >> 4) * 2 + (c >> 5), rr = r & 15, cc = c & 31, ob = rr * 64 + cc * 2; return st * 1024 + (ob ^ (((ob >> 9) & 1) << 5)); }
__host__ __device__ __forceinline__ void stage_rc(int b, int& R, int& C) { const int st = b / 1024, sb = b % 1024, swz = sb ^ (((sb >> 9) & 1) << 5); R = (st >> 1) * 16 + swz / 64; C = (st & 1) * 32 + (swz % 64) / 2; }
__host__ __device__ __forceinline__ int perm32(int rho) { const int n = rho >> 4, i = rho & 15; return 8 * (i >> 2) + 4 * n + (i & 3); }

struct Unit { int pm, pn; };
struct Gemm { const bf16_t* A; const bf16_t* Bt; int M, N, K; };

struct StaticOrder {
    int nM, nN, nwg, G, c, panel;
    __host__ __device__ void init(int M, int N, int G_, int c_) { nM = M / BM; nN = N / BM; nwg = nM * nN; G = G_; c = c_; panel = 0; }
    __host__ __device__ bool next(int i, Unit& u) const {
        if (panel) { const int p_ = c + G * (i / nN); if (p_ >= nM) return false; u.pm = p_; u.pn = i % nN; return true; }
        const long L = (long)i * G + c; if (L >= nwg) return false;
        int wgid = (int)L; { const int q = nwg / NXCD, r = nwg % NXCD, xcd = wgid % NXCD, off = wgid / NXCD; wgid = (xcd < r ? xcd * (q + 1) : r * (q + 1) + (xcd - r) * q) + off; }
        const int nig = WGM * nN, gid = wgid / nig, fm = gid * WGM, gsz = (nM - fm) < WGM ? (nM - fm) : WGM;
        u.pm = fm + ((wgid % nig) % gsz); u.pn = (wgid % nig) / gsz; return true;
    }
    __device__ __forceinline__ void a_ready(const Unit&) const {}
    __device__ __forceinline__ void done(const Unit&) const {}
};
typedef float f32x2 __attribute__((ext_vector_type(2))); typedef __bf16 bf16x2_t __attribute__((ext_vector_type(2)));
__device__ __forceinline__ unsigned cvt_pk_bf16(float lo, float hi) { f32x2 v = {lo, hi}; bf16x2_t b = __builtin_convertvector(v, bf16x2_t); return __builtin_bit_cast(unsigned, b); }
constexpr float EPSF = 1e-6f;
constexpr float QC2 = 0.125f * 1.4426950408889634f;
__device__ __forceinline__ u32x4 pack8(const f32x4 a, const f32x4 b) { u32x4 w; w.x = cvt_pk_bf16(a[0], a[1]); w.y = cvt_pk_bf16(a[2], a[3]); w.z = cvt_pk_bf16(b[0], b[1]); w.w = cvt_pk_bf16(b[2], b[3]); return w; }
__device__ __forceinline__ float bf_lo(unsigned u) { return __uint_as_float(u << 16); }
__device__ __forceinline__ float bf_hi(unsigned u) { return __uint_as_float(u & 0xffff0000u); }
__device__ __forceinline__ void unpack8(const u32x4 w, f32x4& a, f32x4& b) { a = (f32x4){bf_lo(w.x), bf_hi(w.x), bf_lo(w.y), bf_hi(w.y)}; b = (f32x4){bf_lo(w.z), bf_hi(w.z), bf_lo(w.w), bf_hi(w.w)}; }
template <int X> __device__ __forceinline__ float swz_xor(float v) { return __uint_as_float((unsigned)__builtin_amdgcn_ds_swizzle((int)__float_as_uint(v), (X << 10) | 0x1f)); }
__device__ __forceinline__ float wave_sum64(float v) { v += swz_xor<1>(v); v += swz_xor<2>(v); v += swz_xor<4>(v); v += swz_xor<8>(v); v += swz_xor<16>(v);
    auto rr = __builtin_amdgcn_permlane32_swap(__float_as_uint(v), __float_as_uint(v), false, false); return __uint_as_float(rr[0]) + __uint_as_float(rr[1]); }
__device__ __forceinline__ float sigm(float x) { return __builtin_amdgcn_rcpf(1.f + __builtin_amdgcn_exp2f(-1.4426950408889634f * x)); }
#ifdef EXP_NOSIG
__device__ __forceinline__ f32x4 sigm4(const f32x4 v) { return v * 0.25f + 0.5f; }
#else
__device__ __forceinline__ f32x4 sigm4(const f32x4 v) { return (f32x4){sigm(v[0]), sigm(v[1]), sigm(v[2]), sigm(v[3])}; }
#endif

template <class T> __device__ __forceinline__ void st_g(T* p, const T v) { *(__attribute__((address_space(1))) T*)p = v; }
template <class T> __device__ __forceinline__ T ld_g(const T* p) { return *(const __attribute__((address_space(1))) T*)p; }
#ifndef EPI_NT_STORES
#define ST_NT(p, v) st_g((p), (v))
#else
#define ST_NT(p, v) __builtin_nontemporal_store((v), (p))
#endif
struct EpiP { bf16_t *o0, *o1, *o2, *o3, *o4, *o5, *o6; const float *f0, *f1; float* fo; };
constexpr unsigned EPI_LDS_ADDR = 131072 + 512;
#ifdef FULL_LINE
#define PL_COL (64 * wc + 8 * fq)
#define PL_BJ 32
#else
#define PL_COL (wc * 32 + 8 * fq)
#define PL_BJ HALF
#endif
struct EpiAll {
    static constexpr bool PERM = true, AFTER_DRAIN = false;
    int mode;
    __device__ __forceinline__ int vm_ops(const Unit& un) const {
        if (mode == 0 || mode == 1 || mode == 2) return 16;
        if (mode == 5) return (un.pn >= 4 && un.pn < 12) ? 8 : 16;
        if (mode == 3) return 32;
        if (mode == 4 || mode == 6) return 8;
        return 0; }
    __device__ __forceinline__ void operator()(const f32x4 (&acc)[2][2][4][2], const Unit& un, int wr, int wc, int fr, int fq) const {
        const PG8_LAS EpiP* P = (const PG8_LAS EpiP*)EPI_LDS_ADDR; const int pn = un.pn; const size_t row0 = (size_t)(mode == 98 ? 0 : un.pm) * BM + wr * 64 + fr;
        if (mode == 99) {
            f32x4 s = {0.f, 0.f, 0.f, 0.f};
#pragma unroll
            for (int ai = 0; ai < 2; ++ai)
#pragma unroll
                for (int bj = 0; bj < 2; ++bj)
#pragma unroll
                    for (int m = 0; m < 4; ++m) { s += acc[ai][bj][m][0]; s += acc[ai][bj][m][1]; }
            if (s[0] + s[1] + s[2] + s[3] == 12345.678f) P->o0[0] = 1;
            return; }
        if (mode == 0) {
            if (pn < 8) {
                const bool isq = pn < 4; bf16_t* base = isq ? P->o0 : P->o1; const float* g = isq ? P->f0 : P->f1; const float sc = isq ? QC2 : 1.f;
                f32x4 gv[2][2];
#pragma unroll
                for (int bj = 0; bj < 2; ++bj)
#pragma unroll
                    for (int n = 0; n < 2; ++n) gv[bj][n] = ld_g((const f32x4*)(g + 32 * bj + 8 * fq + 4 * n)) * sc;
                const int col0 = (pn & 3) * 256 + 64 * wc + 8 * fq;
#pragma unroll
                for (int ai = 0; ai < 2; ++ai)
#pragma unroll
                    for (int m = 0; m < 4; ++m) {
                        float ss = 0.f;
#pragma unroll
                        for (int bj = 0; bj < 2; ++bj)
#pragma unroll
                            for (int n = 0; n < 2; ++n) { const f32x4 x = acc[ai][bj][m][n]; ss += (x[0] * x[0] + x[1] * x[1]) + (x[2] * x[2] + x[3] * x[3]); }
                        ss += swz_xor<16>(ss); { auto rr = __builtin_amdgcn_permlane32_swap(__float_as_uint(ss), __float_as_uint(ss), false, false); ss = __uint_as_float(rr[0]) + __uint_as_float(rr[1]); }
                        const float rs = rsqrtf(ss * (1.f / 64.f) + EPSF);
                        bf16_t* rowp = base + (row0 + ai * HALF + m * 16) * 1024 + col0;
#pragma unroll
                        for (int bj = 0; bj < 2; ++bj) ST_NT((u32x4*)(rowp + 32 * bj), pack8(acc[ai][bj][m][0] * rs * gv[bj][0], acc[ai][bj][m][1] * rs * gv[bj][1]));
                    }
            } else if (pn < 12) {
                const int col0 = (pn & 3) * 256 + PL_COL;
#pragma unroll
                for (int ai = 0; ai < 2; ++ai)
#pragma unroll
                    for (int m = 0; m < 4; ++m) { bf16_t* rowp = P->o2 + (row0 + ai * HALF + m * 16) * 1024 + col0;
#pragma unroll
                        for (int bj = 0; bj < 2; ++bj) ST_NT((u32x4*)(rowp + bj * PL_BJ), pack8(acc[ai][bj][m][0], acc[ai][bj][m][1])); }
            } else {
                const int col0 = (pn & 3) * 256 + PL_COL;
#pragma unroll
                for (int ai = 0; ai < 2; ++ai)
#pragma unroll
                    for (int m = 0; m < 4; ++m) { bf16_t* rowp = P->o6 + (row0 + ai * HALF + m * 16) * 1024 + col0;
#pragma unroll
                        for (int bj = 0; bj < 2; ++bj) ST_NT((u32x4*)(rowp + bj * PL_BJ), pack8(sigm4(acc[ai][bj][m][0]), sigm4(acc[ai][bj][m][1]))); }
            }
        } else if (mode == 5 || mode == 98 || mode == 97) {
            const bool probe_ = mode == 97; u32x4 xa_ = {0u, 0u, 0u, 0u};
#define ST5(p, v) do { const u32x4 v_ = (v); if (probe_) xa_ ^= v_; else st_g((p), v_); } while (0)
            if (pn < 4) {
                const int col0 = pn * 256 + PL_COL;
#pragma unroll
                for (int ai = 0; ai < 2; ++ai)
#pragma unroll
                    for (int m = 0; m < 4; ++m) { bf16_t* rowp = P->o3 + (row0 + ai * HALF + m * 16) * 1024 + col0;
#pragma unroll
                        for (int bj = 0; bj < 2; ++bj) ST5((u32x4*)(rowp + bj * PL_BJ), pack8(acc[ai][bj][m][0], acc[ai][bj][m][1])); }
            } else if (pn < 12) {
                const int col0 = (pn - 4) * 128 + wc * 32 + 8 * fq;
#pragma unroll
                for (int ai = 0; ai < 2; ++ai)
#pragma unroll
                    for (int m = 0; m < 4; ++m)
                        ST5((u32x4*)(P->o4 + (row0 + ai * HALF + m * 16) * 1024 + col0), pack8(acc[ai][0][m][0] * acc[ai][1][m][0], acc[ai][0][m][1] * acc[ai][1][m][1]));
            } else {
                const int col0 = (pn & 3) * 256 + PL_COL;
#pragma unroll
                for (int ai = 0; ai < 2; ++ai)
#pragma unroll
                    for (int m = 0; m < 4; ++m) { bf16_t* rowp = P->o5 + (row0 + ai * HALF + m * 16) * 1024 + col0;
#pragma unroll
                        for (int bj = 0; bj < 2; ++bj) ST5((u32x4*)(rowp + bj * PL_BJ), pack8(sigm4(acc[ai][bj][m][0]), sigm4(acc[ai][bj][m][1]))); }
            }
            if (probe_ && (xa_.x ^ xa_.y ^ xa_.z ^ xa_.w) == 0x12345678u) *(unsigned*)P->o3 = 1u;
#undef ST5
        } else if (mode == 1 || mode == 2) {
            const int col0 = pn * 256 + wc * 32 + 8 * fq;
#pragma unroll
            for (int ai = 0; ai < 2; ++ai)
#pragma unroll
                for (int m = 0; m < 4; ++m) { const size_t off = (row0 + ai * HALF + m * 16) * 1024 + col0;
#pragma unroll
                    for (int bj = 0; bj < 2; ++bj) { f32x4 ga, gb; unpack8(ld_g((const u32x4*)(P->o1 + off + bj * HALF)), ga, gb);
                        f32x4 r0 = ga * acc[ai][bj][m][0], r1 = gb * acc[ai][bj][m][1];
                        if (mode == 2) { f32x4 ma, mb; unpack8(ld_g((const u32x4*)(P->o0 + off + bj * HALF)), ma, mb); r0 += ma; r1 += mb; }
                        ST_NT((u32x4*)(P->o0 + off + bj * HALF), pack8(r0, r1)); } }
        } else if (mode == 3) {
            const int col0 = pn * 256 + wc * 32 + 8 * fq; const float* gp = P->f1 + (size_t)((un.pm * BM) >> 11) * 6144 + col0;
            f32x4 gv[2][2];
#pragma unroll
            for (int bj = 0; bj < 2; ++bj)
#pragma unroll
                for (int n = 0; n < 2; ++n) gv[bj][n] = ld_g((const f32x4*)(gp + bj * HALF + 4 * n));
#pragma unroll
            for (int ai = 0; ai < 2; ++ai)
#pragma unroll
                for (int m = 0; m < 4; ++m) { const size_t off = (row0 + ai * HALF + m * 16) * 1024 + col0;
#pragma unroll
                    for (int bj = 0; bj < 2; ++bj)
#pragma unroll
                        for (int n = 0; n < 2; ++n) ST_NT((f32x4*)(P->fo + off + bj * HALF + 4 * n), ld_g((const f32x4*)(P->f0 + off + bj * HALF + 4 * n)) + gv[bj][n] * acc[ai][bj][m][n]); }
        } else {
            const int col0 = pn * 128 + wc * 32 + 8 * fq;
            const float sc6 = (mode == 6) ? (1.f / 32.f) : 1.f;
#pragma unroll
            for (int ai = 0; ai < 2; ++ai)
#pragma unroll
                for (int m = 0; m < 4; ++m) { const f32x4 g0 = acc[ai][0][m][0] * sc6, g1 = acc[ai][0][m][1] * sc6;
                    ST_NT((u32x4*)(P->o0 + (row0 + ai * HALF + m * 16) * 2816 + col0), pack8(g0 * sigm4(g0) * (acc[ai][1][m][0] * sc6), g1 * sigm4(g1) * (acc[ai][1][m][1] * sc6))); }
        }
    }
};

struct EpiSw {
    static constexpr bool PERM = true, AFTER_DRAIN = false; float sc;
    __device__ __forceinline__ int vm_ops(const Unit&) const { return 8; }
    __device__ __forceinline__ void operator()(const f32x4 (&acc)[2][2][4][2], const Unit& un, int wr, int wc, int fr, int fq) const {
        const PG8_LAS EpiP* P = (const PG8_LAS EpiP*)EPI_LDS_ADDR; const size_t row0 = (size_t)un.pm * BM + wr * 64 + fr; const int col0 = un.pn * 128 + wc * 32 + 8 * fq;
        bf16_t* ob = P->o0;
#pragma unroll
        for (int ai = 0; ai < 2; ++ai)
#pragma unroll
            for (int m = 0; m < 4; ++m) { const f32x4 g0 = acc[ai][0][m][0] * sc, g1 = acc[ai][0][m][1] * sc;
                st_g((u32x4*)(ob + (row0 + ai * HALF + m * 16) * 2816 + col0), pack8(g0 * sigm4(g0) * (acc[ai][1][m][0] * sc), g1 * sigm4(g1) * (acc[ai][1][m][1] * sc))); }
    }
};

template <class Epi, class Sched, bool ALIGN_EPI = false, bool SP2 = false, bool FP8 = false>
__device__ __forceinline__ void gemm_phase(PG8_LAS unsigned char* lds, const Gemm g, const Sched& S, const Epi& E) {
    int tid_ = threadIdx.x; asm volatile("" : "+v"(tid_)); const int tid = tid_, wid = __builtin_amdgcn_readfirstlane(tid >> 6), lane = tid & 63, wr = wid >> 2, wc = wid & 3, fr = lane & 15, fq = lane >> 4;
    const int K = g.K, nt = K / BK;
    unsigned voffA[2], voffB[2];
#pragma unroll
    for (int i = 0; i < 2; ++i) { int R, C; stage_rc(tid * 16 + i * 8192, R, C); const int Rb = Epi::PERM ? ((R & ~31) + perm32(R & 31)) : R;
        voffA[i] = (unsigned)(R * K + C) * 2u; voffB[i] = (unsigned)(Rb * K + C) * 2u; }
    const size_t kstep = (size_t)(BK * 2);
    const size_t hstep = (size_t)HALF * K * 2;
    const size_t tstep = 2 * hstep;
    const unsigned ldsw = (unsigned)wid * 1024u;
    const int aoff = FP8 ? lds_byte(wr * 64 + fr, fq * 16) : lds_byte(wr * 64 + fr, fq * 8), boff = FP8 ? lds_byte(wc * 32 + fr, fq * 16) : lds_byte(wc * 32 + fr, fq * 8);
    const int aoff1 = aoff + (FP8 ? 16 : 1024), boff1 = boff + (FP8 ? 16 : 1024);
#define PG8_SA(b, h) (((b) * 2 + (h)) * HTB)
#define PG8_SB(b, h) ((4 + (b) * 2 + (h)) * HTB)
#define PG8_STAGE(bufoff, gbase, voff) do { _Pragma("unroll") for (int _i = 0; _i < 2; ++_i) \
        __builtin_amdgcn_global_load_lds((const unsigned*)((const char*)(gbase) + (voff)[_i]), (PG8_LAS unsigned*)(lds + (bufoff) + ldsw + _i * 8192), 16, 0, 0); } while (0)
#define PG8_LDA(dst, b, h) do { _Pragma("unroll") for (int m = 0; m < 4; ++m) { if constexpr (FP8) { int ao_ = aoff; asm volatile("" : "+v"(ao_));   const v4i_ lo_ = *(const PG8_LAS v4i_*)(lds + PG8_SA(b, h) + ao_ + m * 2048), hi_ = *(const PG8_LAS v4i_*)(lds + PG8_SA(b, h) + ao_ + 16 + m * 2048); dst##8[m] = __builtin_shufflevector(lo_, hi_, 0, 1, 2, 3, 4, 5, 6, 7); } \
        else { _Pragma("unroll") for (int k = 0; k < 2; ++k) dst[m][k] = *(const PG8_LAS bf16x8*)(lds + PG8_SA(b, h) + aoff + m * 2048 + k * 1024); } } } while (0)
#define PG8_LDB(dst, b, h) do { _Pragma("unroll") for (int n = 0; n < 2; ++n) { if constexpr (FP8) { int bo_ = boff; asm volatile("" : "+v"(bo_)); const v4i_ lo_ = *(const PG8_LAS v4i_*)(lds + PG8_SB(b, h) + bo_ + n * 2048), hi_ = *(const PG8_LAS v4i_*)(lds + PG8_SB(b, h) + bo_ + 16 + n * 2048); dst##8[n] = __builtin_shufflevector(lo_, hi_, 0, 1, 2, 3, 4, 5, 6, 7); } \
        else { _Pragma("unroll") for (int k = 0; k < 2; ++k) dst[n][k] = *(const PG8_LAS bf16x8*)(lds + PG8_SB(b, h) + boff + n * 2048 + k * 1024); } } } while (0)
#define PG8_MMA(ai, bj, At, Bt) do { __builtin_amdgcn_s_setprio(1); _Pragma("unroll") for (int m = 0; m < 4; ++m) _Pragma("unroll") for (int n = 0; n < 2; ++n) { \
        if constexpr (FP8) { acc[ai][bj][m][n] = __builtin_amdgcn_mfma_scale_f32_16x16x128_f8f6f4(Bt##8[n], At##8[m], acc[ai][bj][m][n], 0, 0, 0, 0, 0, 0); } \
        else { _Pragma("unroll") for (int k = 0; k < 2; ++k) acc[ai][bj][m][n] = __builtin_amdgcn_mfma_f32_16x16x32_bf16(Bt[n][k], At[m][k], acc[ai][bj][m][n], 0, 0, 0); } } \
        __builtin_amdgcn_s_setprio(0); } while (0)
#define PG8_WAIT_V(n) asm volatile("s_waitcnt vmcnt(" #n ")" ::: "memory")
#define PG8_WAIT_L(n) asm volatile("s_waitcnt lgkmcnt(" #n ")" ::: "memory")
#define PG8_BAR __builtin_amdgcn_s_barrier()
#define PG8_SCHED __builtin_amdgcn_sched_barrier(0)
#ifdef GEMM_STAG
    { const unsigned g_ = (blockIdx.x >> 3) & (GEMM_STAGN - 1u); if (g_) { const unsigned long long t0_ = __builtin_amdgcn_s_memrealtime(); while (__builtin_amdgcn_s_memrealtime() - t0_ < (unsigned long long)(g_ * GEMM_STAG)) __builtin_amdgcn_s_sleep(8); } }
#endif
    Unit cur, nxt; int ui = 0;
    if (!S.next(0, cur)) return;
    f32x4 acc[2][2][4][2];
#pragma unroll
    for (int a = 0; a < 2; ++a)
#pragma unroll
        for (int b = 0; b < 2; ++b)
#pragma unroll
            for (int m = 0; m < 4; ++m)
#pragma unroll
                for (int n = 0; n < 2; ++n) acc[a][b][m][n] = (f32x4){0.f, 0.f, 0.f, 0.f};
    typedef int v4i_ __attribute__((ext_vector_type(4))); typedef int v8i_ __attribute__((ext_vector_type(8)));
    bf16x8 At[4][2], B0[2][2], B1[2][2]; v8i_ At8[4], B08[2], B18[2];
    const char* cA = (const char*)g.A + (size_t)cur.pm * tstep; const char* cB = (const char*)g.Bt + (size_t)cur.pn * tstep;
    S.a_ready(cur);
    if constexpr (SP2) {
        PG8_STAGE(PG8_SB(0, 0), cB, voffB); PG8_STAGE(PG8_SB(0, 1), cB + hstep, voffB); PG8_STAGE(PG8_SA(0, 0), cA, voffA); PG8_STAGE(PG8_SA(0, 1), cA + hstep, voffA);
        if (wr == 1) PG8_BAR;
        PG8_WAIT_V(2); PG8_BAR;
        PG8_STAGE(PG8_SB(1, 0), cB + kstep, voffB); PG8_STAGE(PG8_SA(1, 0), cA + kstep, voffA); PG8_STAGE(PG8_SB(1, 1), cB + hstep + kstep, voffB);
        PG8_WAIT_V(6); PG8_BAR;
    } else {
        PG8_STAGE(PG8_SB(0, 0), cB, voffB); PG8_STAGE(PG8_SA(0, 0), cA, voffA); PG8_STAGE(PG8_SB(0, 1), cB + hstep, voffB); PG8_STAGE(PG8_SA(0, 1), cA + hstep, voffA);
        if (wr == 1) PG8_BAR;
        PG8_WAIT_V(4); PG8_BAR;
        PG8_STAGE(PG8_SB(1, 0), cB + kstep, voffB); PG8_STAGE(PG8_SA(1, 0), cA + kstep, voffA); PG8_STAGE(PG8_SB(1, 1), cB + hstep + kstep, voffB);
        PG8_WAIT_V(6); PG8_BAR;
    }
    for (;;) {
        const bool has_next = S.next(ui + 1, nxt);
        const char* nA = has_next ? (const char*)g.A + (size_t)nxt.pm * tstep : cA; const char* nB = has_next ? (const char*)g.Bt + (size_t)nxt.pn * tstep : cB;
        for (int t = 0; t < nt; t += 2) {
            const bool last = (t == nt - 2);
            const char* a1 = cA + (size_t)(t + 1) * kstep;
            const char* a2 = last ? nA : cA + (size_t)(t + 2) * kstep; const char* b2 = last ? nB : cB + (size_t)(t + 2) * kstep;
            const char* a3 = a2 + kstep; const char* b3 = b2 + kstep;
            if (last && has_next) S.a_ready(nxt);
            if constexpr (SP2) {
            PG8_LDB(B0, 0, 0); PG8_LDB(B1, 0, 1); PG8_SCHED; PG8_LDA(At, 0, 0); PG8_STAGE(PG8_SA(1, 1), a1 + hstep, voffA);
            PG8_WAIT_V(8); PG8_WAIT_L(0); PG8_BAR; PG8_MMA(0, 0, At, B0); PG8_MMA(0, 1, At, B1); PG8_BAR; PG8_SCHED;
            PG8_LDA(At, 0, 1); PG8_STAGE(PG8_SB(0, 0), b2, voffB); PG8_STAGE(PG8_SB(0, 1), b2 + hstep, voffB); PG8_STAGE(PG8_SA(0, 0), a2, voffA);
            PG8_WAIT_V(8); PG8_WAIT_L(0); PG8_BAR; PG8_MMA(1, 0, At, B0); PG8_MMA(1, 1, At, B1); PG8_BAR; PG8_SCHED;
            PG8_LDB(B0, 1, 0); PG8_LDB(B1, 1, 1); PG8_SCHED; PG8_LDA(At, 1, 0); PG8_STAGE(PG8_SA(0, 1), a2 + hstep, voffA);
            PG8_WAIT_V(8); PG8_WAIT_L(0); PG8_BAR; PG8_MMA(0, 0, At, B0); PG8_MMA(0, 1, At, B1); PG8_BAR; PG8_SCHED;
            PG8_LDA(At, 1, 1); PG8_STAGE(PG8_SB(1, 0), b3, voffB); PG8_STAGE(PG8_SB(1, 1), b3 + hstep, voffB); PG8_STAGE(PG8_SA(1, 0), a3, voffA);
            PG8_WAIT_V(8); PG8_WAIT_L(0); PG8_BAR; PG8_MMA(1, 0, At, B0); PG8_MMA(1, 1, At, B1); PG8_BAR; PG8_SCHED;
            } else {
            PG8_LDB(B0, 0, 0); PG8_SCHED; PG8_LDA(At, 0, 0); PG8_STAGE(PG8_SA(1, 1), a1 + hstep, voffA);
            PG8_WAIT_L(8); PG8_BAR; PG8_WAIT_L(0); PG8_MMA(0, 0, At, B0); PG8_BAR; PG8_SCHED;
            PG8_LDB(B1, 0, 1); PG8_STAGE(PG8_SB(0, 0), b2, voffB);
            PG8_BAR; PG8_WAIT_L(0); PG8_MMA(0, 1, At, B1); PG8_BAR;
            PG8_LDA(At, 0, 1); PG8_STAGE(PG8_SA(0, 0), a2, voffA);
            PG8_BAR; PG8_WAIT_L(0); PG8_MMA(1, 0, At, B0); PG8_BAR; PG8_SCHED;
            PG8_STAGE(PG8_SB(0, 1), b2 + hstep, voffB);
            PG8_WAIT_V(6); PG8_BAR; PG8_MMA(1, 1, At, B1); PG8_BAR;
            PG8_LDB(B0, 1, 0); PG8_SCHED; PG8_LDA(At, 1, 0); PG8_STAGE(PG8_SA(0, 1), a2 + hstep, voffA);
            PG8_WAIT_L(8); PG8_BAR; PG8_WAIT_L(0); PG8_MMA(0, 0, At, B0); PG8_BAR; PG8_SCHED;
            PG8_LDB(B1, 1, 1); PG8_STAGE(PG8_SB(1, 0), b3, voffB);
            PG8_BAR; PG8_WAIT_L(0); PG8_MMA(0, 1, At, B1); PG8_BAR;
            PG8_LDA(At, 1, 1); PG8_STAGE(PG8_SA(1, 0), a3, voffA);
            PG8_BAR; PG8_WAIT_L(0); PG8_MMA(1, 0, At, B0); PG8_BAR; PG8_SCHED;
            PG8_STAGE(PG8_SB(1, 1), b3 + hstep, voffB);
            PG8_WAIT_V(6); PG8_BAR; PG8_MMA(1, 1, At, B1); PG8_BAR;
            }
        }
        if constexpr (ALIGN_EPI) { if (wr == 0) PG8_BAR; }
        if constexpr (!Epi::AFTER_DRAIN) { E(acc, cur, wr, wc, fr, fq); S.done(cur); }
        if (!has_next) break;
#pragma unroll
        for (int a = 0; a < 2; ++a)
#pragma unroll
            for (int b = 0; b < 2; ++b)
#pragma unroll
                for (int m = 0; m < 4; ++m)
#pragma unroll
                    for (int n = 0; n < 2; ++n) acc[a][b][m][n] = (f32x4){0.f, 0.f, 0.f, 0.f};
        cur = nxt; cA = nA; cB = nB; ++ui;
        if constexpr (ALIGN_EPI) { if (wr == 1) PG8_BAR; }
    }
    PG8_WAIT_V(0);
    if constexpr (!ALIGN_EPI) { if (wr == 0) PG8_BAR; }
    PG8_BAR;
    if constexpr (Epi::AFTER_DRAIN) { E.fused(acc, cur, wr, wc, fr, fq, lds, wid, lane); S.done(cur); }
#undef PG8_SA
#undef PG8_SB
#undef PG8_STAGE
#undef PG8_LDA
#undef PG8_LDB
#undef PG8_MMA
#undef PG8_WAIT_V
#undef PG8_WAIT_L
#undef PG8_BAR
#undef PG8_SCHED
}
}
namespace attn2 {
typedef short bf16x8 __attribute__((ext_vector_type(8)));
typedef short s16x4 __attribute__((ext_vector_type(4)));
typedef float f32x16 __attribute__((ext_vector_type(16)));
typedef float f32x4 __attribute__((ext_vector_type(4)));
typedef unsigned u32x4 __attribute__((ext_vector_type(4)));
typedef unsigned short bf16;
constexpr int LD = 1024, NW = 8, QBLK = 32, KVBLK = 64, QB = NW * QBLK, SEQ = 2048;
constexpr int SHM_V = KVBLK * 128 * 2, SHM_K = KVBLK * 64 * 2;
constexpr int OFF_K = 2 * SHM_V, OFF_WS = OFF_K + 2 * SHM_K, OFF_OST = OFF_WS + NW * 64 * 4, LDS_BYTES = OFF_OST + NW * 8192;
constexpr float THR = 8.f;
#define KSWZ(row, colB) ((row) * 128 + ((colB) ^ (((row) & 7) << 4)))
#define SBAR() __builtin_amdgcn_sched_barrier(0)
#ifdef ATTN_SGB
#define SGB_QK() do { __builtin_amdgcn_sched_group_barrier(0x100, 4, 0); _Pragma("unroll") for (int i_ = 0; i_ < 8; ++i_) { __builtin_amdgcn_sched_group_barrier(0x008, 1, 0); __builtin_amdgcn_sched_group_barrier(0x100, 1, 0); __builtin_amdgcn_sched_group_barrier(0x002, ATTN_SGB, 0); } } while (0)
#else
#define SGB_QK() do {} while (0)
#endif
__device__ __forceinline__ int v_st(int k, int c) { const int kk = (k & ~0xC) | ((k & 4) << 1) | ((k & 8) >> 1); return ((kk >> 3) * 4 + (c >> 5)) * 512 + ((kk & 7) * 32 + (c & 31)) * 2; }
__device__ __forceinline__ int v_rd_base(int lane) { return ((lane & 3) << 3) | (((lane >> 2) & 3) << 6) | (((lane >> 4) & 1) << 5) | (((lane >> 5) & 1) << 8); }
constexpr int v_rd_off(int d0, int ks, int half) { return d0 * 512 + ks * 4096 + half * 2048; }
__device__ __forceinline__ int crow(int r, int hi) { return (r & 3) + 8 * (r >> 2) + 4 * hi; }
__device__ __forceinline__ unsigned cvtpk(float lo, float hi) { return pg8::cvt_pk_bf16(lo, hi); }
__device__ __forceinline__ void mask_tile(f32x16& p0, f32x16& p1, int dq) {
    const float NEG = -__builtin_inff();
#pragma unroll
    for (int r = 0; r < 16; ++r) { const int c = (r & 3) + 8 * (r >> 2); if (dq - c < 0) p0[r] = NEG; if (dq - c - 32 < 0) p1[r] = NEG; }
}
__device__ __forceinline__ void partialSM(f32x16& p0, f32x16& p1, float& m_reg, float& mn, float& alpha) {
    float pmax = p0[0];
#pragma unroll
    for (int r = 1; r < 16; ++r) pmax = fmaxf(pmax, p0[r]);
#pragma unroll
    for (int r = 0; r < 16; ++r) pmax = fmaxf(pmax, p1[r]);
    { auto rr = __builtin_amdgcn_permlane32_swap(__float_as_uint(pmax), __float_as_uint(pmax), false, false); pmax = fmaxf(__uint_as_float(rr[0]), __uint_as_float(rr[1])); }
    if (__builtin_expect(__all((pmax - m_reg) <= THR), 1)) { mn = m_reg; alpha = 1.f; }
    else { mn = fmaxf(m_reg, pmax); alpha = __builtin_amdgcn_exp2f(m_reg - mn); m_reg = mn; }
#pragma unroll
    for (int r = 0; r < 16; ++r) { p0[r] -= mn; p1[r] -= mn; }
#pragma unroll
    for (int r = 0; r < 16; ++r) p0[r] = __builtin_amdgcn_exp2f(p0[r]);
}
__device__ __forceinline__ void finishSM(f32x16& p0, f32x16& p1, float alpha, float& l_reg, bf16x8& pa0, bf16x8& pa1, bf16x8& pa2, bf16x8& pa3) {
#pragma unroll
    for (int r = 0; r < 16; ++r) p1[r] = __builtin_amdgcn_exp2f(p1[r]);
    typedef float f32x2_ __attribute__((ext_vector_type(2)));
    f32x2_ ps2 = {0.f, 0.f};
#pragma unroll
    for (int r = 0; r < 16; r += 2) { ps2 += (f32x2_){p0[r], p0[r + 1]}; ps2 += (f32x2_){p1[r], p1[r + 1]}; }
    float ps = ps2.x + ps2.y;
    { auto rr = __builtin_amdgcn_permlane32_swap(__float_as_uint(ps), __float_as_uint(ps), false, false); ps = __uint_as_float(rr[0]) + __uint_as_float(rr[1]); }
    l_reg = l_reg * alpha + ps;
#define PK4(P, B_, OUT) do { unsigned a0 = cvtpk(P[B_+0], P[B_+1]), a1 = cvtpk(P[B_+2], P[B_+3]);                          \
        unsigned b0 = cvtpk(P[B_+4], P[B_+5]), b1 = cvtpk(P[B_+6], P[B_+7]);                                             \
        auto r0 = __builtin_amdgcn_permlane32_swap(a0, b0, false, false); auto r1 = __builtin_amdgcn_permlane32_swap(a1, b1, false, false); \
        u32x4 w = {r0[0], r1[0], r0[1], r1[1]}; OUT = __builtin_bit_cast(bf16x8, w); } while (0)
    PK4(p0, 0, pa0); PK4(p0, 8, pa1); PK4(p1, 0, pa2); PK4(p1, 8, pa3);
#undef PK4
}
template <int KB>
__device__ __forceinline__ void qkt(f32x16& p0, f32x16& p1, const char* K_lds, int r32, int hi, const bf16x8* qr, bool act) {
#ifdef ATTN_WSKIP
    if (!act) { const float NEG = -__builtin_inff();
#pragma unroll
        for (int r = 0; r < 16; ++r) { p0[r] = NEG; p1[r] = NEG; } return; }
#endif
    p0 = f32x16{}; p1 = f32x16{};
#pragma unroll
    for (int d0 = 0; d0 < 4; ++d0) { const char* a = K_lds + KB * SHM_K + KSWZ(r32, (d0 * 16 + hi * 8) * 2);
        const bf16x8 b0 = *reinterpret_cast<const bf16x8*>(a);
        const bf16x8 b1 = *reinterpret_cast<const bf16x8*>(a + 32 * 128);
        p0 = __builtin_amdgcn_mfma_f32_32x32x16_bf16(b0, qr[d0], p0, 0, 0, 0);
        p1 = __builtin_amdgcn_mfma_f32_32x32x16_bf16(b1, qr[d0], p1, 0, 0, 0); }
}
template <int VB>
__device__ __forceinline__ void pv_tile(f32x16* o, int vb0, bf16x8 pa0, bf16x8 pa1, bf16x8 pa2, bf16x8 pa3, bool act) {
#ifdef ATTN_WSKIP
    if (!act) return;
#endif
#define TRRD(dst, off) asm volatile("ds_read_b64_tr_b16 %0, %1 offset:%2" : "=&v"(dst) : "v"(vb0), "i"(off) : "memory")
#define PV_D0(d0) do { s16x4 l0, l1, l2, l3, h0, h1, h2, h3; constexpr int b_ = VB * SHM_V + v_rd_off(d0, 0, 0); \
        TRRD(l0, b_); TRRD(h0, b_ + 2048); TRRD(l1, b_ + 4096); TRRD(h1, b_ + 6144); TRRD(l2, b_ + 8192); TRRD(h2, b_ + 10240); TRRD(l3, b_ + 12288); TRRD(h3, b_ + 14336); \
        asm volatile("s_waitcnt lgkmcnt(0)" ::: "memory"); SBAR();   \
        o[d0] = __builtin_amdgcn_mfma_f32_32x32x16_bf16(pa0, (bf16x8){l0[0], l0[1], l0[2], l0[3], h0[0], h0[1], h0[2], h0[3]}, o[d0], 0, 0, 0);   \
        o[d0] = __builtin_amdgcn_mfma_f32_32x32x16_bf16(pa1, (bf16x8){l1[0], l1[1], l1[2], l1[3], h1[0], h1[1], h1[2], h1[3]}, o[d0], 0, 0, 0);   \
        o[d0] = __builtin_amdgcn_mfma_f32_32x32x16_bf16(pa2, (bf16x8){l2[0], l2[1], l2[2], l2[3], h2[0], h2[1], h2[2], h2[3]}, o[d0], 0, 0, 0);   \
        o[d0] = __builtin_amdgcn_mfma_f32_32x32x16_bf16(pa3, (bf16x8){l3[0], l3[1], l3[2], l3[3], h3[0], h3[1], h3[2], h3[3]}, o[d0], 0, 0, 0); } while (0)
    PV_D0(0); PV_D0(1); PV_D0(2); PV_D0(3);
#undef PV_D0
#undef TRRD
}
#ifndef ATTN_NO_FUSE
template <int VB>
__device__ __forceinline__ void pv_softmax(f32x16* o, int vb0, bf16x8 pa0, bf16x8 pa1, bf16x8 pa2, bf16x8 pa3, f32x16& p0, f32x16& p1, float& m_reg, float& mn, float& alpha) {
#define TRRD(dst, off) asm volatile("ds_read_b64_tr_b16 %0, %1 offset:%2" : "=&v"(dst) : "v"(vb0), "i"(off) : "memory")
#define RD8(F, ks) do { constexpr int b_ = VB * SHM_V + (ks) * 4096; \
        TRRD(F##00, b_); TRRD(F##01, b_ + 2048); TRRD(F##10, b_ + 512); TRRD(F##11, b_ + 512 + 2048); TRRD(F##20, b_ + 1024); TRRD(F##21, b_ + 1024 + 2048); TRRD(F##30, b_ + 1536); TRRD(F##31, b_ + 1536 + 2048); } while (0)
#define FR(L_, H_) (bf16x8){L_[0], L_[1], L_[2], L_[3], H_[0], H_[1], H_[2], H_[3]}
#define LGK(n) asm volatile("s_waitcnt lgkmcnt(" #n ")" ::: "memory")
#define MM(d0, PA, L_, H_) o[d0] = __builtin_amdgcn_mfma_f32_32x32x16_bf16(PA, FR(L_, H_), o[d0], 0, 0, 0)
#define MX4(P, b) fmaxf(fmaxf(fmaxf(P[b], P[(b) + 1]), P[(b) + 2]), P[(b) + 3])
#define SE4(P, b) do { typedef float f32x2_ __attribute__((ext_vector_type(2))); const f32x2_ m2_ = {mn, mn}; const f32x2_ d0_ = (f32x2_){P[b], P[(b) + 1]} - m2_, d1_ = (f32x2_){P[(b) + 2], P[(b) + 3]} - m2_; P[b] = __builtin_amdgcn_exp2f(d0_.x); P[(b) + 1] = __builtin_amdgcn_exp2f(d0_.y); P[(b) + 2] = __builtin_amdgcn_exp2f(d1_.x); P[(b) + 3] = __builtin_amdgcn_exp2f(d1_.y); } while (0)
#define SB8(P, b) do { typedef float f32x2_ __attribute__((ext_vector_type(2))); const f32x2_ m2_ = {mn, mn}; _Pragma("unroll") for (int r_ = 0; r_ < 8; r_ += 2) { const f32x2_ d_ = (f32x2_){P[(b) + r_], P[(b) + r_ + 1]} - m2_; P[(b) + r_] = d_.x; P[(b) + r_ + 1] = d_.y; } } while (0)
    s16x4 A00, A01, A10, A11, A20, A21, A30, A31, B00, B01, B10, B11, B20, B21, B30, B31;
    float t0, t1, t2, t3, t4, t5, t6, t7;
#define PINV(x) asm volatile("" : "+v"(x))
    RD8(A, 0); RD8(B, 1); LGK(8); SBAR();
    MM(0, pa0, A00, A01); t0 = MX4(p0, 0);  PINV(t0); SBAR();
    MM(1, pa0, A10, A11); t1 = MX4(p0, 4);  PINV(t1); SBAR();
    MM(2, pa0, A20, A21); t2 = MX4(p0, 8);  PINV(t2); SBAR();
    MM(3, pa0, A30, A31); t3 = MX4(p0, 12); PINV(t3); SBAR();
    RD8(A, 2); LGK(8); SBAR();
    MM(0, pa1, B00, B01); t4 = MX4(p1, 0);  PINV(t4); SBAR();
    MM(1, pa1, B10, B11); t5 = MX4(p1, 4);  PINV(t5); SBAR();
    MM(2, pa1, B20, B21); t6 = MX4(p1, 8);  PINV(t6); SBAR();
    MM(3, pa1, B30, B31); t7 = MX4(p1, 12); PINV(t7); SBAR();
    RD8(B, 3); LGK(8); SBAR();
    MM(0, pa2, A00, A01);
    float pmax = fmaxf(fmaxf(fmaxf(fmaxf(fmaxf(fmaxf(fmaxf(t0, t1), t2), t3), t4), t5), t6), t7);
    { auto rr = __builtin_amdgcn_permlane32_swap(__float_as_uint(pmax), __float_as_uint(pmax), false, false); pmax = fmaxf(__uint_as_float(rr[0]), __uint_as_float(rr[1])); }
    PINV(pmax); SBAR();
    MM(1, pa2, A10, A11);
    { const bool keep = __all((pmax - m_reg) <= THR); mn = keep ? m_reg : fmaxf(m_reg, pmax); alpha = __builtin_amdgcn_exp2f(m_reg - mn); m_reg = mn; }
    PINV(mn); PINV(alpha); SBAR();
    MM(2, pa2, A20, A21); SE4(p0, 0);  PINV(p0); SBAR();
    MM(3, pa2, A30, A31); SE4(p0, 4);  PINV(p0); SBAR();
    LGK(0); SBAR();
    MM(0, pa3, B00, B01); SE4(p0, 8);  PINV(p0); SBAR();
    MM(1, pa3, B10, B11); SE4(p0, 12); PINV(p0); SBAR();
    MM(2, pa3, B20, B21); SB8(p1, 0);  PINV(p1); SBAR();
    MM(3, pa3, B30, B31); SB8(p1, 8);  PINV(p1); SBAR();
#undef PINV
#undef TRRD
#undef RD8
#undef FR
#undef LGK
#undef MM
#undef MX4
#undef SE4
#undef SB8
}
#endif
struct BlockRef { const bf16* Q; const bf16* K; const bf16* V; bf16* O; int P0; int mode; };
struct Seam { bf16x8 qr[4]; bf16x8 st_v0, st_v1, st_k0; };
struct Stage2 { bf16x8 sv0, sv1, sk0; };
#define VMW() asm volatile("s_waitcnt vmcnt(0)" ::: "memory")
#define VMWN(n) asm volatile("s_waitcnt vmcnt(%0)" :: "i"(n) : "memory")
#define SLOAD_H(Kp, Vp, k0) do { S.st_v0 = *(const bf16x8*)((Vp) + (size_t)((k0) + sr) * LD + sc); S.st_v1 = *(const bf16x8*)((Vp) + (size_t)((k0) + 32 + sr) * LD + sc); \
                                 S.st_k0 = *(const bf16x8*)((Kp) + (size_t)((k0) + kr) * LD + kc); } while (0)
#define SWRITE_HK(bf) do { *(bf16x8*)(K_lds + (bf) * SHM_K + kws) = S.st_k0; } while (0)
#define SWRITE_HV(bf) do { *(bf16x8*)(V_lds + (bf) * SHM_V + vst0) = S.st_v0; *(bf16x8*)(V_lds + (bf) * SHM_V + vst1) = S.st_v1; } while (0)
#define SWRITE_H(bf) do { SWRITE_HV(bf); SWRITE_HK(bf); } while (0)
#define SLOAD_B(Kp, Vp, k0) do { T2.sv0 = *(const bf16x8*)((Vp) + (size_t)((k0) + sr) * LD + sc); T2.sv1 = *(const bf16x8*)((Vp) + (size_t)((k0) + 32 + sr) * LD + sc); \
                                 T2.sk0 = *(const bf16x8*)((Kp) + (size_t)((k0) + kr) * LD + kc); } while (0)
#define SWRITE_B(bf) do { *(bf16x8*)(V_lds + (bf) * SHM_V + vst0) = T2.sv0; *(bf16x8*)(V_lds + (bf) * SHM_V + vst1) = T2.sv1; *(bf16x8*)(K_lds + (bf) * SHM_K + kws) = T2.sk0; } while (0)
__device__ __forceinline__ void attn_prime(const BlockRef& cur, char* lds, Seam& S) {
    int tid_ = threadIdx.x; asm volatile("" : "+v"(tid_)); const int tid = tid_, wid = __builtin_amdgcn_readfirstlane(tid >> 6), lane = tid & 63, r32 = lane & 31, hi = lane >> 5;
    const int sr = tid >> 4, sc = (tid & 15) * 8, kr = tid >> 3, kc = (tid & 7) * 8, kws = KSWZ(kr, kc * 2); char* K_lds = lds + OFF_K;
#pragma unroll
    for (int d0 = 0; d0 < 4; ++d0) S.qr[d0] = *(const bf16x8*)(cur.Q + (size_t)(wid * QBLK + r32) * LD + d0 * 16 + hi * 8);
    SLOAD_H(cur.K, cur.V, 0); VMW(); SWRITE_HK(0);
    __syncthreads();
}
template <int ABL>
__device__ __forceinline__ void attn_block(const BlockRef& cur, const BlockRef& nxt, char* lds, Seam& S, float lam, const float* subg) {
    int tid_ = threadIdx.x; asm volatile("" : "+v"(tid_)); const int tid = tid_, wid = __builtin_amdgcn_readfirstlane(tid >> 6), lane = tid & 63, r32 = lane & 31, hi = lane >> 5;
    const int NT = cur.P0 / KVBLK + QB / KVBLK;
    const int qlo = cur.P0 + wid * QBLK, qm = qlo + r32 - 4 * hi;
    char* V_lds = lds; char* K_lds = lds + OFF_K;
    float* ws = (float*)(lds + OFF_WS) + wid * 64; float* li_l = ws, * al_l = ws + 32;
    float m_reg = -1e30f, l_reg = 0; f32x16 o[4] = {};
    const int sr = tid >> 4, sc = (tid & 15) * 8, vst0 = v_st(sr, sc), vst1 = v_st(32 + sr, sc), kr = tid >> 3, kc = (tid & 7) * 8, kws = KSWZ(kr, kc * 2);
    const int vb0 = (int)(uintptr_t)V_lds + v_rd_base(lane);
    const bf16* Kh = cur.K; const bf16* Vh = cur.V;
#define RESC(a) do { if (__any((a) < 1.f)) { if (hi == 0) al_l[r32] = (a); asm volatile("s_waitcnt lgkmcnt(0)" ::: "memory");              \
                     _Pragma("unroll") for (int d_ = 0; d_ < 4; ++d_) _Pragma("unroll") for (int r = 0; r < 16; ++r) o[d_][r] *= al_l[crow(r, hi)]; } } while (0)
#define KBASE(t) ((t) * KVBLK)
#define ACT(t) (KBASE(t) <= qlo + QBLK - 1)
#define MASKT(P0_, P1_, t) do { const int kb_ = KBASE(t); if (kb_ + KVBLK - 1 > qlo) mask_tile(P0_, P1_, qm - kb_); } while (0)
#ifndef ATTN_NO_FUSE
#define PVSM(VB, PX0, PX1, mnX, alX, t) do { MASKT(PX0, PX1, (t)); SBAR(); pv_softmax<VB>(o, vb0, pa0, pa1, pa2, pa3, PX0, PX1, m_reg, mnX, alX); } while (0)
#else
#define PVSM(VB, PX0, PX1, mnX, alX, t) do { pv_tile<VB>(o, vb0, pa0, pa1, pa2, pa3, ACT((t) - 1)); MASKT(PX0, PX1, (t)); partialSM(PX0, PX1, m_reg, mnX, alX); } while (0)
#endif
#define SEAM_K0() do { VMWN(4); SWRITE_HK(0); SBAR(); } while (0)
    f32x16 pA0, pA1, pB0, pB1; float mnA, mnB, alA, alB; bf16x8 pa0, pa1, pa2, pa3;
    Stage2 T2;
    SWRITE_HV(0); SBAR();
    SLOAD_H(Kh, Vh, KBASE(1)); SBAR(); SLOAD_B(Kh, Vh, KBASE(2)); SBAR();
    qkt<0>(pA0, pA1, K_lds, r32, hi, S.qr, true);
    MASKT(pA0, pA1, 0); partialSM(pA0, pA1, m_reg, mnA, alA);
    VMWN(3); SWRITE_H(1);
    __syncthreads();
#define BARX() do { if (!(ABL & 1)) __syncthreads(); } while (0)
#define HALF_STEP(PX0, PX1, mnX, alX, PY0, PY1, alY, t, KB, VB, SB, LOADM, WRITEM) do {                                      \
        SBAR(); if (!(ABL & 2)) qkt<KB>(PX0, PX1, K_lds, r32, hi, S.qr, ACT(t));                                             \
        finishSM(PY0, PY1, alY, l_reg, pa0, pa1, pa2, pa3); SGB_QK(); SBAR();                                                           \
        if ((t) + 2 < NT) { LOADM(Kh, Vh, KBASE((t) + 2)); SBAR(); }                                               \
        if (!(ABL & 4)) PVSM(VB, PX0, PX1, mnX, alX, t);                                        \
        BARX();                                                                                                      \
        if ((t) + 1 < NT) { if ((t) + 2 < NT) { VMWN(3); } else { VMW(); } WRITEM(SB); }        \
        RESC(alX); BARX(); } while (0)
    for (int t = 1; t + 1 < NT; t += 2) {
        HALF_STEP(pB0, pB1, mnB, alB, pA0, pA1, alA, t, 1, 0, 0, SLOAD_H, SWRITE_B);
        HALF_STEP(pA0, pA1, mnA, alA, pB0, pB1, alB, t + 1, 0, 1, 1, SLOAD_B, SWRITE_H);
    }
    SBAR(); qkt<1>(pB0, pB1, K_lds, r32, hi, S.qr, ACT(NT - 1)); SBAR();
    SLOAD_H(nxt.K, nxt.V, 0); SBAR();
#pragma unroll
    for (int d0 = 0; d0 < 4; ++d0) S.qr[d0] = *(const bf16x8*)(nxt.Q + (size_t)(wid * QBLK + r32) * LD + d0 * 16 + hi * 8);
    SBAR();
    finishSM(pA0, pA1, alA, l_reg, pa0, pa1, pa2, pa3); SBAR();
    PVSM(0, pB0, pB1, mnB, alB, NT - 1); __syncthreads(); RESC(alB);
    finishSM(pB0, pB1, alB, l_reg, pa0, pa1, pa2, pa3); SBAR(); pv_tile<1>(o, vb0, pa0, pa1, pa2, pa3, ACT(NT - 1));
    SBAR(); SEAM_K0();
    if (hi == 0) li_l[r32] = l_reg; asm volatile("s_waitcnt lgkmcnt(0)" ::: "memory");
    float rli[16];
#pragma unroll
    for (int r = 0; r < 16; ++r) rli[r] = __builtin_amdgcn_rcpf(li_l[crow(r, hi)]);
    bf16* stg = (bf16*)(lds + OFF_OST) + wid * 4096;
#pragma unroll
    for (int r = 0; r < 16; ++r) { const int orow = crow(r, hi);
#pragma unroll
        for (int d0 = 0; d0 < 4; ++d0) { const float v = o[d0][r] * rli[r]; stg[orow * 128 + d0 * 32 + r32] = (bf16)(cvtpk(v, v) & 0xffffu); } }
    asm volatile("s_waitcnt lgkmcnt(0)" ::: "memory");
    bf16* Ow = cur.O + (size_t)(wid * QBLK) * LD;
    if (cur.mode == 0) {
#pragma unroll
        for (int i = 0; i < 8; ++i) { const int row = i * 4 + (lane >> 4), ch = lane & 15; *(u32x4*)(Ow + (size_t)row * LD + ch * 8) = *(const u32x4*)(stg + row * 128 + ch * 8); }
    } else {
        f32x4 ga = *(const f32x4*)(subg + (lane & 15) * 8), gb = *(const f32x4*)(subg + (lane & 15) * 8 + 4);
#pragma unroll
        for (int i = 0; i < 8; ++i) { const int row = i * 4 + (lane >> 4), ch = lane & 15; bf16* p = Ow + (size_t)row * LD + ch * 8;
            const u32x4 v = *(const u32x4*)(stg + row * 128 + ch * 8), pv = *(const u32x4*)p; float d[8]; float ss = 0.f;
#pragma unroll
            for (int j = 0; j < 4; ++j) { d[2 * j] = __uint_as_float(pv[j] << 16) - lam * __uint_as_float(v[j] << 16); d[2 * j + 1] = __uint_as_float(pv[j] & 0xffff0000u) - lam * __uint_as_float(v[j] & 0xffff0000u); }
#pragma unroll
            for (int j = 0; j < 8; ++j) ss += d[j] * d[j];
            ss += pg8::swz_xor<1>(ss); ss += pg8::swz_xor<2>(ss); ss += pg8::swz_xor<4>(ss); ss += pg8::swz_xor<8>(ss);
            const float rs = rsqrtf(ss * (1.f / 128.f) + 1e-6f) * 0.8f;
            u32x4 w; w[0] = cvtpk(d[0] * rs * ga[0], d[1] * rs * ga[1]); w[1] = cvtpk(d[2] * rs * ga[2], d[3] * rs * ga[3]); w[2] = cvtpk(d[4] * rs * gb[0], d[5] * rs * gb[1]); w[3] = cvtpk(d[6] * rs * gb[2], d[7] * rs * gb[3]);
            *(u32x4*)p = w; }
    }
    __syncthreads();
#undef RESC
#undef KBASE
#undef ACT
#undef MASKT
#undef SEAM_K0
#undef PVSM
#undef HALF_STEP
#undef BARX
}
#undef VMW
#undef VMWN
#undef SLOAD_H
#undef SWRITE_HK
#undef SWRITE_HV
#undef SWRITE_H
#undef SLOAD_B
#undef SWRITE_B
__device__ __forceinline__ BlockRef block_ref(int n, int vcu, int G, const bf16* Q, const bf16* K, const bf16* V, bf16* O) {
    const int w = vcu + (n >> 2) * G, i = (n >> 1) & 1, c = n & 1, bh = w >> 2, s = w & 3, b = bh >> 3, h = bh & 7, qb = i == 0 ? s : 7 - s;
    const size_t r0 = (size_t)b * SEQ; BlockRef r;
    r.Q = Q + (r0 + (size_t)qb * QB) * LD + (2 * h + c) * 64; r.K = K + r0 * LD + (2 * h + c) * 64; r.V = V + r0 * LD + h * 128; r.O = O + (r0 + (size_t)qb * QB) * LD + h * 128; r.P0 = qb * QB; r.mode = c;
    return r;
}
template <int ABL>
__device__ __forceinline__ void attn_phase(char* lds, const bf16* Q, const bf16* K, const bf16* V, bf16* O, int vcu, int G, float lam, const float* subg) {
    const int nblk = ((1024 - vcu + G - 1) / G) * 4;
    if (nblk <= 0) return;
    BlockRef cur = block_ref(0, vcu, G, Q, K, V, O); Seam S;
#ifdef ATTN_PRIO
    if ((threadIdx.x >> 8) != 0) __builtin_amdgcn_s_setprio(1);
#endif
    attn_prime(cur, lds, S);
    for (int n = 0; n < nblk; ++n) {
        const BlockRef nxt = (n + 1 < nblk) ? block_ref(n + 1, vcu, G, Q, K, V, O) : cur;
        attn_block<ABL>(cur, nxt, lds, S, lam, subg);
        cur = nxt;
    }
#ifdef ATTN_PRIO
    __builtin_amdgcn_s_setprio(0);
#endif
}
#undef KSWZ
#undef SBAR
}

constexpr int NWAVES = 8;
constexpr int BATCH = 32, SEQ = 2048, D = 1024, M = BATCH * SEQ, DIN = 8192, DFF = 2816, NGU = 2 * DFF, NMOD = 6 * D;
constexpr size_t MiB = 1u << 20;
constexpr size_t WS_S0 = 0, WS_S1 = 128 * MiB, WS_S2 = 256 * MiB, WS_S3 = 384 * MiB, WS_S4 = 512 * MiB, WS_S5 = 640 * MiB;
constexpr size_t WS_WIN = 768 * MiB, WS_WA = WS_WIN + 16 * MiB, WS_WB = WS_WA + 2 * MiB, WS_WO = WS_WB + 2 * MiB, WS_WGU = WS_WO + 2 * MiB, WS_WDN = WS_WGU + 11 * MiB, WS_MOD = WS_WDN + 6 * MiB, WS_CTL = WS_MOD + 1 * MiB, WS_END = WS_CTL + 1 * MiB;
constexpr int RING_BYTES = 131072, LDS_BYTES = 147456;
#define LAS __attribute__((address_space(3)))
typedef unsigned short bf16;
typedef unsigned v4u __attribute__((ext_vector_type(4)));
typedef unsigned v2u __attribute__((ext_vector_type(2)));
typedef float f32x4 __attribute__((ext_vector_type(4)));
__device__ __forceinline__ unsigned pk2(float lo, float hi) { return pg8::cvt_pk_bf16(lo, hi); }
__device__ __forceinline__ float wave_sum(float v) { return pg8::wave_sum64(v); }
__device__ __forceinline__ void transpose_item(const float* W, int K, int N, int src_col0, bf16* WT, int dst_row0, int k0, LAS float* scr, int lane) {
    float wv_[32];
#pragma unroll
    for (int i = 0; i < 32; ++i) { const int kk = 2 * i + (lane >> 5); wv_[i] = W[(size_t)(k0 + kk) * N + src_col0 + (lane & 31)]; }
#pragma unroll
    for (int i = 0; i < 32; ++i) { const int kk = 2 * i + (lane >> 5); scr[kk * 33 + (lane & 31)] = wv_[i]; }
    asm volatile("s_waitcnt lgkmcnt(0)" ::: "memory");
    const int c = lane & 7;
#pragma unroll
    for (int j = 0; j < 4; ++j) { const int n = (lane >> 3) + 8 * j; const LAS float* s = scr + (8 * c) * 33 + n;
        v4u o; o.x = pk2(s[0 * 33], s[1 * 33]); o.y = pk2(s[2 * 33], s[3 * 33]); o.z = pk2(s[4 * 33], s[5 * 33]); o.w = pk2(s[6 * 33], s[7 * 33]);
        *(v4u*)(WT + (size_t)(dst_row0 + n) * K + k0 + 8 * c) = o; }
    asm volatile("s_waitcnt lgkmcnt(0)" ::: "memory");
}
#ifdef FULL_LINE
__device__ __forceinline__ int grp64(int s) { return 64 * ((s & 127) >> 5) + 32 * (s >> 7); }
#else
__device__ __forceinline__ int grp64(int s) { return s; }
#endif
__device__ __forceinline__ int win_src(int n0) {
    if (n0 < 1024) return 3072 + (n0 & ~255) + grp64(n0 & 255);
    if (n0 < 3072) { const int p = (n0 - 1024) >> 8, s = n0 & 255; return s < 128 ? 4096 + 128 * p + s : 5120 + 128 * p + (s - 128); }
    if (n0 < 4096) { const int m = n0 - 3072; return 6144 + (m & ~255) + grp64(m & 255); }
    if (n0 < 6144) { const int m = n0 - 4096, pn = m >> 8, s = m & 255, bj = s >> 7, wc = (s & 127) >> 5; return pn * 256 + 64 * wc + 32 * bj; }
    if (n0 < 7168) { const int m = n0 - 6144; return 2048 + (m & ~255) + grp64(m & 255); }
    { const int m = n0 - 7168; return 7168 + (m & ~255) + grp64(m & 255); }
}
__device__ __forceinline__ int wgu_src(int n0) { const int p = n0 >> 8, s = n0 & 255; return s < 128 ? 128 * p + s : DFF + 128 * p + (s - 128); }

#ifndef P0_EARLY
#define P0_EARLY 3
#endif
#ifndef NORM_RB
#define NORM_RB 4
#endif
__device__ __forceinline__ void norm_rows(const float* X, const float* g, const float* modsh, const float* modsc, bf16* H, int rb, int lane) {
    const size_t row0 = (size_t)rb * 32; const int b = (int)(row0 >> 11);
    f32x4 av[4], sv[4];
#pragma unroll
    for (int j = 0; j < 4; ++j) { const int idx = 4 * lane + 256 * j; const f32x4 gg = *(const f32x4*)(g + idx), sc = *(const f32x4*)(modsc + (size_t)b * NMOD + idx); av[j] = gg * (sc + 1.0f); sv[j] = *(const f32x4*)(modsh + (size_t)b * NMOD + idx); }
    for (int r0 = 0; r0 < 32; r0 += NORM_RB) {
        f32x4 v[NORM_RB][4];
#pragma unroll
        for (int rr = 0; rr < NORM_RB; ++rr) { const f32x4* xr = (const f32x4*)(X + (row0 + r0 + rr) * D) + lane;
#pragma unroll
            for (int j = 0; j < 4; ++j) v[rr][j] = xr[64 * j]; }
#pragma unroll
        for (int rr = 0; rr < NORM_RB; ++rr) { float s = 0.f;
#pragma unroll
            for (int j = 0; j < 4; ++j) s += (v[rr][j].x * v[rr][j].x + v[rr][j].y * v[rr][j].y) + (v[rr][j].z * v[rr][j].z + v[rr][j].w * v[rr][j].w);
            const float rstd = rsqrtf(wave_sum(s) * (1.f / D) + 1e-6f);
            v2u* o8 = (v2u*)(H + (row0 + r0 + rr) * D) + lane;
#pragma unroll
            for (int j = 0; j < 4; ++j) { const f32x4 y = v[rr][j] * rstd * av[j] + sv[j]; v2u w; w.x = pk2(y.x, y.y); w.y = pk2(y.z, y.w); o8[64 * j] = w; } }
    }
}

#define XB_TMO      128
#define XB_XCNT(j)  (256  + 64 * (j))
#define XB_XSUB(j)  (1280 + 64 * (j))
#define XB_XGEN(j)  (2304 + 64 * (j))
#define XB_TOP      3328
#define XB_TOPGEN   3392
#define XCD_BAR_WORDS 3456
#define XB_SPIN_CAP (1u << 18)

__device__ __forceinline__ unsigned xb_ld(unsigned* p)              { return __hip_atomic_load(p, __ATOMIC_RELAXED, __HIP_MEMORY_SCOPE_AGENT); }
__device__ __forceinline__ unsigned xb_add(unsigned* p, unsigned v) { return __hip_atomic_fetch_add(p, v, __ATOMIC_RELAXED, __HIP_MEMORY_SCOPE_AGENT); }
__device__ __forceinline__ unsigned xb_xcc_id() { return (unsigned)__builtin_amdgcn_s_getreg((3 << 11) | 20) & 0xFu; }
#define XB_SPIN(cond, bar) do { unsigned _sp = 0; while (cond) { __builtin_amdgcn_s_sleep(1); \
    if ((++_sp & 255u) == 0u) { if (xb_ld(&(bar)[XB_TMO])) break; if (_sp > XB_SPIN_CAP) { atomicAdd(&(bar)[XB_TMO], 1u); break; } } } } while (0)

struct XcdBarrier {
    unsigned* bar; unsigned x;
    volatile LAS unsigned* st;
};

__device__ __forceinline__ XcdBarrier xcd_barrier_post(unsigned* bar, volatile LAS unsigned* st) {
    XcdBarrier b; b.bar = bar; b.x = xb_xcc_id(); b.st = st;
    if (threadIdx.x == 0) (void)xb_add(&bar[XB_XCNT(b.x)], 1u);
    return b;
}
__device__ __forceinline__ void xcd_barrier_complete(unsigned* bar, unsigned x, unsigned& nloc, unsigned& nx) {
    const unsigned G = gridDim.x * gridDim.y * gridDim.z;
    unsigned sum, cnt, mine, sp = 0u;
    for (;;) {
        sum = 0u; cnt = 0u; mine = 0u;
#pragma unroll
        for (unsigned j = 0; j < 16; ++j) { const unsigned c = xb_ld(&bar[XB_XCNT(j)]); sum += c; cnt += (c > 0u) ? 1u : 0u; mine = (j == x) ? c : mine; }
        if (sum == G) break;
        __builtin_amdgcn_s_sleep(1);
        if ((++sp & 255u) == 0u) { if (xb_ld(&bar[XB_TMO])) break; if (sp > XB_SPIN_CAP) { atomicAdd(&bar[XB_TMO], 1u); break; } }
    }
    nloc = mine > 0u ? mine : 1u; nx = cnt > 0u ? cnt : 1u;
}

__device__ __forceinline__ void xcd_barrier(const XcdBarrier& b) {
    asm volatile("s_waitcnt vmcnt(0)" ::: "memory");
    __syncthreads();
    if (threadIdx.x == 0) {
        unsigned* bar = b.bar;
        __builtin_amdgcn_s_waitcnt(0);
        unsigned nloc = b.st[0], nx = b.st[1];
        if (nloc == 0u) { xcd_barrier_complete(bar, b.x, nloc, nx); b.st[0] = nloc; b.st[1] = nx; }
        const unsigned old = xb_add(&bar[XB_XSUB(b.x)], 1u);
        const unsigned gen = old / nloc;
        if (old + 1u == (gen + 1u) * nloc) {
            __builtin_amdgcn_fence(__ATOMIC_RELEASE, "agent");
            asm volatile("s_waitcnt vmcnt(0)" ::: "memory");
            const unsigned og = xb_add(&bar[XB_TOP], 1u);
            const unsigned tg = og / nx;
            if (og + 1u == (tg + 1u) * nx) xb_add(&bar[XB_TOPGEN], 1u);
            else XB_SPIN(xb_ld(&bar[XB_TOPGEN]) == tg, bar);
            __builtin_amdgcn_fence(__ATOMIC_ACQUIRE, "agent");
            xb_add(&bar[XB_XGEN(b.x)], 1u);
            asm volatile("s_waitcnt vmcnt(0)" ::: "memory");
        } else {
            XB_SPIN(xb_ld(&bar[XB_XGEN(b.x)]) == gen, bar);
            __builtin_amdgcn_fence(__ATOMIC_ACQUIRE, "agent");
            asm volatile("s_waitcnt vmcnt(0)" ::: "memory");
        }
    }
    __syncthreads();
}


__device__ __forceinline__ unsigned pk4_fp8(float a, float b, float c, float d) { unsigned w = 0u; w = (unsigned)__builtin_amdgcn_cvt_pk_fp8_f32(a, b, (int)w, false); w = (unsigned)__builtin_amdgcn_cvt_pk_fp8_f32(c, d, (int)w, true); return w; }
constexpr float WGU_FP8_SCALE = 32.f;
__device__ __forceinline__ void transpose_item8(const float* W, int K, int N, int src_col0, unsigned char* WT, int dst_row0, int k0, LAS float* scr, int lane, float scale) {
    float wv_[32];
#pragma unroll
    for (int i = 0; i < 32; ++i) { const int kk = 2 * i + (lane >> 5); wv_[i] = W[(size_t)(k0 + kk) * N + src_col0 + (lane & 31)]; }
#pragma unroll
    for (int i = 0; i < 32; ++i) { const int kk = 2 * i + (lane >> 5); scr[kk * 33 + (lane & 31)] = wv_[i]; }
    asm volatile("s_waitcnt lgkmcnt(0)" ::: "memory");
    const int n = lane >> 1, kh = (lane & 1) * 32; const LAS float* s = scr + kh * 33 + n;
    v4u o0, o1;
    o0.x = pk4_fp8(s[0 * 33] * scale, s[1 * 33] * scale, s[2 * 33] * scale, s[3 * 33] * scale);     o0.y = pk4_fp8(s[4 * 33] * scale, s[5 * 33] * scale, s[6 * 33] * scale, s[7 * 33] * scale);
    o0.z = pk4_fp8(s[8 * 33] * scale, s[9 * 33] * scale, s[10 * 33] * scale, s[11 * 33] * scale);   o0.w = pk4_fp8(s[12 * 33] * scale, s[13 * 33] * scale, s[14 * 33] * scale, s[15 * 33] * scale);
    o1.x = pk4_fp8(s[16 * 33] * scale, s[17 * 33] * scale, s[18 * 33] * scale, s[19 * 33] * scale); o1.y = pk4_fp8(s[20 * 33] * scale, s[21 * 33] * scale, s[22 * 33] * scale, s[23 * 33] * scale);
    o1.z = pk4_fp8(s[24 * 33] * scale, s[25 * 33] * scale, s[26 * 33] * scale, s[27 * 33] * scale); o1.w = pk4_fp8(s[28 * 33] * scale, s[29 * 33] * scale, s[30 * 33] * scale, s[31 * 33] * scale);
    v4u* dst = (v4u*)(WT + (size_t)(dst_row0 + n) * K + k0 + kh); dst[0] = o0; dst[1] = o1;
    asm volatile("s_waitcnt lgkmcnt(0)" ::: "memory");
}
__device__ __forceinline__ void norm_rows8(const float* X, const float* g, const float* modsh, const float* modsc, unsigned char* H8, int rb, int lane) {
    const size_t row0 = (size_t)rb * 32; const int b = (int)(row0 >> 11);
    f32x4 av[4], sv[4];
#pragma unroll
    for (int j = 0; j < 4; ++j) { const int idx = 4 * lane + 256 * j; const f32x4 gg = *(const f32x4*)(g + idx), sc = *(const f32x4*)(modsc + (size_t)b * NMOD + idx); av[j] = gg * (sc + 1.0f); sv[j] = *(const f32x4*)(modsh + (size_t)b * NMOD + idx); }
    for (int r0 = 0; r0 < 32; r0 += NORM_RB) {
        f32x4 v[NORM_RB][4];
#pragma unroll
        for (int rr = 0; rr < NORM_RB; ++rr) { const f32x4* xr = (const f32x4*)(X + (row0 + r0 + rr) * D) + lane;
#pragma unroll
            for (int j = 0; j < 4; ++j) v[rr][j] = xr[64 * j]; }
#pragma unroll
        for (int rr = 0; rr < NORM_RB; ++rr) { float s = 0.f;
#pragma unroll
            for (int j = 0; j < 4; ++j) s += (v[rr][j].x * v[rr][j].x + v[rr][j].y * v[rr][j].y) + (v[rr][j].z * v[rr][j].z + v[rr][j].w * v[rr][j].w);
            const float rstd = rsqrtf(wave_sum(s) * (1.f / D) + 1e-6f);
            unsigned* o4 = (unsigned*)(H8 + (row0 + r0 + rr) * D) + lane;
#pragma unroll
            for (int j = 0; j < 4; ++j) { const f32x4 y = v[rr][j] * rstd * av[j] + sv[j]; o4[64 * j] = pk4_fp8(y.x, y.y, y.z, y.w); } }
    }
}
#ifndef FP8_SP2
#define FP8_SP2 true
#endif
#ifndef GEMM_ALIGN
#define GEMM_ALIGN true
#endif
#ifndef GEMM_SP2
#define GEMM_SP2 true
#endif
struct Args { const float* in[20]; float* out; unsigned char* ws; };
__global__ void __launch_bounds__(NWAVES * 64, 2) fwd_megakernel(Args args) {
    extern __shared__ __attribute__((aligned(16))) unsigned char lds[];
    cg::grid_group grid = cg::this_grid();
    const int G = gridDim.x, bx = blockIdx.x, vcu = (G % 8 == 0) ? (bx % 8) * (G / 8) + bx / 8 : bx;
    const int NGW = G * NWAVES;
#define GRID_SYNC() do { xcd_barrier(xbar); asm volatile("" ::: "memory"); } while (0)
#define PHASE_IDS() int tid = threadIdx.x; asm volatile("" : "+v"(tid)); const int lane = tid & 63, wave = __builtin_amdgcn_readfirstlane(tid >> 6), gw = vcu * NWAVES + wave; (void)lane; (void)gw
    unsigned char* ws = args.ws;
    const float* x = args.in[0];
    bf16* S0 = (bf16*)(ws + WS_S0); bf16* S1 = (bf16*)(ws + WS_S1); bf16* S2 = (bf16*)(ws + WS_S2); bf16* S3 = (bf16*)(ws + WS_S3); bf16* S4 = (bf16*)(ws + WS_S4); bf16* S5 = (bf16*)(ws + WS_S5);
    bf16* WIN = (bf16*)(ws + WS_WIN); bf16* WA = (bf16*)(ws + WS_WA); bf16* WB = (bf16*)(ws + WS_WB); bf16* WO = (bf16*)(ws + WS_WO); bf16* WGU = (bf16*)(ws + WS_WGU); bf16* WDN = (bf16*)(ws + WS_WDN);
    float* mod = (float*)(ws + WS_MOD);
    float* X1 = (float*)(ws + WS_S1);
    LAS unsigned char* ldsl = (LAS unsigned char*)lds;
    volatile LAS unsigned* MISC = (volatile LAS unsigned*)(ldsl + RING_BYTES + 320);
    if (threadIdx.x < 32) MISC[threadIdx.x] = 0u;
    __syncthreads();
    XcdBarrier xbar = xcd_barrier_post((unsigned*)(ws + WS_CTL), MISC + 8);
    if (args.out == nullptr) grid.sync();

    if (bx < 96) {
        PHASE_IDS();
        LAS float* cact = (LAS float*)ldsl;
        const float* c = args.in[1];
        for (int i = tid; i < BATCH * D; i += NWAVES * 64) { const int b = i >> 10, k = i & 1023; const float cv = c[i]; cact[k * 32 + b] = cv / (1.f + __expf(-cv)); }
        __syncthreads();
        const float* wada = args.in[2]; const int col = bx * 64 + lane, k0 = wave * 128;
        float acc[32];
#pragma unroll
        for (int b = 0; b < 32; ++b) acc[b] = 0.f;
#pragma unroll 8
        for (int kk = 0; kk < 128; ++kk) { const float w = wada[(size_t)(k0 + kk) * NMOD + col]; const LAS f32x4* cp = (const LAS f32x4*)(cact + (k0 + kk) * 32);
#pragma unroll
            for (int j = 0; j < 8; ++j) { const f32x4 cv = cp[j]; acc[4 * j] += w * cv.x; acc[4 * j + 1] += w * cv.y; acc[4 * j + 2] += w * cv.z; acc[4 * j + 3] += w * cv.w; } }
        __syncthreads();
        LAS float* part = (LAS float*)ldsl;
#pragma unroll
        for (int b = 0; b < 32; ++b) part[(wave * 32 + b) * 64 + lane] = acc[b];
        __syncthreads();
        const float* bada = args.in[3];
        for (int o = tid; o < 2048; o += NWAVES * 64) { const int b = o >> 6, cl = o & 63; float s = 0.f;
#pragma unroll
            for (int w = 0; w < 8; ++w) s += part[(w * 32 + b) * 64 + cl];
            mod[(size_t)b * NMOD + bx * 64 + cl] = s + bada[bx * 64 + cl]; }
        __syncthreads();
    }
    {
        PHASE_IDS();
        LAS float* scr = (LAS float*)(ldsl + wave * 16384);
        constexpr int I_IN = 16 * 256, I_SQ = 16 * 32, I_GU = 16 * 176, I_DN = 44 * 32, NITEMS = I_IN + 3 * I_SQ + I_GU + I_DN;
        for (int it = gw; it < NITEMS; it += NGW) {
            int r = it;
            if (r < I_IN) { const int kb = r >> 8, nb = r & 255; transpose_item(args.in[5], D, DIN, win_src(32 * nb), WIN, 32 * nb, 64 * kb, scr, lane); continue; } r -= I_IN;
            if (r < I_SQ) { const int kb = r >> 5, nb = r & 31; transpose_item(args.in[14], D, D, 32 * nb, WA, 32 * nb, 64 * kb, scr, lane); continue; } r -= I_SQ;
            if (r < I_SQ) { const int kb = r >> 5, nb = r & 31; transpose_item(args.in[15], D, D, 32 * nb, WB, 32 * nb, 64 * kb, scr, lane); continue; } r -= I_SQ;
            if (r < I_SQ) { const int kb = r >> 5, nb = r & 31; transpose_item(args.in[16], D, D, 32 * nb, WO, 32 * nb, 64 * kb, scr, lane); continue; } r -= I_SQ;
#ifdef FFN_FP8
            if (r < I_GU) { const int kb = r / 176, nb = r % 176; transpose_item8(args.in[18], D, NGU, wgu_src(32 * nb), (unsigned char*)WGU, 32 * nb, 64 * kb, scr, lane, WGU_FP8_SCALE); continue; } r -= I_GU;
#else
            if (r < I_GU) { const int kb = r / 176, nb = r % 176; transpose_item(args.in[18], D, NGU, wgu_src(32 * nb), WGU, 32 * nb, 64 * kb, scr, lane); continue; } r -= I_GU;
#endif
            { const int kb = r >> 5, nb = r & 31; transpose_item(args.in[19], DFF, D, 32 * nb, WDN, 32 * nb, 64 * kb, scr, lane); }
        }
    }
    GRID_SYNC();
#ifdef EXP_BAR10
    GRID_SYNC(); GRID_SYNC(); GRID_SYNC(); GRID_SYNC(); GRID_SYNC(); GRID_SYNC(); GRID_SYNC(); GRID_SYNC(); GRID_SYNC(); GRID_SYNC();
#endif
    { PHASE_IDS(); for (int rb = gw; rb < M / 32; rb += NGW) norm_rows(x, args.in[4], mod, mod + D, S0, rb, lane); }
    GRID_SYNC();

    pg8::StaticOrder SO; pg8::Gemm g; pg8::EpiAll E{};
    LAS pg8::EpiP* EP = (LAS pg8::EpiP*)pg8::EPI_LDS_ADDR;
#define EPI_SET(stmts) do { if (threadIdx.x == 0) { stmts; } __syncthreads(); } while (0)
    g = pg8::Gemm{S0, WIN, M, 4096, D}; SO.init(M, 4096, G, bx);
    E.mode = 5; EPI_SET(EP->o3 = S1; EP->o4 = S2; EP->o5 = S3);
    pg8::gemm_phase<pg8::EpiAll, pg8::StaticOrder, GEMM_ALIGN, GEMM_SP2>(ldsl, g, SO, E);
    GRID_SYNC();
#ifdef EXP_KLOOP
    E.mode = EXP_KLOOP; EPI_SET(EP->o3 = S4; EP->o4 = S4; EP->o5 = S5); pg8::gemm_phase<pg8::EpiAll, pg8::StaticOrder, GEMM_ALIGN, GEMM_SP2>(ldsl, g, SO, E);
    GRID_SYNC();
#endif
    {
        PHASE_IDS();
        const float* cw = args.in[6]; const int NT = G * NWAVES * 64, gt = vcu * (NWAVES * 64) + tid;
        for (int it = gt; it < (M / 16) * 128; it += NT) {
            const int cgp = it & 127, rbk = it >> 7; const size_t t0 = (size_t)rbk * 16; const int c0 = cgp * 8;
            f32x4 w0a = *(const f32x4*)(cw + c0), w0b = *(const f32x4*)(cw + c0 + 4), w1a = *(const f32x4*)(cw + D + c0), w1b = *(const f32x4*)(cw + D + c0 + 4), w2a = *(const f32x4*)(cw + 2 * D + c0), w2b = *(const f32x4*)(cw + 2 * D + c0 + 4);
            f32x4 p2a = {0.f, 0.f, 0.f, 0.f}, p2b = p2a, p1a = p2a, p1b = p2a;
            if ((t0 & (SEQ - 1)) != 0) { pg8::unpack8(*(const v4u*)(S2 + (t0 - 2) * D + c0), p2a, p2b); pg8::unpack8(*(const v4u*)(S2 + (t0 - 1) * D + c0), p1a, p1b); }
#pragma unroll 8
            for (int r = 0; r < 16; ++r) { f32x4 ua, ub, ba, bb; pg8::unpack8(*(const v4u*)(S2 + (t0 + r) * D + c0), ua, ub); pg8::unpack8(*(const v4u*)(S1 + (t0 + r) * D + c0), ba, bb);
                const f32x4 ya = ba * (w0a * p2a + w1a * p1a + w2a * ua), yb = bb * (w0b * p2b + w1b * p1b + w2b * ub);
                *(v4u*)(S1 + (t0 + r) * D + c0) = pg8::pack8(ya, yb); p2a = p1a; p2b = p1b; p1a = ua; p1b = ub; }
        }
    }
    GRID_SYNC();
    SO.init(M, D, G, bx);
    g = pg8::Gemm{S1, WA, M, D, D}; E.mode = 1; EPI_SET(EP->o0 = S3; EP->o1 = S3);
    pg8::gemm_phase<pg8::EpiAll, pg8::StaticOrder, GEMM_ALIGN, GEMM_SP2>(ldsl, g, SO, E);
    GRID_SYNC();
    g = pg8::Gemm{S0, WIN + (size_t)4096 * D, M, 4096, D}; SO.init(M, 4096, G, bx);
    E.mode = 0; EPI_SET(EP->o0 = S1; EP->o1 = S2; EP->o2 = S4; EP->o6 = S5; EP->f0 = args.in[7]; EP->f1 = args.in[8]);
    pg8::gemm_phase<pg8::EpiAll, pg8::StaticOrder, GEMM_ALIGN, GEMM_SP2>(ldsl, g, SO, E);
    GRID_SYNC();
    {
        PHASE_IDS();
        float l1 = args.in[9][lane] * args.in[10][lane], l2 = args.in[11][lane] * args.in[12][lane];
        l1 = wave_sum(l1); l2 = wave_sum(l2);
        const float lam = __uint_as_float(__builtin_amdgcn_readfirstlane(__float_as_uint(__expf(l1) - __expf(l2) + 0.2f)));
        attn2::attn_phase<0>((char*)lds, S1, S2, S4, S0, vcu, G, lam, args.in[13]);
#ifdef EXP_ATTN
        GRID_SYNC(); attn2::attn_phase<EXP_ATTN>((char*)lds, S1, S2, S4, (bf16*)(ws + 816 * MiB), vcu, G, lam, args.in[13]);
#endif
    }
    GRID_SYNC();
    SO.init(M, D, G, bx);
    g = pg8::Gemm{S0, WB, M, D, D}; E.mode = 2; EPI_SET(EP->o0 = S3; EP->o1 = S5);
    pg8::gemm_phase<pg8::EpiAll, pg8::StaticOrder, GEMM_ALIGN, GEMM_SP2>(ldsl, g, SO, E);
    GRID_SYNC();
#ifdef EXP_NOFFN
    g = pg8::Gemm{S3, WO, M, D, D}; E.mode = 3; EPI_SET(EP->f0 = x; EP->f1 = mod + 2 * D; EP->fo = args.out);
    pg8::gemm_phase<pg8::EpiAll, pg8::StaticOrder, GEMM_ALIGN, GEMM_SP2>(ldsl, g, SO, E);
    return;
#endif
#ifdef P5_PANEL
    g = pg8::Gemm{S3, WO, M, D, D}; SO.init(M, D, G, bx); SO.panel = 1; E.mode = 3; EPI_SET(EP->f0 = x; EP->f1 = mod + 2 * D; EP->fo = X1);
    pg8::gemm_phase<pg8::EpiAll, pg8::StaticOrder, GEMM_ALIGN, GEMM_SP2>(ldsl, g, SO, E);
#else
    g = pg8::Gemm{S3, WO, M, D, D}; SO.init(M, D, G, bx); E.mode = 3; EPI_SET(EP->f0 = x; EP->f1 = mod + 2 * D; EP->fo = X1);
    pg8::gemm_phase<pg8::EpiAll, pg8::StaticOrder, GEMM_ALIGN, GEMM_SP2>(ldsl, g, SO, E);
    GRID_SYNC();
#endif
#ifdef P5_PANEL
    { PHASE_IDS(); for (int pnl = bx; pnl < M / 256; pnl += G) norm_rows(X1, args.in[17], mod + 3 * D, mod + 4 * D, S0, pnl * 8 + wave, lane); }
#else
#ifdef FFN_FP8
    { PHASE_IDS(); for (int rb = gw; rb < M / 32; rb += NGW) norm_rows8(X1, args.in[17], mod + 3 * D, mod + 4 * D, (unsigned char*)S0, rb, lane); }
#else
    { PHASE_IDS(); for (int rb = gw; rb < M / 32; rb += NGW) norm_rows(X1, args.in[17], mod + 3 * D, mod + 4 * D, S0, rb, lane); }
#endif
#endif
    GRID_SYNC();
#ifdef FFN_FP8
    g = pg8::Gemm{S0, WGU, M, NGU, D / 2}; SO.init(M, NGU, G, bx); E.mode = 6; EPI_SET(EP->o0 = S3);
    { pg8::EpiSw E8{1.f / WGU_FP8_SCALE}; pg8::gemm_phase<pg8::EpiSw, pg8::StaticOrder, GEMM_ALIGN, FP8_SP2, true>(ldsl, g, SO, E8); }
#else
    g = pg8::Gemm{S0, WGU, M, NGU, D}; SO.init(M, NGU, G, bx); E.mode = 4; EPI_SET(EP->o0 = S3);
    pg8::gemm_phase<pg8::EpiAll, pg8::StaticOrder, GEMM_ALIGN, GEMM_SP2>(ldsl, g, SO, E);
#endif
    GRID_SYNC();
    g = pg8::Gemm{S3, WDN, M, D, DFF}; SO.init(M, D, G, bx); E.mode = 3; EPI_SET(EP->f0 = X1; EP->f1 = mod + 5 * D; EP->fo = args.out);
    pg8::gemm_phase<pg8::EpiAll, pg8::StaticOrder, GEMM_ALIGN, GEMM_SP2>(ldsl, g, SO, E);
}

#ifdef FP8_TEST
__global__ void __launch_bounds__(NWAVES * 64, 2) fp8_only(const bf16* A, const bf16* Bt, bf16* out) {
    extern __shared__ __attribute__((aligned(16))) unsigned char lds[];
    LAS unsigned char* ldsl = (LAS unsigned char*)lds;
    LAS pg8::EpiP* EP = (LAS pg8::EpiP*)pg8::EPI_LDS_ADDR; if (threadIdx.x == 0) EP->o0 = out; __syncthreads();
    pg8::StaticOrder SO; SO.init(M, NGU, gridDim.x, blockIdx.x); pg8::Gemm g{A, Bt, M, NGU, D / 2};
    pg8::EpiSw E8{1.f / 32.f}; pg8::gemm_phase<pg8::EpiSw, pg8::StaticOrder, GEMM_ALIGN, FP8_SP2, true>(ldsl, g, SO, E8);
}
__global__ void __launch_bounds__(NWAVES * 64, 2) bf16_only(const bf16* A, const bf16* Bt, bf16* out) {
    extern __shared__ __attribute__((aligned(16))) unsigned char lds[];
    LAS unsigned char* ldsl = (LAS unsigned char*)lds;
    LAS pg8::EpiP* EP = (LAS pg8::EpiP*)pg8::EPI_LDS_ADDR; if (threadIdx.x == 0) EP->o0 = out; __syncthreads();
    pg8::StaticOrder SO; SO.init(M, NGU, gridDim.x, blockIdx.x); pg8::Gemm g{A, Bt, M, NGU, D};
    pg8::EpiSw E8{1.f}; pg8::gemm_phase<pg8::EpiSw, pg8::StaticOrder, GEMM_ALIGN, FP8_SP2, false>(ldsl, g, SO, E8);
}
#endif
extern "C" void kernel_launch(void* const* d_in, const int* in_sizes, int n_in, void* d_out, int out_size, void* d_ws, size_t ws_size, hipStream_t stream) {
    static int grid = 0;
    if (grid == 0) {
        if (n_in != 20 || in_sizes[0] != M * D || out_size != M * D || ws_size < WS_END) { fprintf(stderr, "kernel_launch: unexpected shapes (n_in %d, in0 %d, out %d, ws %zu)\n", n_in, n_in > 0 ? in_sizes[0] : -1, out_size, ws_size); grid = -1; return; }
        int dev = 0, cus = 0, per_cu = 0;
        (void)hipGetDevice(&dev); (void)hipDeviceGetAttribute(&cus, hipDeviceAttributeMultiprocessorCount, dev);
        (void)hipFuncSetAttribute((const void*)fwd_megakernel, hipFuncAttributeMaxDynamicSharedMemorySize, LDS_BYTES);
        if (hipOccupancyMaxActiveBlocksPerMultiprocessor(&per_cu, (const void*)fwd_megakernel, NWAVES * 64, LDS_BYTES) != hipSuccess || per_cu < 1) per_cu = 1;
        (void)hipGetLastError();
        grid = cus * per_cu;
    }
    if (grid < 0) return;
    (void)hipMemsetAsync((unsigned char*)d_ws + WS_CTL, 0, 16384, stream);
    Args a{};
    for (int i = 0; i < 20; ++i) a.in[i] = (const float*)d_in[i];
    a.out = (float*)d_out; a.ws = (unsigned char*)d_ws;
    void* kargs[] = {&a};
    hipError_t e = hipLaunchCooperativeKernel((const void*)fwd_megakernel, dim3(grid), dim3(NWAVES * 64), kargs, LDS_BYTES, stream);
    if (e != hipSuccess) fprintf(stderr, "cooperative launch failed: %s (grid %d)\n", hipGetErrorString(e), grid);
}
```

```cpp
#define FULL_LINE 1
#include <hip/hip_runtime.h>
#include <hip/hip_cooperative_groups.h>
#include <hip/hip_bf16.h>
#include <cstdio>
#include <cstdint>
#include <cmath>
namespace cg = cooperative_groups;
#ifndef PG8_WGM
#define PG8_WGM 8
#endif
namespace pg8 {
#define PG8_LAS __attribute__((address_space(3)))
typedef unsigned short bf16_t;
typedef short bf16x8 __attribute__((ext_vector_type(8)));
typedef float f32x4 __attribute__((ext_vector_type(4)));
typedef unsigned u32x4 __attribute__((ext_vector_type(4)));
constexpr int BM = 256, BK = 64, HALF = 128, HTB = HALF * BK * 2  , STAGE_BYTES = 8 * HTB, NXCD = 8, WGM = PG8_WGM;

__host__ __device__ __forceinline__ int lds_byte(int r, int c) { const int st = (r >> 4) * 2 + (c >> 5), rr = r & 15, cc = c & 31, ob = rr * 64 + cc * 2; return st * 1024 + (ob ^ (((ob >> 9) & 1) << 5)); }
__host__ __device__ __forceinline__ void stage_rc(int b, int& R, int& C) { const int st = b / 1024, sb = b % 1024, swz = sb ^ (((sb >> 9) & 1) << 5); R = (st >> 1) * 16 + swz / 64; C = (st & 1) * 32 + (swz % 64) / 2; }
__host__ __device__ __forceinline__ int perm32(int rho) { const int n = rho >> 4, i = rho & 15; return 8 * (i >> 2) + 4 * n + (i & 3); }

struct Unit { int pm, pn; };
struct Gemm { const bf16_t* A; const bf16_t* Bt; int M, N, K; };

struct StaticOrder {
    int nM, nN, nwg, G, c, panel;
    __host__ __device__ void init(int M, int N, int G_, int c_) { nM = M / BM; nN = N / BM; nwg = nM * nN; G = G_; c = c_; panel = 0; }
    __host__ __device__ bool next(int i, Unit& u) const {
        if (panel) { const int p_ = c + G * (i / nN); if (p_ >= nM) return false; u.pm = p_; u.pn = i % nN; return true; }
        const long L = (long)i * G + c; if (L >= nwg) return false;
        int wgid = (int)L; { const int q = nwg / NXCD, r = nwg % NXCD, xcd = wgid % NXCD, off = wgid / NXCD; wgid = (xcd < r ? xcd * (q + 1) : r * (q + 1) + (xcd - r) * q) + off; }
        const int nig = WGM * nN, gid = wgid / nig, fm = gid * WGM, gsz = (nM - fm) < WGM ? (nM - fm) : WGM;
        u.pm = fm + ((wgid % nig) % gsz); u.pn = (wgid % nig) / gsz; return true;
    }
    __device__ __forceinline__ void a_ready(const Unit&) const {}
    __device__ __forceinline__ void done(const Unit&) const {}
};
typedef float f32x2 __attribute__((ext_vector_type(2))); typedef __bf16 bf16x2_t __attribute__((ext_vector_type(2)));
__device__ __forceinline__ unsigned cvt_pk_bf16(float lo, float hi) { f32x2 v = {lo, hi}; bf16x2_t b = __builtin_convertvector(v, bf16x2_t); return __builtin_bit_cast(unsigned, b); }
constexpr float EPSF = 1e-6f;
constexpr float QC2 = 0.125f * 1.4426950408889634f;
__device__ __forceinline__ u32x4 pack8(const f32x4 a, const f32x4 b) { u32x4 w; w.x = cvt_pk_bf16(a[0], a[1]); w.y = cvt_pk_bf16(a[2], a[3]); w.z = cvt_pk_bf16(b[0], b[1]); w.w = cvt_pk_bf16(b[2], b[3]); return w; }
__device__ __forceinline__ float bf_lo(unsigned u) { return __uint_as_float(u << 16); }
__device__ __forceinline__ float bf_hi(unsigned u) { return __uint_as_float(u & 0xffff0000u); }
__device__ __forceinline__ void unpack8(const u32x4 w, f32x4& a, f32x4& b) { a = (f32x4){bf_lo(w.x), bf_hi(w.x), bf_lo(w.y), bf_hi(w.y)}; b = (f32x4){bf_lo(w.z), bf_hi(w.z), bf_lo(w.w), bf_hi(w.w)}; }
template <int X> __device__ __forceinline__ float swz_xor(float v) { return __uint_as_float((unsigned)__builtin_amdgcn_ds_swizzle((int)__float_as_uint(v), (X << 10) | 0x1f)); }
__device__ __forceinline__ float wave_sum64(float v) { v += swz_xor<1>(v); v += swz_xor<2>(v); v += swz_xor<4>(v); v += swz_xor<8>(v); v += swz_xor<16>(v);
    auto rr = __builtin_amdgcn_permlane32_swap(__float_as_uint(v), __float_as_uint(v), false, false); return __uint_as_float(rr[0]) + __uint_as_float(rr[1]); }
__device__ __forceinline__ float sigm(float x) { return __builtin_amdgcn_rcpf(1.f + __builtin_amdgcn_exp2f(-1.4426950408889634f * x)); }
#ifdef EXP_NOSIG
__device__ __forceinline__ f32x4 sigm4(const f32x4 v) { return v * 0.25f + 0.5f; }
#else
__device__ __forceinline__ f32x4 sigm4(const f32x4 v) { return (f32x4){sigm(v[0]), sigm(v[1]), sigm(v[2]), sigm(v[3])}; }
#endif

template <class T> __device__ __forceinline__ void st_g(T* p, const T v) { *(__attribute__((address_space(1))) T*)p = v; }
template <class T> __device__ __forceinline__ T ld_g(const T* p) { return *(const __attribute__((address_space(1))) T*)p; }
#ifndef EPI_NT_STORES
#define ST_NT(p, v) st_g((p), (v))
#else
#define ST_NT(p, v) __builtin_nontemporal_store((v), (p))
#endif
struct EpiP { bf16_t *o0, *o1, *o2, *o3, *o4, *o5, *o6; const float *f0, *f1; float* fo; };
constexpr unsigned EPI_LDS_ADDR = 131072 + 512;
#ifdef FULL_LINE
#define PL_COL (64 * wc + 8 * fq)
#define PL_BJ 32
#else
#define PL_COL (wc * 32 + 8 * fq)
#define PL_BJ HALF
#endif
struct EpiAll {
    static constexpr bool PERM = true, AFTER_DRAIN = false;
    int mode;
    __device__ __forceinline__ int vm_ops(const Unit& un) const {
        if (mode == 0 || mode == 1 || mode == 2) return 16;
        if (mode == 5) return (un.pn >= 4 && un.pn < 12) ? 8 : 16;
        if (mode == 3) return 32;
        if (mode == 4 || mode == 6) return 8;
        return 0; }
    __device__ __forceinline__ void operator()(const f32x4 (&acc)[2][2][4][2], const Unit& un, int wr, int wc, int fr, int fq) const {
        const PG8_LAS EpiP* P = (const PG8_LAS EpiP*)EPI_LDS_ADDR; const int pn = un.pn; const size_t row0 = (size_t)(mode == 98 ? 0 : un.pm) * BM + wr * 64 + fr;
        if (mode == 99) {
            f32x4 s = {0.f, 0.f, 0.f, 0.f};
#pragma unroll
            for (int ai = 0; ai < 2; ++ai)
#pragma unroll
                for (int bj = 0; bj < 2; ++bj)
#pragma unroll
                    for (int m = 0; m < 4; ++m) { s += acc[ai][bj][m][0]; s += acc[ai][bj][m][1]; }
            if (s[0] + s[1] + s[2] + s[3] == 12345.678f) P->o0[0] = 1;
            return; }
        if (mode == 0) {
            if (pn < 8) {
                const bool isq = pn < 4; bf16_t* base = isq ? P->o0 : P->o1; const float* g = isq ? P->f0 : P->f1; const float sc = isq ? QC2 : 1.f;
                f32x4 gv[2][2];
#pragma unroll
                for (int bj = 0; bj < 2; ++bj)
#pragma unroll
                    for (int n = 0; n < 2; ++n) gv[bj][n] = ld_g((const f32x4*)(g + 32 * bj + 8 * fq + 4 * n)) * sc;
                const int col0 = (pn & 3) * 256 + 64 * wc + 8 * fq;
#pragma unroll
                for (int ai = 0; ai < 2; ++ai)
#pragma unroll
                    for (int m = 0; m < 4; ++m) {
                        float ss = 0.f;
#pragma unroll
                        for (int bj = 0; bj < 2; ++bj)
#pragma unroll
                            for (int n = 0; n < 2; ++n) { const f32x4 x = acc[ai][bj][m][n]; ss += (x[0] * x[0] + x[1] * x[1]) + (x[2] * x[2] + x[3] * x[3]); }
                        ss += swz_xor<16>(ss); { auto rr = __builtin_amdgcn_permlane32_swap(__float_as_uint(ss), __float_as_uint(ss), false, false); ss = __uint_as_float(rr[0]) + __uint_as_float(rr[1]); }
                        const float rs = rsqrtf(ss * (1.f / 64.f) + EPSF);
                        bf16_t* rowp = base + (row0 + ai * HALF + m * 16) * 1024 + col0;
#pragma unroll
                        for (int bj = 0; bj < 2; ++bj) ST_NT((u32x4*)(rowp + 32 * bj), pack8(acc[ai][bj][m][0] * rs * gv[bj][0], acc[ai][bj][m][1] * rs * gv[bj][1]));
                    }
            } else if (pn < 12) {
                const int col0 = (pn & 3) * 256 + PL_COL;
#pragma unroll
                for (int ai = 0; ai < 2; ++ai)
#pragma unroll
                    for (int m = 0; m < 4; ++m) { bf16_t* rowp = P->o2 + (row0 + ai * HALF + m * 16) * 1024 + col0;
#pragma unroll
                        for (int bj = 0; bj < 2; ++bj) ST_NT((u32x4*)(rowp + bj * PL_BJ), pack8(acc[ai][bj][m][0], acc[ai][bj][m][1])); }
            } else {
                const int col0 = (pn & 3) * 256 + PL_COL;
#pragma unroll
                for (int ai = 0; ai < 2; ++ai)
#pragma unroll
                    for (int m = 0; m < 4; ++m) { bf16_t* rowp = P->o6 + (row0 + ai * HALF + m * 16) * 1024 + col0;
#pragma unroll
                        for (int bj = 0; bj < 2; ++bj) ST_NT((u32x4*)(rowp + bj * PL_BJ), pack8(sigm4(acc[ai][bj][m][0]), sigm4(acc[ai][bj][m][1]))); }
            }
        } else if (mode == 5 || mode == 98 || mode == 97) {
            const bool probe_ = mode == 97; u32x4 xa_ = {0u, 0u, 0u, 0u};
#define ST5(p, v) do { const u32x4 v_ = (v); if (probe_) xa_ ^= v_; else st_g((p), v_); } while (0)
            if (pn < 4) {
                const int col0 = pn * 256 + PL_COL;
#pragma unroll
                for (int ai = 0; ai < 2; ++ai)
#pragma unroll
                    for (int m = 0; m < 4; ++m) { bf16_t* rowp = P->o3 + (row0 + ai * HALF + m * 16) * 1024 + col0;
#pragma unroll
                        for (int bj = 0; bj < 2; ++bj) ST5((u32x4*)(rowp + bj * PL_BJ), pack8(acc[ai][bj][m][0], acc[ai][bj][m][1])); }
            } else if (pn < 12) {
                const int col0 = (pn - 4) * 128 + wc * 32 + 8 * fq;
#pragma unroll
                for (int ai = 0; ai < 2; ++ai)
#pragma unroll
                    for (int m = 0; m < 4; ++m)
                        ST5((u32x4*)(P->o4 + (row0 + ai * HALF + m * 16) * 1024 + col0), pack8(acc[ai][0][m][0] * acc[ai][1][m][0], acc[ai][0][m][1] * acc[ai][1][m][1]));
            } else {
                const int col0 = (pn & 3) * 256 + PL_COL;
#pragma unroll
                for (int ai = 0; ai < 2; ++ai)
#pragma unroll
                    for (int m = 0; m < 4; ++m) { bf16_t* rowp = P->o5 + (row0 + ai * HALF + m * 16) * 1024 + col0;
#pragma unroll
                        for (int bj = 0; bj < 2; ++bj) ST5((u32x4*)(rowp + bj * PL_BJ), pack8(sigm4(acc[ai][bj][m][0]), sigm4(acc[ai][bj][m][1]))); }
            }
            if (probe_ && (xa_.x ^ xa_.y ^ xa_.z ^ xa_.w) == 0x12345678u) *(unsigned*)P->o3 = 1u;
#undef ST5
        } else if (mode == 1 || mode == 2) {
            const int col0 = pn * 256 + wc * 32 + 8 * fq;
#pragma unroll
            for (int ai = 0; ai < 2; ++ai)
#pragma unroll
                for (int m = 0; m < 4; ++m) { const size_t off = (row0 + ai * HALF + m * 16) * 1024 + col0;
#pragma unroll
                    for (int bj = 0; bj < 2; ++bj) { f32x4 ga, gb; unpack8(ld_g((const u32x4*)(P->o1 + off + bj * HALF)), ga, gb);
                        f32x4 r0 = ga * acc[ai][bj][m][0], r1 = gb * acc[ai][bj][m][1];
                        if (mode == 2) { f32x4 ma, mb; unpack8(ld_g((const u32x4*)(P->o0 + off + bj * HALF)), ma, mb); r0 += ma; r1 += mb; }
                        ST_NT((u32x4*)(P->o0 + off + bj * HALF), pack8(r0, r1)); } }
        } else if (mode == 3) {
            const int col0 = pn * 256 + wc * 32 + 8 * fq; const float* gp = P->f1 + (size_t)((un.pm * BM) >> 11) * 6144 + col0;
            f32x4 gv[2][2];
#pragma unroll
            for (int bj = 0; bj < 2; ++bj)
#pragma unroll
                for (int n = 0; n < 2; ++n) gv[bj][n] = ld_g((const f32x4*)(gp + bj * HALF + 4 * n));
#pragma unroll
            for (int ai = 0; ai < 2; ++ai)
#pragma unroll
                for (int m = 0; m < 4; ++m) { const size_t off = (row0 + ai * HALF + m * 16) * 1024 + col0;
#pragma unroll
                    for (int bj = 0; bj < 2; ++bj)
#pragma unroll
                        for (int n = 0; n < 2; ++n) ST_NT((f32x4*)(P->fo + off + bj * HALF + 4 * n), ld_g((const f32x4*)(P->f0 + off + bj * HALF + 4 * n)) + gv[bj][n] * acc[ai][bj][m][n]); }
        } else {
            const int col0 = pn * 128 + wc * 32 + 8 * fq;
            const float sc6 = (mode == 6) ? (1.f / 32.f) : 1.f;
#pragma unroll
            for (int ai = 0; ai < 2; ++ai)
#pragma unroll
                for (int m = 0; m < 4; ++m) { const f32x4 g0 = acc[ai][0][m][0] * sc6, g1 = acc[ai][0][m][1] * sc6;
                    ST_NT((u32x4*)(P->o0 + (row0 + ai * HALF + m * 16) * 2816 + col0), pack8(g0 * sigm4(g0) * (acc[ai][1][m][0] * sc6), g1 * sigm4(g1) * (acc[ai][1][m][1] * sc6))); }
        }
    }
};

struct EpiSw {
    static constexpr bool PERM = true, AFTER_DRAIN = false; float sc;
    __device__ __forceinline__ int vm_ops(const Unit&) const { return 8; }
    __device__ __forceinline__ void operator()(const f32x4 (&acc)[2][2][4][2], const Unit& un, int wr, int wc, int fr, int fq) const {
        const PG8_LAS EpiP* P = (const PG8_LAS EpiP*)EPI_LDS_ADDR; const size_t row0 = (size_t)un.pm * BM + wr * 64 + fr; const int col0 = un.pn * 128 + wc * 32 + 8 * fq;
        bf16_t* ob = P->o0;
#pragma unroll
        for (int ai = 0; ai < 2; ++ai)
#pragma unroll
            for (int m = 0; m < 4; ++m) { const f32x4 g0 = acc[ai][0][m][0] * sc, g1 = acc[ai][0][m][1] * sc;
                st_g((u32x4*)(ob + (row0 + ai * HALF + m * 16) * 2816 + col0), pack8(g0 * sigm4(g0) * (acc[ai][1][m][0] * sc), g1 * sigm4(g1) * (acc[ai][1][m][1] * sc))); }
    }
};

template <class Epi, class Sched, bool ALIGN_EPI = false, bool SP2 = false, bool FP8 = false>
__device__ __forceinline__ void gemm_phase(PG8_LAS unsigned char* lds, const Gemm g, const Sched& S, const Epi& E) {
    int tid_ = threadIdx.x; asm volatile("" : "+v"(tid_)); const int tid = tid_, wid = __builtin_amdgcn_readfirstlane(tid >> 6), lane = tid & 63, wr = wid >> 2, wc = wid & 3, fr = lane & 15, fq = lane >> 4;
    const int K = g.K, nt = K / BK;
    unsigned voffA[2], voffB[2];
#pragma unroll
    for (int i = 0; i < 2; ++i) { int R, C; stage_rc(tid * 16 + i * 8192, R, C); const int Rb = Epi::PERM ? ((R & ~31) + perm32(R & 31)) : R;
        voffA[i] = (unsigned)(R * K + C) * 2u; voffB[i] = (unsigned)(Rb * K + C) * 2u; }
    const size_t kstep = (size_t)(BK * 2);
    const size_t hstep = (size_t)HALF * K * 2;
    const size_t tstep = 2 * hstep;
    const unsigned ldsw = (unsigned)wid * 1024u;
    const int aoff = FP8 ? lds_byte(wr * 64 + fr, fq * 16) : lds_byte(wr * 64 + fr, fq * 8), boff = FP8 ? lds_byte(wc * 32 + fr, fq * 16) : lds_byte(wc * 32 + fr, fq * 8);
    const int aoff1 = aoff + (FP8 ? 16 : 1024), boff1 = boff + (FP8 ? 16 : 1024);
#define PG8_SA(b, h) (((b) * 2 + (h)) * HTB)
#define PG8_SB(b, h) ((4 + (b) * 2 + (h)) * HTB)
#define PG8_STAGE(bufoff, gbase, voff) do { _Pragma("unroll") for (int _i = 0; _i < 2; ++_i) \
        __builtin_amdgcn_global_load_lds((const unsigned*)((const char*)(gbase) + (voff)[_i]), (PG8_LAS unsigned*)(lds + (bufoff) + ldsw + _i * 8192), 16, 0, 0); } while (0)
#define PG8_LDA(dst, b, h) do { _Pragma("unroll") for (int m = 0; m < 4; ++m) { if constexpr (FP8) { int ao_ = aoff; asm volatile("" : "+v"(ao_));   const v4i_ lo_ = *(const PG8_LAS v4i_*)(lds + PG8_SA(b, h) + ao_ + m * 2048), hi_ = *(const PG8_LAS v4i_*)(lds + PG8_SA(b, h) + ao_ + 16 + m * 2048); dst##8[m] = __builtin_shufflevector(lo_, hi_, 0, 1, 2, 3, 4, 5, 6, 7); } \
        else { _Pragma("unroll") for (int k = 0; k < 2; ++k) dst[m][k] = *(const PG8_LAS bf16x8*)(lds + PG8_SA(b, h) + aoff + m * 2048 + k * 1024); } } } while (0)
#define PG8_LDB(dst, b, h) do { _Pragma("unroll") for (int n = 0; n < 2; ++n) { if constexpr (FP8) { int bo_ = boff; asm volatile("" : "+v"(bo_)); const v4i_ lo_ = *(const PG8_LAS v4i_*)(lds + PG8_SB(b, h) + bo_ + n * 2048), hi_ = *(const PG8_LAS v4i_*)(lds + PG8_SB(b, h) + bo_ + 16 + n * 2048); dst##8[n] = __builtin_shufflevector(lo_, hi_, 0, 1, 2, 3, 4, 5, 6, 7); } \
        else { _Pragma("unroll") for (int k = 0; k < 2; ++k) dst[n][k] = *(const PG8_LAS bf16x8*)(lds + PG8_SB(b, h) + boff + n * 2048 + k * 1024); } } } while (0)
#define PG8_MMA(ai, bj, At, Bt) do { __builtin_amdgcn_s_setprio(1); _Pragma("unroll") for (int m = 0; m < 4; ++m) _Pragma("unroll") for (int n = 0; n < 2; ++n) { \
        if constexpr (FP8) { acc[ai][bj][m][n] = __builtin_amdgcn_mfma_scale_f32_16x16x128_f8f6f4(Bt##8[n], At##8[m], acc[ai][bj][m][n], 0, 0, 0, 0, 0, 0); } \
        else { _Pragma("unroll") for (int k = 0; k < 2; ++k) acc[ai][bj][m][n] = __builtin_amdgcn_mfma_f32_16x16x32_bf16(Bt[n][k], At[m][k], acc[ai][bj][m][n], 0, 0, 0); } } \
        __builtin_amdgcn_s_setprio(0); } while (0)
#define PG8_WAIT_V(n) asm volatile("s_waitcnt vmcnt(" #n ")" ::: "memory")
#define PG8_WAIT_L(n) asm volatile("s_waitcnt lgkmcnt(" #n ")" ::: "memory")
#define PG8_BAR __builtin_amdgcn_s_barrier()
#define PG8_SCHED __builtin_amdgcn_sched_barrier(0)
#ifdef GEMM_STAG
    { const unsigned g_ = (blockIdx.x >> 3) & (GEMM_STAGN - 1u); if (g_) { const unsigned long long t0_ = __builtin_amdgcn_s_memrealtime(); while (__builtin_amdgcn_s_memrealtime() - t0_ < (unsigned long long)(g_ * GEMM_STAG)) __builtin_amdgcn_s_sleep(8); } }
#endif
    Unit cur, nxt; int ui = 0;
    if (!S.next(0, cur)) return;
    f32x4 acc[2][2][4][2];
#pragma unroll
    for (int a = 0; a < 2; ++a)
#pragma unroll
        for (int b = 0; b < 2; ++b)
#pragma unroll
            for (int m = 0; m < 4; ++m)
#pragma unroll
                for (int n = 0; n < 2; ++n) acc[a][b][m][n] = (f32x4){0.f, 0.f, 0.f, 0.f};
    typedef int v4i_ __attribute__((ext_vector_type(4))); typedef int v8i_ __attribute__((ext_vector_type(8)));
    bf16x8 At[4][2], B0[2][2], B1[2][2]; v8i_ At8[4], B08[2], B18[2];
    const char* cA = (const char*)g.A + (size_t)cur.pm * tstep; const char* cB = (const char*)g.Bt + (size_t)cur.pn * tstep;
    S.a_ready(cur);
    if constexpr (SP2) {
        PG8_STAGE(PG8_SB(0, 0), cB, voffB); PG8_STAGE(PG8_SB(0, 1), cB + hstep, voffB); PG8_STAGE(PG8_SA(0, 0), cA, voffA); PG8_STAGE(PG8_SA(0, 1), cA + hstep, voffA);
        if (wr == 1) PG8_BAR;
        PG8_WAIT_V(2); PG8_BAR;
        PG8_STAGE(PG8_SB(1, 0), cB + kstep, voffB); PG8_STAGE(PG8_SA(1, 0), cA + kstep, voffA); PG8_STAGE(PG8_SB(1, 1), cB + hstep + kstep, voffB);
        PG8_WAIT_V(6); PG8_BAR;
    } else {
        PG8_STAGE(PG8_SB(0, 0), cB, voffB); PG8_STAGE(PG8_SA(0, 0), cA, voffA); PG8_STAGE(PG8_SB(0, 1), cB + hstep, voffB); PG8_STAGE(PG8_SA(0, 1), cA + hstep, voffA);
        if (wr == 1) PG8_BAR;
        PG8_WAIT_V(4); PG8_BAR;
        PG8_STAGE(PG8_SB(1, 0), cB + kstep, voffB); PG8_STAGE(PG8_SA(1, 0), cA + kstep, voffA); PG8_STAGE(PG8_SB(1, 1), cB + hstep + kstep, voffB);
        PG8_WAIT_V(6); PG8_BAR;
    }
    for (;;) {
        const bool has_next = S.next(ui + 1, nxt);
        const char* nA = has_next ? (const char*)g.A + (size_t)nxt.pm * tstep : cA; const char* nB = has_next ? (const char*)g.Bt + (size_t)nxt.pn * tstep : cB;
        for (int t = 0; t < nt; t += 2) {
            const bool last = (t == nt - 2);
            const char* a1 = cA + (size_t)(t + 1) * kstep;
            const char* a2 = last ? nA : cA + (size_t)(t + 2) * kstep; const char* b2 = last ? nB : cB + (size_t)(t + 2) * kstep;
            const char* a3 = a2 + kstep; const char* b3 = b2 + kstep;
            if (last && has_next) S.a_ready(nxt);
            if constexpr (SP2) {
            PG8_LDB(B0, 0, 0); PG8_LDB(B1, 0, 1); PG8_SCHED; PG8_LDA(At, 0, 0); PG8_STAGE(PG8_SA(1, 1), a1 + hstep, voffA);
            PG8_WAIT_V(8); PG8_WAIT_L(0); PG8_BAR; PG8_MMA(0, 0, At, B0); PG8_MMA(0, 1, At, B1); PG8_BAR; PG8_SCHED;
            PG8_LDA(At, 0, 1); PG8_STAGE(PG8_SB(0, 0), b2, voffB); PG8_STAGE(PG8_SB(0, 1), b2 + hstep, voffB); PG8_STAGE(PG8_SA(0, 0), a2, voffA);
            PG8_WAIT_V(8); PG8_WAIT_L(0); PG8_BAR; PG8_MMA(1, 0, At, B0); PG8_MMA(1, 1, At, B1); PG8_BAR; PG8_SCHED;
            PG8_LDB(B0, 1, 0); PG8_LDB(B1, 1, 1); PG8_SCHED; PG8_LDA(At, 1, 0); PG8_STAGE(PG8_SA(0, 1), a2 + hstep, voffA);
            PG8_WAIT_V(8); PG8_WAIT_L(0); PG8_BAR; PG8_MMA(0, 0, At, B0); PG8_MMA(0, 1, At, B1); PG8_BAR; PG8_SCHED;
            PG8_LDA(At, 1, 1); PG8_STAGE(PG8_SB(1, 0), b3, voffB); PG8_STAGE(PG8_SB(1, 1), b3 + hstep, voffB); PG8_STAGE(PG8_SA(1, 0), a3, voffA);
            PG8_WAIT_V(8); PG8_WAIT_L(0); PG8_BAR; PG8_MMA(1, 0, At, B0); PG8_MMA(1, 1, At, B1); PG8_BAR; PG8_SCHED;
            } else {
            PG8_LDB(B0, 0, 0); PG8_SCHED; PG8_LDA(At, 0, 0); PG8_STAGE(PG8_SA(1, 1), a1 + hstep, voffA);
            PG8_WAIT_L(8); PG8_BAR; PG8_WAIT_L(0); PG8_MMA(0, 0, At, B0); PG8_BAR; PG8_SCHED;
            PG8_LDB(B1, 0, 1); PG8_STAGE(PG8_SB(0, 0), b2, voffB);
            PG8_BAR; PG8_WAIT_L(0); PG8_MMA(0, 1, At, B1); PG8_BAR;
            PG8_LDA(At, 0, 1); PG8_STAGE(PG8_SA(0, 0), a2, voffA);
            PG8_BAR; PG8_WAIT_L(0); PG8_MMA(1, 0, At, B0); PG8_BAR; PG8_SCHED;
            PG8_STAGE(PG8_SB(0, 1), b2 + hstep, voffB);
            PG8_WAIT_V(6); PG8_BAR; PG8_MMA(1, 1, At, B1); PG8_BAR;
            PG8_LDB(B0, 1, 0); PG8_SCHED; PG8_LDA(At, 1, 0); PG8_STAGE(PG8_SA(0, 1), a2 + hstep, voffA);
            PG8_WAIT_L(8); PG8_BAR; PG8_WAIT_L(0); PG8_MMA(0, 0, At, B0); PG8_BAR; PG8_SCHED;
            PG8_LDB(B1, 1, 1); PG8_STAGE(PG8_SB(1, 0), b3, voffB);
            PG8_BAR; PG8_WAIT_L(0); PG8_MMA(0, 1, At, B1); PG8_BAR;
            PG8_LDA(At, 1, 1); PG8_STAGE(PG8_SA(1, 0), a3, voffA);
            PG8_BAR; PG8_WAIT_L(0); PG8_MMA(1, 0, At, B0); PG8_BAR; PG8_SCHED;
            PG8_STAGE(PG8_SB(1, 1), b3 + hstep, voffB);
            PG8_WAIT_V(6); PG8_BAR; PG8_MMA(1, 1, At, B1); PG8_BAR;
            }
        }
        if constexpr (ALIGN_EPI) { if (wr == 0) PG8_BAR; }
        if constexpr (!Epi::AFTER_DRAIN) { E(acc, cur, wr, wc, fr, fq); S.done(cur); }
        if (!has_next) break;
#pragma unroll
        for (int a = 0; a < 2; ++a)
#pragma unroll
            for (int b = 0; b < 2; ++b)
#pragma unroll
                for (int m = 0; m < 4; ++m)
#pragma unroll
                    for (int n = 0; n < 2; ++n) acc[a][b][m][n] = (f32x4){0.f, 0.f, 0.f, 0.f};
        cur = nxt; cA = nA; cB = nB; ++ui;
        if constexpr (ALIGN_EPI) { if (wr == 1) PG8_BAR; }
    }
    PG8_WAIT_V(0);
    if constexpr (!ALIGN_EPI) { if (wr == 0) PG8_BAR; }
    PG8_BAR;
    if constexpr (Epi::AFTER_DRAIN) { E.fused(acc, cur, wr, wc, fr, fq, lds, wid, lane); S.done(cur); }
#undef PG8_SA
#undef PG8_SB
#undef PG8_STAGE
#undef PG8_LDA
#undef PG8_LDB
#undef PG8_MMA
#undef PG8_WAIT_V
#undef PG8_WAIT_L
#undef PG8_BAR
#undef PG8_SCHED
}
}
namespace attn2 {
typedef short bf16x8 __attribute__((ext_vector_type(8)));
typedef short s16x4 __attribute__((ext_vector_type(4)));
typedef float f32x16 __attribute__((ext_vector_type(16)));
typedef float f32x4 __attribute__((ext_vector_type(4)));
typedef unsigned u32x4 __attribute__((ext_vector_type(4)));
typedef unsigned short bf16;
constexpr int LD = 1024, NW = 8, QBLK = 32, KVBLK = 64, QB = NW * QBLK, SEQ = 2048;
constexpr int SHM_V = KVBLK * 128 * 2, SHM_K = KVBLK * 64 * 2;
constexpr int OFF_K = 2 * SHM_V, OFF_WS = OFF_K + 2 * SHM_K, OFF_OST = OFF_WS + NW * 64 * 4, LDS_BYTES = OFF_OST + NW * 8192;
constexpr float THR = 8.f;
#define KSWZ(row, colB) ((row) * 128 + ((colB) ^ (((row) & 7) << 4)))
#define SBAR() __builtin_amdgcn_sched_barrier(0)
#ifdef ATTN_SGB
#define SGB_QK() do { __builtin_amdgcn_sched_group_barrier(0x100, 4, 0); _Pragma("unroll") for (int i_ = 0; i_ < 8; ++i_) { __builtin_amdgcn_sched_group_barrier(0x008, 1, 0); __builtin_amdgcn_sched_group_barrier(0x100, 1, 0); __builtin_amdgcn_sched_group_barrier(0x002, ATTN_SGB, 0); } } while (0)
#else
#define SGB_QK() do {} while (0)
#endif
__device__ __forceinline__ int v_st(int k, int c) { const int kk = (k & ~0xC) | ((k & 4) << 1) | ((k & 8) >> 1); return ((kk >> 3) * 4 + (c >> 5)) * 512 + ((kk & 7) * 32 + (c & 31)) * 2; }
__device__ __forceinline__ int v_rd_base(int lane) { return ((lane & 3) << 3) | (((lane >> 2) & 3) << 6) | (((lane >> 4) & 1) << 5) | (((lane >> 5) & 1) << 8); }
constexpr int v_rd_off(int d0, int ks, int half) { return d0 * 512 + ks * 4096 + half * 2048; }
__device__ __forceinline__ int crow(int r, int hi) { return (r & 3) + 8 * (r >> 2) + 4 * hi; }
__device__ __forceinline__ unsigned cvtpk(float lo, float hi) { return pg8::cvt_pk_bf16(lo, hi); }
__device__ __forceinline__ void mask_tile(f32x16& p0, f32x16& p1, int dq) {
    const float NEG = -__builtin_inff();
#pragma unroll
    for (int r = 0; r < 16; ++r) { const int c = (r & 3) + 8 * (r >> 2); if (dq - c < 0) p0[r] = NEG; if (dq - c - 32 < 0) p1[r] = NEG; }
}
__device__ __forceinline__ void partialSM(f32x16& p0, f32x16& p1, float& m_reg, float& mn, float& alpha) {
    float pmax = p0[0];
#pragma unroll
    for (int r = 1; r < 16; ++r) pmax = fmaxf(pmax, p0[r]);
#pragma unroll
    for (int r = 0; r < 16; ++r) pmax = fmaxf(pmax, p1[r]);
    { auto rr = __builtin_amdgcn_permlane32_swap(__float_as_uint(pmax), __float_as_uint(pmax), false, false); pmax = fmaxf(__uint_as_float(rr[0]), __uint_as_float(rr[1])); }
    if (__builtin_expect(__all((pmax - m_reg) <= THR), 1)) { mn = m_reg; alpha = 1.f; }
    else { mn = fmaxf(m_reg, pmax); alpha = __builtin_amdgcn_exp2f(m_reg - mn); m_reg = mn; }
#pragma unroll
    for (int r = 0; r < 16; ++r) { p0[r] -= mn; p1[r] -= mn; }
#pragma unroll
    for (int r = 0; r < 16; ++r) p0[r] = __builtin_amdgcn_exp2f(p0[r]);
}
__device__ __forceinline__ void finishSM(f32x16& p0, f32x16& p1, float alpha, float& l_reg, bf16x8& pa0, bf16x8& pa1, bf16x8& pa2, bf16x8& pa3) {
#pragma unroll
    for (int r = 0; r < 16; ++r) p1[r] = __builtin_amdgcn_exp2f(p1[r]);
    typedef float f32x2_ __attribute__((ext_vector_type(2)));
    f32x2_ ps2 = {0.f, 0.f};
#pragma unroll
    for (int r = 0; r < 16; r += 2) { ps2 += (f32x2_){p0[r], p0[r + 1]}; ps2 += (f32x2_){p1[r], p1[r + 1]}; }
    float ps = ps2.x + ps2.y;
    { auto rr = __builtin_amdgcn_permlane32_swap(__float_as_uint(ps), __float_as_uint(ps), false, false); ps = __uint_as_float(rr[0]) + __uint_as_float(rr[1]); }
    l_reg = l_reg * alpha + ps;
#define PK4(P, B_, OUT) do { unsigned a0 = cvtpk(P[B_+0], P[B_+1]), a1 = cvtpk(P[B_+2], P[B_+3]);                          \
        unsigned b0 = cvtpk(P[B_+4], P[B_+5]), b1 = cvtpk(P[B_+6], P[B_+7]);                                             \
        auto r0 = __builtin_amdgcn_permlane32_swap(a0, b0, false, false); auto r1 = __builtin_amdgcn_permlane32_swap(a1, b1, false, false); \
        u32x4 w = {r0[0], r1[0], r0[1], r1[1]}; OUT = __builtin_bit_cast(bf16x8, w); } while (0)
    PK4(p0, 0, pa0); PK4(p0, 8, pa1); PK4(p1, 0, pa2); PK4(p1, 8, pa3);
#undef PK4
}
template <int KB>
__device__ __forceinline__ void qkt(f32x16& p0, f32x16& p1, const char* K_lds, int r32, int hi, const bf16x8* qr, bool act) {
#ifdef ATTN_WSKIP
    if (!act) { const float NEG = -__builtin_inff();
#pragma unroll
        for (int r = 0; r < 16; ++r) { p0[r] = NEG; p1[r] = NEG; } return; }
#endif
    p0 = f32x16{}; p1 = f32x16{};
#pragma unroll
    for (int d0 = 0; d0 < 4; ++d0) { const char* a = K_lds + KB * SHM_K + KSWZ(r32, (d0 * 16 + hi * 8) * 2);
        const bf16x8 b0 = *reinterpret_cast<const bf16x8*>(a);
        const bf16x8 b1 = *reinterpret_cast<const bf16x8*>(a + 32 * 128);
        p0 = __builtin_amdgcn_mfma_f32_32x32x16_bf16(b0, qr[d0], p0, 0, 0, 0);
        p1 = __builtin_amdgcn_mfma_f32_32x32x16_bf16(b1, qr[d0], p1, 0, 0, 0); }
}
template <int VB>
__device__ __forceinline__ void pv_tile(f32x16* o, int vb0, bf16x8 pa0, bf16x8 pa1, bf16x8 pa2, bf16x8 pa3, bool act) {
#ifdef ATTN_WSKIP
    if (!act) return;
#endif
#define TRRD(dst, off) asm volatile("ds_read_b64_tr_b16 %0, %1 offset:%2" : "=&v"(dst) : "v"(vb0), "i"(off) : "memory")
#define PV_D0(d0) do { s16x4 l0, l1, l2, l3, h0, h1, h2, h3; constexpr int b_ = VB * SHM_V + v_rd_off(d0, 0, 0); \
        TRRD(l0, b_); TRRD(h0, b_ + 2048); TRRD(l1, b_ + 4096); TRRD(h1, b_ + 6144); TRRD(l2, b_ + 8192); TRRD(h2, b_ + 10240); TRRD(l3, b_ + 12288); TRRD(h3, b_ + 14336); \
        asm volatile("s_waitcnt lgkmcnt(0)" ::: "memory"); SBAR();   \
        o[d0] = __builtin_amdgcn_mfma_f32_32x32x16_bf16(pa0, (bf16x8){l0[0], l0[1], l0[2], l0[3], h0[0], h0[1], h0[2], h0[3]}, o[d0], 0, 0, 0);   \
        o[d0] = __builtin_amdgcn_mfma_f32_32x32x16_bf16(pa1, (bf16x8){l1[0], l1[1], l1[2], l1[3], h1[0], h1[1], h1[2], h1[3]}, o[d0], 0, 0, 0);   \
        o[d0] = __builtin_amdgcn_mfma_f32_32x32x16_bf16(pa2, (bf16x8){l2[0], l2[1], l2[2], l2[3], h2[0], h2[1], h2[2], h2[3]}, o[d0], 0, 0, 0);   \
        o[d0] = __builtin_amdgcn_mfma_f32_32x32x16_bf16(pa3, (bf16x8){l3[0], l3[1], l3[2], l3[3], h3[0], h3[1], h3[2], h3[3]}, o[d0], 0, 0, 0); } while (0)
    PV_D0(0); PV_D0(1); PV_D0(2); PV_D0(3);
#undef PV_D0
#undef TRRD
}
#ifndef ATTN_NO_FUSE
template <int VB>
__device__ __forceinline__ void pv_softmax(f32x16* o, int vb0, bf16x8 pa0, bf16x8 pa1, bf16x8 pa2, bf16x8 pa3, f32x16& p0, f32x16& p1, float& m_reg, float& mn, float& alpha) {
#define TRRD(dst, off) asm volatile("ds_read_b64_tr_b16 %0, %1 offset:%2" : "=&v"(dst) : "v"(vb0), "i"(off) : "memory")
#define RD8(F, ks) do { constexpr int b_ = VB * SHM_V + (ks) * 4096; \
        TRRD(F##00, b_); TRRD(F##01, b_ + 2048); TRRD(F##10, b_ + 512); TRRD(F##11, b_ + 512 + 2048); TRRD(F##20, b_ + 1024); TRRD(F##21, b_ + 1024 + 2048); TRRD(F##30, b_ + 1536); TRRD(F##31, b_ + 1536 + 2048); } while (0)
#define FR(L_, H_) (bf16x8){L_[0], L_[1], L_[2], L_[3], H_[0], H_[1], H_[2], H_[3]}
#define LGK(n) asm volatile("s_waitcnt lgkmcnt(" #n ")" ::: "memory")
#define MM(d0, PA, L_, H_) o[d0] = __builtin_amdgcn_mfma_f32_32x32x16_bf16(PA, FR(L_, H_), o[d0], 0, 0, 0)
#define MX4(P, b) fmaxf(fmaxf(fmaxf(P[b], P[(b) + 1]), P[(b) + 2]), P[(b) + 3])
#define SE4(P, b) do { typedef float f32x2_ __attribute__((ext_vector_type(2))); const f32x2_ m2_ = {mn, mn}; const f32x2_ d0_ = (f32x2_){P[b], P[(b) + 1]} - m2_, d1_ = (f32x2_){P[(b) + 2], P[(b) + 3]} - m2_; P[b] = __builtin_amdgcn_exp2f(d0_.x); P[(b) + 1] = __builtin_amdgcn_exp2f(d0_.y); P[(b) + 2] = __builtin_amdgcn_exp2f(d1_.x); P[(b) + 3] = __builtin_amdgcn_exp2f(d1_.y); } while (0)
#define SB8(P, b) do { typedef float f32x2_ __attribute__((ext_vector_type(2))); const f32x2_ m2_ = {mn, mn}; _Pragma("unroll") for (int r_ = 0; r_ < 8; r_ += 2) { const f32x2_ d_ = (f32x2_){P[(b) + r_], P[(b) + r_ + 1]} - m2_; P[(b) + r_] = d_.x; P[(b) + r_ + 1] = d_.y; } } while (0)
    s16x4 A00, A01, A10, A11, A20, A21, A30, A31, B00, B01, B10, B11, B20, B21, B30, B31;
    float t0, t1, t2, t3, t4, t5, t6, t7;
#define PINV(x) asm volatile("" : "+v"(x))
    RD8(A, 0); RD8(B, 1); LGK(8); SBAR();
    MM(0, pa0, A00, A01); t0 = MX4(p0, 0);  PINV(t0); SBAR();
    MM(1, pa0, A10, A11); t1 = MX4(p0, 4);  PINV(t1); SBAR();
    MM(2, pa0, A20, A21); t2 = MX4(p0, 8);  PINV(t2); SBAR();
    MM(3, pa0, A30, A31); t3 = MX4(p0, 12); PINV(t3); SBAR();
    RD8(A, 2); LGK(8); SBAR();
    MM(0, pa1, B00, B01); t4 = MX4(p1, 0);  PINV(t4); SBAR();
    MM(1, pa1, B10, B11); t5 = MX4(p1, 4);  PINV(t5); SBAR();
    MM(2, pa1, B20, B21); t6 = MX4(p1, 8);  PINV(t6); SBAR();
    MM(3, pa1, B30, B31); t7 = MX4(p1, 12); PINV(t7); SBAR();
    RD8(B, 3); LGK(8); SBAR();
    MM(0, pa2, A00, A01);
    float pmax = fmaxf(fmaxf(fmaxf(fmaxf(fmaxf(fmaxf(fmaxf(t0, t1), t2), t3), t4), t5), t6), t7);
    { auto rr = __builtin_amdgcn_permlane32_swap(__float_as_uint(pmax), __float_as_uint(pmax), false, false); pmax = fmaxf(__uint_as_float(rr[0]), __uint_as_float(rr[1])); }
    PINV(pmax); SBAR();
    MM(1, pa2, A10, A11);
    { const bool keep = __all((pmax - m_reg) <= THR); mn = keep ? m_reg : fmaxf(m_reg, pmax); alpha = __builtin_amdgcn_exp2f(m_reg - mn); m_reg = mn; }
    PINV(mn); PINV(alpha); SBAR();
    MM(2, pa2, A20, A21); SE4(p0, 0);  PINV(p0); SBAR();
    MM(3, pa2, A30, A31); SE4(p0, 4);  PINV(p0); SBAR();
    LGK(0); SBAR();
    MM(0, pa3, B00, B01); SE4(p0, 8);  PINV(p0); SBAR();
    MM(1, pa3, B10, B11); SE4(p0, 12); PINV(p0); SBAR();
    MM(2, pa3, B20, B21); SB8(p1, 0);  PINV(p1); SBAR();
    MM(3, pa3, B30, B31); SB8(p1, 8);  PINV(p1); SBAR();
#undef PINV
#undef TRRD
#undef RD8
#undef FR
#undef LGK
#undef MM
#undef MX4
#undef SE4
#undef SB8
}
#endif
struct BlockRef { const bf16* Q; const bf16* K; const bf16* V; bf16* O; int P0; int mode; };
struct Seam { bf16x8 qr[4]; bf16x8 st_v0, st_v1, st_k0; };
struct Stage2 { bf16x8 sv0, sv1, sk0; };
#define VMW() asm volatile("s_waitcnt vmcnt(0)" ::: "memory")
#define VMWN(n) asm volatile("s_waitcnt vmcnt(%0)" :: "i"(n) : "memory")
#define SLOAD_H(Kp, Vp, k0) do { S.st_v0 = *(const bf16x8*)((Vp) + (size_t)((k0) + sr) * LD + sc); S.st_v1 = *(const bf16x8*)((Vp) + (size_t)((k0) + 32 + sr) * LD + sc); \
                                 S.st_k0 = *(const bf16x8*)((Kp) + (size_t)((k0) + kr) * LD + kc); } while (0)
#define SWRITE_HK(bf) do { *(bf16x8*)(K_lds + (bf) * SHM_K + kws) = S.st_k0; } while (0)
#define SWRITE_HV(bf) do { *(bf16x8*)(V_lds + (bf) * SHM_V + vst0) = S.st_v0; *(bf16x8*)(V_lds + (bf) * SHM_V + vst1) = S.st_v1; } while (0)
#define SWRITE_H(bf) do { SWRITE_HV(bf); SWRITE_HK(bf); } while (0)
#define SLOAD_B(Kp, Vp, k0) do { T2.sv0 = *(const bf16x8*)((Vp) + (size_t)((k0) + sr) * LD + sc); T2.sv1 = *(const bf16x8*)((Vp) + (size_t)((k0) + 32 + sr) * LD + sc); \
                                 T2.sk0 = *(const bf16x8*)((Kp) + (size_t)((k0) + kr) * LD + kc); } while (0)
#define SWRITE_B(bf) do { *(bf16x8*)(V_lds + (bf) * SHM_V + vst0) = T2.sv0; *(bf16x8*)(V_lds + (bf) * SHM_V + vst1) = T2.sv1; *(bf16x8*)(K_lds + (bf) * SHM_K + kws) = T2.sk0; } while (0)
__device__ __forceinline__ void attn_prime(const BlockRef& cur, char* lds, Seam& S) {
    int tid_ = threadIdx.x; asm volatile("" : "+v"(tid_)); const int tid = tid_, wid = __builtin_amdgcn_readfirstlane(tid >> 6), lane = tid & 63, r32 = lane & 31, hi = lane >> 5;
    const int sr = tid >> 4, sc = (tid & 15) * 8, kr = tid >> 3, kc = (tid & 7) * 8, kws = KSWZ(kr, kc * 2); char* K_lds = lds + OFF_K;
#pragma unroll
    for (int d0 = 0; d0 < 4; ++d0) S.qr[d0] = *(const bf16x8*)(cur.Q + (size_t)(wid * QBLK + r32) * LD + d0 * 16 + hi * 8);
    SLOAD_H(cur.K, cur.V, 0); VMW(); SWRITE_HK(0);
    __syncthreads();
}
template <int ABL>
__device__ __forceinline__ void attn_block(const BlockRef& cur, const BlockRef& nxt, char* lds, Seam& S, float lam, const float* subg) {
    int tid_ = threadIdx.x; asm volatile("" : "+v"(tid_)); const int tid = tid_, wid = __builtin_amdgcn_readfirstlane(tid >> 6), lane = tid & 63, r32 = lane & 31, hi = lane >> 5;
    const int NT = cur.P0 / KVBLK + QB / KVBLK;
    const int qlo = cur.P0 + wid * QBLK, qm = qlo + r32 - 4 * hi;
    char* V_lds = lds; char* K_lds = lds + OFF_K;
    float* ws = (float*)(lds + OFF_WS) + wid * 64; float* li_l = ws, * al_l = ws + 32;
    float m_reg = -1e30f, l_reg = 0; f32x16 o[4] = {};
    const int sr = tid >> 4, sc = (tid & 15) * 8, vst0 = v_st(sr, sc), vst1 = v_st(32 + sr, sc), kr = tid >> 3, kc = (tid & 7) * 8, kws = KSWZ(kr, kc * 2);
    const int vb0 = (int)(uintptr_t)V_lds + v_rd_base(lane);
    const bf16* Kh = cur.K; const bf16* Vh = cur.V;
#define RESC(a) do { if (__any((a) < 1.f)) { if (hi == 0) al_l[r32] = (a); asm volatile("s_waitcnt lgkmcnt(0)" ::: "memory");              \
                     _Pragma("unroll") for (int d_ = 0; d_ < 4; ++d_) _Pragma("unroll") for (int r = 0; r < 16; ++r) o[d_][r] *= al_l[crow(r, hi)]; } } while (0)
#define KBASE(t) ((t) * KVBLK)
#define ACT(t) (KBASE(t) <= qlo + QBLK - 1)
#define MASKT(P0_, P1_, t) do { const int kb_ = KBASE(t); if (kb_ + KVBLK - 1 > qlo) mask_tile(P0_, P1_, qm - kb_); } while (0)
#ifndef ATTN_NO_FUSE
#define PVSM(VB, PX0, PX1, mnX, alX, t) do { MASKT(PX0, PX1, (t)); SBAR(); pv_softmax<VB>(o, vb0, pa0, pa1, pa2, pa3, PX0, PX1, m_reg, mnX, alX); } while (0)
#else
#define PVSM(VB, PX0, PX1, mnX, alX, t) do { pv_tile<VB>(o, vb0, pa0, pa1, pa2, pa3, ACT((t) - 1)); MASKT(PX0, PX1, (t)); partialSM(PX0, PX1, m_reg, mnX, alX); } while (0)
#endif
#define SEAM_K0() do { VMWN(4); SWRITE_HK(0); SBAR(); } while (0)
    f32x16 pA0, pA1, pB0, pB1; float mnA, mnB, alA, alB; bf16x8 pa0, pa1, pa2, pa3;
    Stage2 T2;
    SWRITE_HV(0); SBAR();
    SLOAD_H(Kh, Vh, KBASE(1)); SBAR(); SLOAD_B(Kh, Vh, KBASE(2)); SBAR();
    qkt<0>(pA0, pA1, K_lds, r32, hi, S.qr, true);
    MASKT(pA0, pA1, 0); partialSM(pA0, pA1, m_reg, mnA, alA);
    VMWN(3); SWRITE_H(1);
    __syncthreads();
#define BARX() do { if (!(ABL & 1)) __syncthreads(); } while (0)
#define HALF_STEP(PX0, PX1, mnX, alX, PY0, PY1, alY, t, KB, VB, SB, LOADM, WRITEM) do {                                      \
        SBAR(); if (!(ABL & 2)) qkt<KB>(PX0, PX1, K_lds, r32, hi, S.qr, ACT(t));                                             \
        finishSM(PY0, PY1, alY, l_reg, pa0, pa1, pa2, pa3); SGB_QK(); SBAR();                                                           \
        if ((t) + 2 < NT) { LOADM(Kh, Vh, KBASE((t) + 2)); SBAR(); }                                               \
        if (!(ABL & 4)) PVSM(VB, PX0, PX1, mnX, alX, t);                                        \
        BARX();                                                                                                      \
        if ((t) + 1 < NT) { if ((t) + 2 < NT) { VMWN(3); } else { VMW(); } WRITEM(SB); }        \
        RESC(alX); BARX(); } while (0)
    for (int t = 1; t + 1 < NT; t += 2) {
        HALF_STEP(pB0, pB1, mnB, alB, pA0, pA1, alA, t, 1, 0, 0, SLOAD_H, SWRITE_B);
        HALF_STEP(pA0, pA1, mnA, alA, pB0, pB1, alB, t + 1, 0, 1, 1, SLOAD_B, SWRITE_H);
    }
    SBAR(); qkt<1>(pB0, pB1, K_lds, r32, hi, S.qr, ACT(NT - 1)); SBAR();
    SLOAD_H(nxt.K, nxt.V, 0); SBAR();
#pragma unroll
    for (int d0 = 0; d0 < 4; ++d0) S.qr[d0] = *(const bf16x8*)(nxt.Q + (size_t)(wid * QBLK + r32) * LD + d0 * 16 + hi * 8);
    SBAR();
    finishSM(pA0, pA1, alA, l_reg, pa0, pa1, pa2, pa3); SBAR();
    PVSM(0, pB0, pB1, mnB, alB, NT - 1); __syncthreads(); RESC(alB);
    finishSM(pB0, pB1, alB, l_reg, pa0, pa1, pa2, pa3); SBAR(); pv_tile<1>(o, vb0, pa0, pa1, pa2, pa3, ACT(NT - 1));
    SBAR(); SEAM_K0();
    if (hi == 0) li_l[r32] = l_reg; asm volatile("s_waitcnt lgkmcnt(0)" ::: "memory");
    float rli[16];
#pragma unroll
    for (int r = 0; r < 16; ++r) rli[r] = __builtin_amdgcn_rcpf(li_l[crow(r, hi)]);
    bf16* stg = (bf16*)(lds + OFF_OST) + wid * 4096;
#pragma unroll
    for (int r = 0; r < 16; ++r) { const int orow = crow(r, hi);
#pragma unroll
        for (int d0 = 0; d0 < 4; ++d0) { const float v = o[d0][r] * rli[r]; stg[orow * 128 + d0 * 32 + r32] = (bf16)(cvtpk(v, v) & 0xffffu); } }
    asm volatile("s_waitcnt lgkmcnt(0)" ::: "memory");
    bf16* Ow = cur.O + (size_t)(wid * QBLK) * LD;
    if (cur.mode == 0) {
#pragma unroll
        for (int i = 0; i < 8; ++i) { const int row = i * 4 + (lane >> 4), ch = lane & 15; *(u32x4*)(Ow + (size_t)row * LD + ch * 8) = *(const u32x4*)(stg + row * 128 + ch * 8); }
    } else {
        f32x4 ga = *(const f32x4*)(subg + (lane & 15) * 8), gb = *(const f32x4*)(subg + (lane & 15) * 8 + 4);
#pragma unroll
        for (int i = 0; i < 8; ++i) { const int row = i * 4 + (lane >> 4), ch = lane & 15; bf16* p = Ow + (size_t)row * LD + ch * 8;
            const u32x4 v = *(const u32x4*)(stg + row * 128 + ch * 8), pv = *(const u32x4*)p; float d[8]; float ss = 0.f;
#pragma unroll
            for (int j = 0; j < 4; ++j) { d[2 * j] = __uint_as_float(pv[j] << 16) - lam * __uint_as_float(v[j] << 16); d[2 * j + 1] = __uint_as_float(pv[j] & 0xffff0000u) - lam * __uint_as_float(v[j] & 0xffff0000u); }
#pragma unroll
            for (int j = 0; j < 8; ++j) ss += d[j] * d[j];
            ss += pg8::swz_xor<1>(ss); ss += pg8::swz_xor<2>(ss); ss += pg8::swz_xor<4>(ss); ss += pg8::swz_xor<8>(ss);
            const float rs = rsqrtf(ss * (1.f / 128.f) + 1e-6f) * 0.8f;
            u32x4 w; w[0] = cvtpk(d[0] * rs * ga[0], d[1] * rs * ga[1]); w[1] = cvtpk(d[2] * rs * ga[2], d[3] * rs * ga[3]); w[2] = cvtpk(d[4] * rs * gb[0], d[5] * rs * gb[1]); w[3] = cvtpk(d[6] * rs * gb[2], d[7] * rs * gb[3]);
            *(u32x4*)p = w; }
    }
    __syncthreads();
#undef RESC
#undef KBASE
#undef ACT
#undef MASKT
#undef SEAM_K0
#undef PVSM
#undef HALF_STEP
#undef BARX
}
#undef VMW
#undef VMWN
#undef SLOAD_H
#undef SWRITE_HK
#undef SWRITE_HV
#undef SWRITE_H
#undef SLOAD_B
#undef SWRITE_B
__device__ __forceinline__ BlockRef block_ref(int n, int vcu, int G, const bf16* Q, const bf16* K, const bf16* V, bf16* O) {
    const int w = vcu + (n >> 2) * G, i = (n >> 1) & 1, c = n & 1, bh = w >> 2, s = w & 3, b = bh >> 3, h = bh & 7, qb = i == 0 ? s : 7 - s;
    const size_t r0 = (size_t)b * SEQ; BlockRef r;
    r.Q = Q + (r0 + (size_t)qb * QB) * LD + (2 * h + c) * 64; r.K = K + r0 * LD + (2 * h + c) * 64; r.V = V + r0 * LD + h * 128; r.O = O + (r0 + (size_t)qb * QB) * LD + h * 128; r.P0 = qb * QB; r.mode = c;
    return r;
}
template <int ABL>
__device__ __forceinline__ void attn_phase(char* lds, const bf16* Q, const bf16* K, const bf16* V, bf16* O, int vcu, int G, float lam, const float* subg) {
    const int nblk = ((1024 - vcu + G - 1) / G) * 4;
    if (nblk <= 0) return;
    BlockRef cur = block_ref(0, vcu, G, Q, K, V, O); Seam S;
#ifdef ATTN_PRIO
    if ((threadIdx.x >> 8) != 0) __builtin_amdgcn_s_setprio(1);
#endif
    attn_prime(cur, lds, S);
    for (int n = 0; n < nblk; ++n) {
        const BlockRef nxt = (n + 1 < nblk) ? block_ref(n + 1, vcu, G, Q, K, V, O) : cur;
        attn_block<ABL>(cur, nxt, lds, S, lam, subg);
        cur = nxt;
    }
#ifdef ATTN_PRIO
    __builtin_amdgcn_s_setprio(0);
#endif
}
#undef KSWZ
#undef SBAR
}

constexpr int NWAVES = 8;
constexpr int BATCH = 32, SEQ = 2048, D = 1024, M = BATCH * SEQ, DIN = 8192, DFF = 2816, NGU = 2 * DFF, NMOD = 6 * D;
constexpr size_t MiB = 1u << 20;
constexpr size_t WS_S0 = 0, WS_S1 = 128 * MiB, WS_S2 = 256 * MiB, WS_S3 = 384 * MiB, WS_S4 = 512 * MiB, WS_S5 = 640 * MiB;
constexpr size_t WS_WIN = 768 * MiB, WS_WA = WS_WIN + 16 * MiB, WS_WB = WS_WA + 2 * MiB, WS_WO = WS_WB + 2 * MiB, WS_WGU = WS_WO + 2 * MiB, WS_WDN = WS_WGU + 11 * MiB, WS_MOD = WS_WDN + 6 * MiB, WS_CTL = WS_MOD + 1 * MiB, WS_END = WS_CTL + 1 * MiB;
constexpr int RING_BYTES = 131072, LDS_BYTES = 147456;
#define LAS __attribute__((address_space(3)))
typedef unsigned short bf16;
typedef unsigned v4u __attribute__((ext_vector_type(4)));
typedef unsigned v2u __attribute__((ext_vector_type(2)));
typedef float f32x4 __attribute__((ext_vector_type(4)));
__device__ __forceinline__ unsigned pk2(float lo, float hi) { return pg8::cvt_pk_bf16(lo, hi); }
__device__ __forceinline__ float wave_sum(float v) { return pg8::wave_sum64(v); }
__device__ __forceinline__ void transpose_item(const float* W, int K, int N, int src_col0, bf16* WT, int dst_row0, int k0, LAS float* scr, int lane) {
    float wv_[32];
#pragma unroll
    for (int i = 0; i < 32; ++i) { const int kk = 2 * i + (lane >> 5); wv_[i] = W[(size_t)(k0 + kk) * N + src_col0 + (lane & 31)]; }
#pragma unroll
    for (int i = 0; i < 32; ++i) { const int kk = 2 * i + (lane >> 5); scr[kk * 33 + (lane & 31)] = wv_[i]; }
    asm volatile("s_waitcnt lgkmcnt(0)" ::: "memory");
    const int c = lane & 7;
#pragma unroll
    for (int j = 0; j < 4; ++j) { const int n = (lane >> 3) + 8 * j; const LAS float* s = scr + (8 * c) * 33 + n;
        v4u o; o.x = pk2(s[0 * 33], s[1 * 33]); o.y = pk2(s[2 * 33], s[3 * 33]); o.z = pk2(s[4 * 33], s[5 * 33]); o.w = pk2(s[6 * 33], s[7 * 33]);
        *(v4u*)(WT + (size_t)(dst_row0 + n) * K + k0 + 8 * c) = o; }
    asm volatile("s_waitcnt lgkmcnt(0)" ::: "memory");
}
struct TItem { const float* W; int K, N, src; bf16* WT; int drow, k0; };
__device__ __forceinline__ void ti_load(const TItem& t, float (&wv)[32], int lane) {
#pragma unroll
    for (int i = 0; i < 32; ++i) { const int kk = 2 * i + (lane >> 5); wv[i] = t.W[(size_t)(t.k0 + kk) * t.N + t.src + (lane & 31)]; }
}
__device__ __forceinline__ void ti_finish(const TItem& t, const float (&wv)[32], LAS float* scr, int lane) {
#pragma unroll
    for (int i = 0; i < 32; ++i) { const int kk = 2 * i + (lane >> 5); scr[kk * 33 + (lane & 31)] = wv[i]; }
    asm volatile("s_waitcnt lgkmcnt(0)" ::: "memory");
    const int c = lane & 7;
#pragma unroll
    for (int j = 0; j < 4; ++j) { const int n = (lane >> 3) + 8 * j; const LAS float* s = scr + (8 * c) * 33 + n;
        v4u o; o.x = pk2(s[0 * 33], s[1 * 33]); o.y = pk2(s[2 * 33], s[3 * 33]); o.z = pk2(s[4 * 33], s[5 * 33]); o.w = pk2(s[6 * 33], s[7 * 33]);
        *(v4u*)(t.WT + (size_t)(t.drow + n) * t.K + t.k0 + 8 * c) = o; }
    asm volatile("s_waitcnt lgkmcnt(0)" ::: "memory");
}
#ifdef FULL_LINE
__device__ __forceinline__ int grp64(int s) { return 64 * ((s & 127) >> 5) + 32 * (s >> 7); }
#else
__device__ __forceinline__ int grp64(int s) { return s; }
#endif
__device__ __forceinline__ int win_src(int n0) {
    if (n0 < 1024) return 3072 + (n0 & ~255) + grp64(n0 & 255);
    if (n0 < 3072) { const int p = (n0 - 1024) >> 8, s = n0 & 255; return s < 128 ? 4096 + 128 * p + s : 5120 + 128 * p + (s - 128); }
    if (n0 < 4096) { const int m = n0 - 3072; return 6144 + (m & ~255) + grp64(m & 255); }
    if (n0 < 6144) { const int m = n0 - 4096, pn = m >> 8, s = m & 255, bj = s >> 7, wc = (s & 127) >> 5; return pn * 256 + 64 * wc + 32 * bj; }
    if (n0 < 7168) { const int m = n0 - 6144; return 2048 + (m & ~255) + grp64(m & 255); }
    { const int m = n0 - 7168; return 7168 + (m & ~255) + grp64(m & 255); }
}
__device__ __forceinline__ int wgu_src(int n0) { const int p = n0 >> 8, s = n0 & 255; return s < 128 ? 128 * p + s : DFF + 128 * p + (s - 128); }

#ifndef P0_EARLY
#define P0_EARLY 3
#endif
#ifndef NORM_RB
#define NORM_RB 4
#endif
__device__ __forceinline__ void norm_rows(const float* X, const float* g, const float* modsh, const float* modsc, bf16* H, int rb, int lane) {
    const size_t row0 = (size_t)rb * 32; const int b = (int)(row0 >> 11);
    f32x4 av[4], sv[4];
#pragma unroll
    for (int j = 0; j < 4; ++j) { const int idx = 4 * lane + 256 * j; const f32x4 gg = *(const f32x4*)(g + idx), sc = *(const f32x4*)(modsc + (size_t)b * NMOD + idx); av[j] = gg * (sc + 1.0f); sv[j] = *(const f32x4*)(modsh + (size_t)b * NMOD + idx); }
    for (int r0 = 0; r0 < 32; r0 += NORM_RB) {
        f32x4 v[NORM_RB][4];
#pragma unroll
        for (int rr = 0; rr < NORM_RB; ++rr) { const f32x4* xr = (const f32x4*)(X + (row0 + r0 + rr) * D) + lane;
#pragma unroll
            for (int j = 0; j < 4; ++j) v[rr][j] = xr[64 * j]; }
#pragma unroll
        for (int rr = 0; rr < NORM_RB; ++rr) { float s = 0.f;
#pragma unroll
            for (int j = 0; j < 4; ++j) s += (v[rr][j].x * v[rr][j].x + v[rr][j].y * v[rr][j].y) + (v[rr][j].z * v[rr][j].z + v[rr][j].w * v[rr][j].w);
            const float rstd = rsqrtf(wave_sum(s) * (1.f / D) + 1e-6f);
            v2u* o8 = (v2u*)(H + (row0 + r0 + rr) * D) + lane;
#pragma unroll
            for (int j = 0; j < 4; ++j) { const f32x4 y = v[rr][j] * rstd * av[j] + sv[j]; v2u w; w.x = pk2(y.x, y.y); w.y = pk2(y.z, y.w); o8[64 * j] = w; } }
    }
}

#define XB_TMO      128
#define XB_XCNT(j)  (256  + 64 * (j))
#define XB_XSUB(j)  (1280 + 64 * (j))
#define XB_XGEN(j)  (2304 + 64 * (j))
#define XB_TOP      3328
#define XB_TOPGEN   3392
#define XCD_BAR_WORDS 3456
#define XB_SPIN_CAP (1u << 18)

__device__ __forceinline__ unsigned xb_ld(unsigned* p)              { return __hip_atomic_load(p, __ATOMIC_RELAXED, __HIP_MEMORY_SCOPE_AGENT); }
__device__ __forceinline__ unsigned xb_add(unsigned* p, unsigned v) { return __hip_atomic_fetch_add(p, v, __ATOMIC_RELAXED, __HIP_MEMORY_SCOPE_AGENT); }
__device__ __forceinline__ unsigned xb_xcc_id() { return (unsigned)__builtin_amdgcn_s_getreg((3 << 11) | 20) & 0xFu; }
#define XB_SPIN(cond, bar) do { unsigned _sp = 0; while (cond) { __builtin_amdgcn_s_sleep(1); \
    if ((++_sp & 255u) == 0u) { if (xb_ld(&(bar)[XB_TMO])) break; if (_sp > XB_SPIN_CAP) { atomicAdd(&(bar)[XB_TMO], 1u); break; } } } } while (0)

struct XcdBarrier {
    unsigned* bar; unsigned x;
    volatile LAS unsigned* st;
};

__device__ __forceinline__ XcdBarrier xcd_barrier_post(unsigned* bar, volatile LAS unsigned* st) {
    XcdBarrier b; b.bar = bar; b.x = xb_xcc_id(); b.st = st;
    if (threadIdx.x == 0) (void)xb_add(&bar[XB_XCNT(b.x)], 1u);
    return b;
}
__device__ __forceinline__ void xcd_barrier_complete(unsigned* bar, unsigned x, unsigned& nloc, unsigned& nx) {
    const unsigned G = gridDim.x * gridDim.y * gridDim.z;
    unsigned sum, cnt, mine, sp = 0u;
    for (;;) {
        sum = 0u; cnt = 0u; mine = 0u;
#pragma unroll
        for (unsigned j = 0; j < 16; ++j) { const unsigned c = xb_ld(&bar[XB_XCNT(j)]); sum += c; cnt += (c > 0u) ? 1u : 0u; mine = (j == x) ? c : mine; }
        if (sum == G) break;
        __builtin_amdgcn_s_sleep(1);
        if ((++sp & 255u) == 0u) { if (xb_ld(&bar[XB_TMO])) break; if (sp > XB_SPIN_CAP) { atomicAdd(&bar[XB_TMO], 1u); break; } }
    }
    nloc = mine > 0u ? mine : 1u; nx = cnt > 0u ? cnt : 1u;
}

__device__ __forceinline__ void xcd_barrier(const XcdBarrier& b) {
    asm volatile("s_waitcnt vmcnt(0)" ::: "memory");
    __syncthreads();
    if (threadIdx.x == 0) {
        unsigned* bar = b.bar;
        __builtin_amdgcn_s_waitcnt(0);
        unsigned nloc = b.st[0], nx = b.st[1];
        if (nloc == 0u) { xcd_barrier_complete(bar, b.x, nloc, nx); b.st[0] = nloc; b.st[1] = nx; }
        const unsigned old = xb_add(&bar[XB_XSUB(b.x)], 1u);
        const unsigned gen = old / nloc;
        if (old + 1u == (gen + 1u) * nloc) {
            __builtin_amdgcn_fence(__ATOMIC_RELEASE, "agent");
            asm volatile("s_waitcnt vmcnt(0)" ::: "memory");
            const unsigned og = xb_add(&bar[XB_TOP], 1u);
            const unsigned tg = og / nx;
            if (og + 1u == (tg + 1u) * nx) xb_add(&bar[XB_TOPGEN], 1u);
            else XB_SPIN(xb_ld(&bar[XB_TOPGEN]) == tg, bar);
            __builtin_amdgcn_fence(__ATOMIC_ACQUIRE, "agent");
            xb_add(&bar[XB_XGEN(b.x)], 1u);
            asm volatile("s_waitcnt vmcnt(0)" ::: "memory");
        } else {
            XB_SPIN(xb_ld(&bar[XB_XGEN(b.x)]) == gen, bar);
            __builtin_amdgcn_fence(__ATOMIC_ACQUIRE, "agent");
            asm volatile("s_waitcnt vmcnt(0)" ::: "memory");
        }
    }
    __syncthreads();
}


__device__ __forceinline__ unsigned pk4_fp8(float a, float b, float c, float d) { unsigned w = 0u; w = (unsigned)__builtin_amdgcn_cvt_pk_fp8_f32(a, b, (int)w, false); w = (unsigned)__builtin_amdgcn_cvt_pk_fp8_f32(c, d, (int)w, true); return w; }
constexpr float WGU_FP8_SCALE = 32.f;
__device__ __forceinline__ void transpose_item8(const float* W, int K, int N, int src_col0, unsigned char* WT, int dst_row0, int k0, LAS float* scr, int lane, float scale) {
    float wv_[32];
#pragma unroll
    for (int i = 0; i < 32; ++i) { const int kk = 2 * i + (lane >> 5); wv_[i] = W[(size_t)(k0 + kk) * N + src_col0 + (lane & 31)]; }
#pragma unroll
    for (int i = 0; i < 32; ++i) { const int kk = 2 * i + (lane >> 5); scr[kk * 33 + (lane & 31)] = wv_[i]; }
    asm volatile("s_waitcnt lgkmcnt(0)" ::: "memory");
    const int n = lane >> 1, kh = (lane & 1) * 32; const LAS float* s = scr + kh * 33 + n;
    v4u o0, o1;
    o0.x = pk4_fp8(s[0 * 33] * scale, s[1 * 33] * scale, s[2 * 33] * scale, s[3 * 33] * scale);     o0.y = pk4_fp8(s[4 * 33] * scale, s[5 * 33] * scale, s[6 * 33] * scale, s[7 * 33] * scale);
    o0.z = pk4_fp8(s[8 * 33] * scale, s[9 * 33] * scale, s[10 * 33] * scale, s[11 * 33] * scale);   o0.w = pk4_fp8(s[12 * 33] * scale, s[13 * 33] * scale, s[14 * 33] * scale, s[15 * 33] * scale);
    o1.x = pk4_fp8(s[16 * 33] * scale, s[17 * 33] * scale, s[18 * 33] * scale, s[19 * 33] * scale); o1.y = pk4_fp8(s[20 * 33] * scale, s[21 * 33] * scale, s[22 * 33] * scale, s[23 * 33] * scale);
    o1.z = pk4_fp8(s[24 * 33] * scale, s[25 * 33] * scale, s[26 * 33] * scale, s[27 * 33] * scale); o1.w = pk4_fp8(s[28 * 33] * scale, s[29 * 33] * scale, s[30 * 33] * scale, s[31 * 33] * scale);
    v4u* dst = (v4u*)(WT + (size_t)(dst_row0 + n) * K + k0 + kh); dst[0] = o0; dst[1] = o1;
    asm volatile("s_waitcnt lgkmcnt(0)" ::: "memory");
}
__device__ __forceinline__ void norm_rows8(const float* X, const float* g, const float* modsh, const float* modsc, unsigned char* H8, int rb, int lane) {
    const size_t row0 = (size_t)rb * 32; const int b = (int)(row0 >> 11);
    f32x4 av[4], sv[4];
#pragma unroll
    for (int j = 0; j < 4; ++j) { const int idx = 4 * lane + 256 * j; const f32x4 gg = *(const f32x4*)(g + idx), sc = *(const f32x4*)(modsc + (size_t)b * NMOD + idx); av[j] = gg * (sc + 1.0f); sv[j] = *(const f32x4*)(modsh + (size_t)b * NMOD + idx); }
    for (int r0 = 0; r0 < 32; r0 += NORM_RB) {
        f32x4 v[NORM_RB][4];
#pragma unroll
        for (int rr = 0; rr < NORM_RB; ++rr) { const f32x4* xr = (const f32x4*)(X + (row0 + r0 + rr) * D) + lane;
#pragma unroll
            for (int j = 0; j < 4; ++j) v[rr][j] = xr[64 * j]; }
#pragma unroll
        for (int rr = 0; rr < NORM_RB; ++rr) { float s = 0.f;
#pragma unroll
            for (int j = 0; j < 4; ++j) s += (v[rr][j].x * v[rr][j].x + v[rr][j].y * v[rr][j].y) + (v[rr][j].z * v[rr][j].z + v[rr][j].w * v[rr][j].w);
            const float rstd = rsqrtf(wave_sum(s) * (1.f / D) + 1e-6f);
            unsigned* o4 = (unsigned*)(H8 + (row0 + r0 + rr) * D) + lane;
#pragma unroll
            for (int j = 0; j < 4; ++j) { const f32x4 y = v[rr][j] * rstd * av[j] + sv[j]; o4[64 * j] = pk4_fp8(y.x, y.y, y.z, y.w); } }
    }
}
#ifndef FP8_SP2
#define FP8_SP2 true
#endif
#ifndef GEMM_ALIGN
#define GEMM_ALIGN true
#endif
#ifndef GEMM_SP2
#define GEMM_SP2 true
#endif
struct Args { const float* in[20]; float* out; unsigned char* ws; };
__global__ void __launch_bounds__(NWAVES * 64, 2) fwd_megakernel(Args args) {
    extern __shared__ __attribute__((aligned(16))) unsigned char lds[];
    cg::grid_group grid = cg::this_grid();
    const int G = gridDim.x, bx = blockIdx.x, vcu = (G % 8 == 0) ? (bx % 8) * (G / 8) + bx / 8 : bx;
    const int NGW = G * NWAVES;
#define GRID_SYNC() do { xcd_barrier(xbar); asm volatile("" ::: "memory"); } while (0)
#define PHASE_IDS() int tid = threadIdx.x; asm volatile("" : "+v"(tid)); const int lane = tid & 63, wave = __builtin_amdgcn_readfirstlane(tid >> 6), gw = vcu * NWAVES + wave; (void)lane; (void)gw
    unsigned char* ws = args.ws;
    const float* x = args.in[0];
    bf16* S0 = (bf16*)(ws + WS_S0); bf16* S1 = (bf16*)(ws + WS_S1); bf16* S2 = (bf16*)(ws + WS_S2); bf16* S3 = (bf16*)(ws + WS_S3); bf16* S4 = (bf16*)(ws + WS_S4); bf16* S5 = (bf16*)(ws + WS_S5);
    bf16* WIN = (bf16*)(ws + WS_WIN); bf16* WA = (bf16*)(ws + WS_WA); bf16* WB = (bf16*)(ws + WS_WB); bf16* WO = (bf16*)(ws + WS_WO); bf16* WGU = (bf16*)(ws + WS_WGU); bf16* WDN = (bf16*)(ws + WS_WDN);
    float* mod = (float*)(ws + WS_MOD);
    float* X1 = (float*)(ws + WS_S1);
    LAS unsigned char* ldsl = (LAS unsigned char*)lds;
    volatile LAS unsigned* MISC = (volatile LAS unsigned*)(ldsl + RING_BYTES + 320);
    if (threadIdx.x < 32) MISC[threadIdx.x] = 0u;
    __syncthreads();
    XcdBarrier xbar = xcd_barrier_post((unsigned*)(ws + WS_CTL), MISC + 8);
    if (args.out == nullptr) grid.sync();

    if (bx < 96) {
        PHASE_IDS();
        LAS float* cact = (LAS float*)ldsl;
        const float* c = args.in[1];
        for (int i = tid; i < BATCH * D; i += NWAVES * 64) { const int b = i >> 10, k = i & 1023; const float cv = c[i]; cact[k * 32 + b] = cv / (1.f + __expf(-cv)); }
        __syncthreads();
        const float* wada = args.in[2]; const int col = bx * 64 + lane, k0 = wave * 128;
        float acc[32];
#pragma unroll
        for (int b = 0; b < 32; ++b) acc[b] = 0.f;
#pragma unroll 8
        for (int kk = 0; kk < 128; ++kk) { const float w = wada[(size_t)(k0 + kk) * NMOD + col]; const LAS f32x4* cp = (const LAS f32x4*)(cact + (k0 + kk) * 32);
#pragma unroll
            for (int j = 0; j < 8; ++j) { const f32x4 cv = cp[j]; acc[4 * j] += w * cv.x; acc[4 * j + 1] += w * cv.y; acc[4 * j + 2] += w * cv.z; acc[4 * j + 3] += w * cv.w; } }
        __syncthreads();
        LAS float* part = (LAS float*)ldsl;
#pragma unroll
        for (int b = 0; b < 32; ++b) part[(wave * 32 + b) * 64 + lane] = acc[b];
        __syncthreads();
        const float* bada = args.in[3];
        for (int o = tid; o < 2048; o += NWAVES * 64) { const int b = o >> 6, cl = o & 63; float s = 0.f;
#pragma unroll
            for (int w = 0; w < 8; ++w) s += part[(w * 32 + b) * 64 + cl];
            mod[(size_t)b * NMOD + bx * 64 + cl] = s + bada[bx * 64 + cl]; }
        __syncthreads();
    }
    {
        PHASE_IDS();
        LAS float* scr = (LAS float*)(ldsl + wave * 16384);
        constexpr int I_IN = 16 * 256, I_SQ = 16 * 32, I_GU = 16 * 176, I_DN = 44 * 32, NITEMS = I_IN + 3 * I_SQ + I_GU + I_DN;
#define TI_DESC(IT, T) do { int r = (IT); \
            if (r < I_IN) { const int kb = r >> 8, nb = r & 255; T.W = args.in[5]; T.K = D; T.N = DIN; T.src = win_src(32 * nb); T.WT = WIN; T.drow = 32 * nb; T.k0 = 64 * kb; break; } r -= I_IN; \
            if (r < I_SQ) { const int kb = r >> 5, nb = r & 31; T.W = args.in[14]; T.K = D; T.N = D; T.src = 32 * nb; T.WT = WA; T.drow = 32 * nb; T.k0 = 64 * kb; break; } r -= I_SQ; \
            if (r < I_SQ) { const int kb = r >> 5, nb = r & 31; T.W = args.in[15]; T.K = D; T.N = D; T.src = 32 * nb; T.WT = WB; T.drow = 32 * nb; T.k0 = 64 * kb; break; } r -= I_SQ; \
            if (r < I_SQ) { const int kb = r >> 5, nb = r & 31; T.W = args.in[16]; T.K = D; T.N = D; T.src = 32 * nb; T.WT = WO; T.drow = 32 * nb; T.k0 = 64 * kb; break; } r -= I_SQ; \
            if (r < I_GU) { const int kb = r / 176, nb = r % 176; T.W = args.in[18]; T.K = D; T.N = NGU; T.src = wgu_src(32 * nb); T.WT = WGU; T.drow = 32 * nb; T.k0 = 64 * kb; break; } r -= I_GU; \
            { const int kb = r >> 5, nb = r & 31; T.W = args.in[19]; T.K = DFF; T.N = D; T.src = 32 * nb; T.WT = WDN; T.drow = 32 * nb; T.k0 = 64 * kb; } } while (0)
        for (int it = gw; it < NITEMS; it += 2 * NGW) {
            TItem ta, tb; const bool hb = it + NGW < NITEMS;
            TI_DESC(it, ta); TI_DESC(hb ? it + NGW : it, tb);
            float va[32], vb[32];
            ti_load(ta, va, lane); if (hb) ti_load(tb, vb, lane);
            ti_finish(ta, va, scr, lane); if (hb) ti_finish(tb, vb, scr, lane);
        }
#undef TI_DESC
    }
    GRID_SYNC();
#ifdef EXP_BAR10
    GRID_SYNC(); GRID_SYNC(); GRID_SYNC(); GRID_SYNC(); GRID_SYNC(); GRID_SYNC(); GRID_SYNC(); GRID_SYNC(); GRID_SYNC(); GRID_SYNC();
#endif
    { PHASE_IDS(); for (int rb = gw; rb < M / 32; rb += NGW) norm_rows(x, args.in[4], mod, mod + D, S0, rb, lane); }
    GRID_SYNC();

    pg8::StaticOrder SO; pg8::Gemm g; pg8::EpiAll E{};
    LAS pg8::EpiP* EP = (LAS pg8::EpiP*)pg8::EPI_LDS_ADDR;
#define EPI_SET(stmts) do { if (threadIdx.x == 0) { stmts; } __syncthreads(); } while (0)
    g = pg8::Gemm{S0, WIN, M, 4096, D}; SO.init(M, 4096, G, bx);
    E.mode = 5; EPI_SET(EP->o3 = S1; EP->o4 = S2; EP->o5 = S3);
    pg8::gemm_phase<pg8::EpiAll, pg8::StaticOrder, GEMM_ALIGN, GEMM_SP2>(ldsl, g, SO, E);
    GRID_SYNC();
#ifdef EXP_KLOOP
    E.mode = EXP_KLOOP; EPI_SET(EP->o3 = S4; EP->o4 = S4; EP->o5 = S5); pg8::gemm_phase<pg8::EpiAll, pg8::StaticOrder, GEMM_ALIGN, GEMM_SP2>(ldsl, g, SO, E);
    GRID_SYNC();
#endif
    {
        PHASE_IDS();
        const float* cw = args.in[6]; const int NT = G * NWAVES * 64, gt = vcu * (NWAVES * 64) + tid;
        for (int it = gt; it < (M / 16) * 128; it += NT) {
            const int cgp = it & 127, rbk = it >> 7; const size_t t0 = (size_t)rbk * 16; const int c0 = cgp * 8;
            f32x4 w0a = *(const f32x4*)(cw + c0), w0b = *(const f32x4*)(cw + c0 + 4), w1a = *(const f32x4*)(cw + D + c0), w1b = *(const f32x4*)(cw + D + c0 + 4), w2a = *(const f32x4*)(cw + 2 * D + c0), w2b = *(const f32x4*)(cw + 2 * D + c0 + 4);
            f32x4 p2a = {0.f, 0.f, 0.f, 0.f}, p2b = p2a, p1a = p2a, p1b = p2a;
            if ((t0 & (SEQ - 1)) != 0) { pg8::unpack8(*(const v4u*)(S2 + (t0 - 2) * D + c0), p2a, p2b); pg8::unpack8(*(const v4u*)(S2 + (t0 - 1) * D + c0), p1a, p1b); }
#pragma unroll 8
            for (int r = 0; r < 16; ++r) { f32x4 ua, ub, ba, bb; pg8::unpack8(*(const v4u*)(S2 + (t0 + r) * D + c0), ua, ub); pg8::unpack8(*(const v4u*)(S1 + (t0 + r) * D + c0), ba, bb);
                const f32x4 ya = ba * (w0a * p2a + w1a * p1a + w2a * ua), yb = bb * (w0b * p2b + w1b * p1b + w2b * ub);
                *(v4u*)(S1 + (t0 + r) * D + c0) = pg8::pack8(ya, yb); p2a = p1a; p2b = p1b; p1a = ua; p1b = ub; }
        }
    }
    GRID_SYNC();
    SO.init(M, D, G, bx);
    g = pg8::Gemm{S1, WA, M, D, D}; E.mode = 1; EPI_SET(EP->o0 = S3; EP->o1 = S3);
    pg8::gemm_phase<pg8::EpiAll, pg8::StaticOrder, GEMM_ALIGN, GEMM_SP2>(ldsl, g, SO, E);
    GRID_SYNC();
    g = pg8::Gemm{S0, WIN + (size_t)4096 * D, M, 4096, D}; SO.init(M, 4096, G, bx);
    E.mode = 0; EPI_SET(EP->o0 = S1; EP->o1 = S2; EP->o2 = S4; EP->o6 = S5; EP->f0 = args.in[7]; EP->f1 = args.in[8]);
    pg8::gemm_phase<pg8::EpiAll, pg8::StaticOrder, GEMM_ALIGN, GEMM_SP2>(ldsl, g, SO, E);
    GRID_SYNC();
    {
        PHASE_IDS();
        float l1 = args.in[9][lane] * args.in[10][lane], l2 = args.in[11][lane] * args.in[12][lane];
        l1 = wave_sum(l1); l2 = wave_sum(l2);
        const float lam = __uint_as_float(__builtin_amdgcn_readfirstlane(__float_as_uint(__expf(l1) - __expf(l2) + 0.2f)));
        attn2::attn_phase<0>((char*)lds, S1, S2, S4, S0, vcu, G, lam, args.in[13]);
#ifdef EXP_ATTN
        GRID_SYNC(); attn2::attn_phase<EXP_ATTN>((char*)lds, S1, S2, S4, (bf16*)(ws + 816 * MiB), vcu, G, lam, args.in[13]);
#endif
    }
    GRID_SYNC();
    SO.init(M, D, G, bx);
    g = pg8::Gemm{S0, WB, M, D, D}; E.mode = 2; EPI_SET(EP->o0 = S3; EP->o1 = S5);
    pg8::gemm_phase<pg8::EpiAll, pg8::StaticOrder, GEMM_ALIGN, GEMM_SP2>(ldsl, g, SO, E);
    GRID_SYNC();
#ifdef EXP_NOFFN
    g = pg8::Gemm{S3, WO, M, D, D}; E.mode = 3; EPI_SET(EP->f0 = x; EP->f1 = mod + 2 * D; EP->fo = args.out);
    pg8::gemm_phase<pg8::EpiAll, pg8::StaticOrder, GEMM_ALIGN, GEMM_SP2>(ldsl, g, SO, E);
    return;
#endif
#ifdef P5_PANEL
    g = pg8::Gemm{S3, WO, M, D, D}; SO.init(M, D, G, bx); SO.panel = 1; E.mode = 3; EPI_SET(EP->f0 = x; EP->f1 = mod + 2 * D; EP->fo = X1);
    pg8::gemm_phase<pg8::EpiAll, pg8::StaticOrder, GEMM_ALIGN, GEMM_SP2>(ldsl, g, SO, E);
#else
    g = pg8::Gemm{S3, WO, M, D, D}; SO.init(M, D, G, bx); E.mode = 3; EPI_SET(EP->f0 = x; EP->f1 = mod + 2 * D; EP->fo = X1);
    pg8::gemm_phase<pg8::EpiAll, pg8::StaticOrder, GEMM_ALIGN, GEMM_SP2>(ldsl, g, SO, E);
    GRID_SYNC();
#endif
#ifdef P5_PANEL
    { PHASE_IDS(); for (int pnl = bx; pnl < M / 256; pnl += G) norm_rows(X1, args.in[17], mod + 3 * D, mod + 4 * D, S0, pnl * 8 + wave, lane); }
#else
#ifdef FFN_FP8
    { PHASE_IDS(); for (int rb = gw; rb < M / 32; rb += NGW) norm_rows8(X1, args.in[17], mod + 3 * D, mod + 4 * D, (unsigned char*)S0, rb, lane); }
#else
    { PHASE_IDS(); for (int rb = gw; rb < M / 32; rb += NGW) norm_rows(X1, args.in[17], mod + 3 * D, mod + 4 * D, S0, rb, lane); }
#endif
#endif
    GRID_SYNC();
#ifdef FFN_FP8
    g = pg8::Gemm{S0, WGU, M, NGU, D / 2}; SO.init(M, NGU, G, bx); E.mode = 6; EPI_SET(EP->o0 = S3);
    { pg8::EpiSw E8{1.f / WGU_FP8_SCALE}; pg8::gemm_phase<pg8::EpiSw, pg8::StaticOrder, GEMM_ALIGN, FP8_SP2, true>(ldsl, g, SO, E8); }
#else
    g = pg8::Gemm{S0, WGU, M, NGU, D}; SO.init(M, NGU, G, bx); E.mode = 4; EPI_SET(EP->o0 = S3);
    pg8::gemm_phase<pg8::EpiAll, pg8::StaticOrder, GEMM_ALIGN, GEMM_SP2>(ldsl, g, SO, E);
#endif
    GRID_SYNC();
    g = pg8::Gemm{S3, WDN, M, D, DFF}; SO.init(M, D, G, bx); E.mode = 3; EPI_SET(EP->f0 = X1; EP->f1 = mod + 5 * D; EP->fo = args.out);
    pg8::gemm_phase<pg8::EpiAll, pg8::StaticOrder, GEMM_ALIGN, GEMM_SP2>(ldsl, g, SO, E);
}

#ifdef FP8_TEST
__global__ void __launch_bounds__(NWAVES * 64, 2) fp8_only(const bf16* A, const bf16* Bt, bf16* out) {
    extern __shared__ __attribute__((aligned(16))) unsigned char lds[];
    LAS unsigned char* ldsl = (LAS unsigned char*)lds;
    LAS pg8::EpiP* EP = (LAS pg8::EpiP*)pg8::EPI_LDS_ADDR; if (threadIdx.x == 0) EP->o0 = out; __syncthreads();
    pg8::StaticOrder SO; SO.init(M, NGU, gridDim.x, blockIdx.x); pg8::Gemm g{A, Bt, M, NGU, D / 2};
    pg8::EpiSw E8{1.f / 32.f}; pg8::gemm_phase<pg8::EpiSw, pg8::StaticOrder, GEMM_ALIGN, FP8_SP2, true>(ldsl, g, SO, E8);
}
__global__ void __launch_bounds__(NWAVES * 64, 2) bf16_only(const bf16* A, const bf16* Bt, bf16* out) {
    extern __shared__ __attribute__((aligned(16))) unsigned char lds[];
    LAS unsigned char* ldsl = (LAS unsigned char*)lds;
    LAS pg8::EpiP* EP = (LAS pg8::EpiP*)pg8::EPI_LDS_ADDR; if (threadIdx.x == 0) EP->o0 = out; __syncthreads();
    pg8::StaticOrder SO; SO.init(M, NGU, gridDim.x, blockIdx.x); pg8::Gemm g{A, Bt, M, NGU, D};
    pg8::EpiSw E8{1.f}; pg8::gemm_phase<pg8::EpiSw, pg8::StaticOrder, GEMM_ALIGN, FP8_SP2, false>(ldsl, g, SO, E8);
}
#endif
extern "C" void kernel_launch(void* const* d_in, const int* in_sizes, int n_in, void* d_out, int out_size, void* d_ws, size_t ws_size, hipStream_t stream) {
    static int grid = 0;
    if (grid == 0) {
        if (n_in != 20 || in_sizes[0] != M * D || out_size != M * D || ws_size < WS_END) { fprintf(stderr, "kernel_launch: unexpected shapes (n_in %d, in0 %d, out %d, ws %zu)\n", n_in, n_in > 0 ? in_sizes[0] : -1, out_size, ws_size); grid = -1; return; }
        int dev = 0, cus = 0, per_cu = 0;
        (void)hipGetDevice(&dev); (void)hipDeviceGetAttribute(&cus, hipDeviceAttributeMultiprocessorCount, dev);
        (void)hipFuncSetAttribute((const void*)fwd_megakernel, hipFuncAttributeMaxDynamicSharedMemorySize, LDS_BYTES);
        if (hipOccupancyMaxActiveBlocksPerMultiprocessor(&per_cu, (const void*)fwd_megakernel, NWAVES * 64, LDS_BYTES) != hipSuccess || per_cu < 1) per_cu = 1;
        (void)hipGetLastError();
        grid = cus * per_cu;
    }
    if (grid < 0) return;
    (void)hipMemsetAsync((unsigned char*)d_ws + WS_CTL, 0, 16384, stream);
    Args a{};
    for (int i = 0; i < 20; ++i) a.in[i] = (const float*)d_in[i];
    a.out = (float*)d_out; a.ws = (unsigned char*)d_ws;
    void* kargs[] = {&a};
    hipError_t e = hipLaunchCooperativeKernel((const void*)fwd_megakernel, dim3(grid), dim3(NWAVES * 64), kargs, LDS_BYTES, stream);
    if (e != hipSuccess) fprintf(stderr, "cooperative launch failed: %s (grid %d)\n", hipGetErrorString(e), grid);
}
```
